# Optimizing an MI355X kernel written in HIP

```python
import jax, jax.numpy as jnp
from jax import lax
import numpy as np

D_MODEL = 1024
BATCH = 4
SEQ = 4096
DEPTH = 1
DEC_BATCH = 32
DEC_SEQ = 4
PAST_LEN = 16384
PAGE_SIZE = 128

RET_HEADS = 4
RET_DK = 256
RET_DV = 512
RET_CHUNK = 128
ATT_HEADS = 8
ATT_KV_HEADS = 2
ATT_HD = 128
IDX_HEADS = 8
IDX_HD = 64
TOPK_ATTN = 256
Q_BLOCK = 128
ROPE_THETA = 10000.0
PEER_HEADS = 8
PEER_NKEYS = 128
PEER_N = PEER_NKEYS * PEER_NKEYS
PEER_DKEY = 256
PEER_TOPK = 16
PEER_BLOCK = 128
PLE_DIM = 256
LN_EPS = 1e-5
ALPHA = (2.0 * DEPTH) ** 0.25
BETA = (8.0 * DEPTH) ** -0.25
NEG = -1e30
SPLITS = (RET_HEADS * RET_DK, RET_HEADS * RET_DK, RET_HEADS * RET_DV, RET_HEADS * RET_DV,
          ATT_HEADS * ATT_HD, ATT_KV_HEADS * ATT_HD, ATT_KV_HEADS * ATT_HD,
          IDX_HEADS * IDX_HD, IDX_HD, IDX_HEADS, D_MODEL, D_MODEL)
VALUE_SPLITS = (2, 6)

kernel_name = 'hybrid_retention_dsa_peer_step'


def layer_norm(x, g, b):
    xf = x.astype(jnp.float32)
    mu = jnp.mean(xf, axis=-1, keepdims=True)
    var = jnp.mean(jnp.square(xf - mu), axis=-1, keepdims=True)
    y = (xf - mu) * lax.rsqrt(var + LN_EPS) * g.astype(jnp.float32) + b.astype(jnp.float32)
    return y.astype(x.dtype)


def rope(x, pos):
    half = x.shape[-1] // 2
    inv = ROPE_THETA ** (-jnp.arange(half, dtype=jnp.float32) / half)
    ang = pos.astype(jnp.float32)[:, None] * inv[None, :]
    cos, sin = jnp.cos(ang)[:, None, :], jnp.sin(ang)[:, None, :]
    xf = x.astype(jnp.float32)
    x1, x2 = xf[..., :half], xf[..., half:]
    return jnp.concatenate([x1 * cos - x2 * sin, x2 * cos + x1 * sin], axis=-1).astype(x.dtype)


def project_in(x, w_in, pos, ik_g, ik_b):
    B, S, _ = x.shape
    offs = np.cumsum(SPLITS)[:-1].tolist()
    rq, rk, rv, rg, aq, ak, av, iq, ik, iw, ga, gb = jnp.split(x @ w_in, offs, axis=-1)
    rq = rope(rq.reshape(B, S, RET_HEADS, RET_DK), pos)
    rk = rope(rk.reshape(B, S, RET_HEADS, RET_DK), pos) * (RET_DK ** -0.5)
    rv = rv.reshape(B, S, RET_HEADS, RET_DV)
    aq = rope(aq.reshape(B, S, ATT_HEADS, ATT_HD), pos)
    ak = rope(ak.reshape(B, S, ATT_KV_HEADS, ATT_HD), pos)
    av = av.reshape(B, S, ATT_KV_HEADS, ATT_HD)
    iq = rope(iq.reshape(B, S, IDX_HEADS, IDX_HD), pos)
    ik = rope(layer_norm(ik, ik_g, ik_b)[:, :, None, :], pos)[:, :, 0, :]
    iw = iw * (IDX_HEADS ** -0.5)
    return rq, rk, rv, rg, aq, ak, av, iq, ik, iw, ga, gb


def retention_log_decay():
    return jnp.log1p(-jnp.exp2(-5.0 - jnp.arange(RET_HEADS, dtype=jnp.float32)))


def retention_chunk(state, qkv):
    q, k, v = (t.astype(jnp.float32) for t in qkv)
    C = q.shape[2]
    lg = retention_log_decay()[:, None]
    i = jnp.arange(C, dtype=jnp.float32)
    diff = i[:, None] - i[None, :]
    decay = jnp.where(diff >= 0, jnp.exp(lg[:, :, None] * jnp.maximum(diff, 0.0)), 0.0)
    inner = jnp.einsum('bhij,bhjv->bhiv', jnp.einsum('bhid,bhjd->bhij', q, k) * decay, v)
    cross = jnp.einsum('bhid,bhdv->bhiv', q, state) * jnp.exp(lg * (i + 1.0))[None, :, :, None]
    k_dec = k * jnp.exp(lg * (C - 1.0 - i))[None, :, :, None]
    new_state = state * jnp.exp(lg * C)[None, :, :, None] + jnp.einsum('bhjd,bhjv->bhdv', k_dec, v)
    return new_state, inner + cross


def retention_prompt(q, k, v):
    B, S = q.shape[:2]
    nc = S // RET_CHUNK

    def chunks(t):
        return t.reshape(B, nc, RET_CHUNK, RET_HEADS, t.shape[-1]).transpose(1, 0, 3, 2, 4)

    s0 = jnp.zeros((B, RET_HEADS, RET_DK, RET_DV), jnp.float32)
    s_fin, o = lax.scan(retention_chunk, s0, (chunks(q), chunks(k), chunks(v)))
    return o.transpose(1, 0, 3, 2, 4).reshape(B, S, RET_HEADS, RET_DV), s_fin


def retention_sample(q, k, v, state):
    s_new, o = retention_chunk(state.astype(jnp.float32),
                               (q.transpose(0, 2, 1, 3), k.transpose(0, 2, 1, 3), v.transpose(0, 2, 1, 3)))
    return o.transpose(0, 2, 1, 3), s_new


def retention_output(o, gate, gn_g, gn_b):
    B, S = o.shape[:2]
    mu = jnp.mean(o, axis=-1, keepdims=True)
    var = jnp.mean(jnp.square(o - mu), axis=-1, keepdims=True)
    on = ((o - mu) * lax.rsqrt(var + LN_EPS)).reshape(B, S, RET_HEADS * RET_DV)
    on = on * gn_g.astype(jnp.float32) + gn_b.astype(jnp.float32)
    return (jax.nn.silu(gate.astype(jnp.float32)) * on).astype(gate.dtype)


def indexer_scores(q_idx, w_idx, k_idx):
    s = jax.nn.relu(jnp.einsum('bthd,bld->bthl', q_idx.astype(jnp.float32), k_idx.astype(jnp.float32)) * (IDX_HD ** -0.5))
    return jnp.einsum('bth,bthl->btl', w_idx.astype(jnp.float32), s)


def sparse_attend(q, k_sel, v_sel, valid):
    B, T = q.shape[:2]
    qg = q.reshape(B, T, ATT_KV_HEADS, ATT_HEADS // ATT_KV_HEADS, ATT_HD).astype(jnp.float32)
    s = jnp.einsum('btgrd,btkgd->btgrk', qg, k_sel.astype(jnp.float32)) * (ATT_HD ** -0.5)
    s = jnp.where(valid[:, :, None, None, :], s, NEG)
    p = jax.nn.softmax(s, axis=-1)
    o = jnp.einsum('btgrk,btkgd->btgrd', p, v_sel.astype(jnp.float32))
    return o.reshape(B, T, ATT_HEADS * ATT_HD).astype(q.dtype)


gather_rows = jax.vmap(lambda t, i: t[i])


def attention_prompt(q, k, v, q_idx, w_idx, k_idx):
    B, S = q.shape[:2]
    topk = min(TOPK_ATTN, S // 4)
    nb = S // Q_BLOCK
    key_pos = jnp.arange(S, dtype=jnp.int32)

    def block(args):
        qb, qib, wb, b0 = args
        qpos = b0 + jnp.arange(Q_BLOCK, dtype=jnp.int32)
        scores = indexer_scores(qib, wb, k_idx)
        scores = jnp.where((key_pos[None, :] <= qpos[:, None])[None], scores, -jnp.inf)
        _, idx = lax.top_k(scores, topk)
        valid = idx <= qpos[None, :, None]
        return sparse_attend(qb, gather_rows(k, idx), gather_rows(v, idx), valid)

    def blocks(t):
        return t.reshape(B, nb, Q_BLOCK, *t.shape[2:]).swapaxes(0, 1)

    starts = jnp.arange(nb, dtype=jnp.int32) * Q_BLOCK
    o = lax.map(block, (blocks(q), blocks(q_idx), blocks(w_idx), starts))
    return o.swapaxes(0, 1).reshape(B, S, ATT_HEADS * ATT_HD)


def attention_sample(q, k_new, v_new, q_idx, w_idx, k_idx_new, cache_k, cache_v, cache_kidx, page_table):
    Bd, T = q.shape[:2]
    L = PAST_LEN + T
    topk = min(TOPK_ATTN, L // 4)
    kidx_past = cache_kidx[page_table].reshape(Bd, PAST_LEN, IDX_HD)
    kidx_all = jnp.concatenate([kidx_past, k_idx_new.astype(kidx_past.dtype)], axis=1)
    qpos = PAST_LEN + jnp.arange(T, dtype=jnp.int32)
    scores = indexer_scores(q_idx, w_idx, kidx_all)
    scores = jnp.where((jnp.arange(L, dtype=jnp.int32)[None, :] <= qpos[:, None])[None], scores, -jnp.inf)
    _, idx = lax.top_k(scores, topk)
    valid = idx <= qpos[None, :, None]
    in_past = (idx < PAST_LEN)[..., None, None]
    pidx = jnp.minimum(idx, PAST_LEN - 1)
    phys = page_table[jnp.arange(Bd)[:, None, None], pidx // PAGE_SIZE]
    off = pidx % PAGE_SIZE
    nidx = jnp.clip(idx - PAST_LEN, 0, T - 1)
    k_sel = jnp.where(in_past, cache_k[phys, off], gather_rows(k_new, nidx).astype(cache_k.dtype))
    v_sel = jnp.where(in_past, cache_v[phys, off], gather_rows(v_new, nidx).astype(cache_v.dtype))
    return sparse_attend(q, k_sel, v_sel, valid)


def peer(x, wq, subkeys, u, v):
    B, S, D = x.shape
    xt = x.reshape(B * S, D)
    n = xt.shape[0]
    xt = jnp.pad(xt, ((0, (-n) % PEER_BLOCK), (0, 0)))
    half = PEER_DKEY // 2

    def block(xb):
        T = xb.shape[0]
        q = (xb @ wq).reshape(T, PEER_HEADS, PEER_DKEY).astype(jnp.float32)
        s1 = jnp.einsum('thd,hnd->thn', q[..., :half], subkeys[:, 0].astype(jnp.float32))
        s2 = jnp.einsum('thd,hnd->thn', q[..., half:], subkeys[:, 1].astype(jnp.float32))
        v1, i1 = lax.top_k(s1, PEER_TOPK)
        v2, i2 = lax.top_k(s2, PEER_TOPK)
        cand = (v1[..., :, None] + v2[..., None, :]).reshape(T, PEER_HEADS, PEER_TOPK * PEER_TOPK)
        cidx = (i1[..., :, None] * PEER_NKEYS + i2[..., None, :]).reshape(T, PEER_HEADS, PEER_TOPK * PEER_TOPK)
        sc, sel = lax.top_k(cand, PEER_TOPK)
        eidx = jnp.take_along_axis(cidx, sel, axis=-1)
        g = jax.nn.softmax(sc, axis=-1)
        act = jax.nn.gelu(jnp.einsum('td,thkd->thk', xb.astype(jnp.float32), u[eidx].astype(jnp.float32)), approximate=False)
        return jnp.einsum('thk,thkd->td', g * act, v[eidx].astype(jnp.float32)).astype(x.dtype)

    out = lax.map(block, xt.reshape(-1, PEER_BLOCK, D))
    return out.reshape(-1, D)[:n].reshape(B, S, D)


def finish_layer(x, p_emb, ret_o, att_o, ga, gb, w_ret_o, w_att_o, w_out, ln1_g, ln1_b,
                 peer_wq, peer_subkeys, peer_u, peer_v, w_ple_gate, w_ple, ln2_g, ln2_b):
    branch = jax.nn.sigmoid(ga) * (ret_o @ w_ret_o) + jax.nn.sigmoid(gb) * (att_o @ w_att_o)
    x = layer_norm(ALPHA * x + branch @ w_out, ln1_g, ln1_b)
    ple = jax.nn.sigmoid(x @ w_ple_gate) * (p_emb @ w_ple)
    return layer_norm(ALPHA * x + peer(x, peer_wq, peer_subkeys, peer_u, peer_v) + ple, ln2_g, ln2_b)


def setup_inputs(seed: int = 0) -> dict:
    key = jax.random.key(seed)
    ks = jax.random.split(key, 32)
    f32 = jnp.float32

    def nrm(k, shape, s):
        return jax.random.normal(k, shape, f32) * s

    n_pages = PAST_LEN // PAGE_SIZE
    n_used = DEC_BATCH * n_pages
    n_phys = n_used + n_used // 4 + 1
    page_table = jax.random.permutation(ks[0], n_phys)[:n_used].reshape(DEC_BATCH, n_pages).astype(jnp.int32)
    in_cols = sum(SPLITS)
    col_scale = jnp.concatenate([jnp.full((c,), BETA if j in VALUE_SPLITS else 1.0, f32) for j, c in enumerate(SPLITS)])
    return {
        'x_prompt': nrm(ks[1], (BATCH, SEQ, D_MODEL), 1.0),
        'x_sample': nrm(ks[2], (DEC_BATCH, DEC_SEQ, D_MODEL), 1.0),
        'cache_k': nrm(ks[3], (DEPTH, n_phys, PAGE_SIZE, ATT_KV_HEADS, ATT_HD), 1.0),
        'cache_v': nrm(ks[4], (DEPTH, n_phys, PAGE_SIZE, ATT_KV_HEADS, ATT_HD), BETA),
        'cache_kidx': nrm(ks[5], (DEPTH, n_phys, PAGE_SIZE, IDX_HD), 1.0),
        'state_ret': nrm(ks[6], (DEPTH, DEC_BATCH, RET_HEADS, RET_DK, RET_DV), 0.3),
        'page_table': page_table,
        'p_prompt': nrm(ks[7], (DEPTH, BATCH, SEQ, PLE_DIM), 1.0),
        'p_sample': nrm(ks[8], (DEPTH, DEC_BATCH, DEC_SEQ, PLE_DIM), 1.0),
        'w_in': nrm(ks[9], (DEPTH, D_MODEL, in_cols), D_MODEL ** -0.5) * col_scale,
        'idx_k_g': 1.0 + nrm(ks[10], (DEPTH, IDX_HD), 0.02),
        'idx_k_b': nrm(ks[11], (DEPTH, IDX_HD), 0.02),
        'gn_g': 1.0 + nrm(ks[12], (DEPTH, RET_HEADS * RET_DV), 0.02),
        'gn_b': nrm(ks[13], (DEPTH, RET_HEADS * RET_DV), 0.02),
        'w_ret_o': nrm(ks[14], (DEPTH, RET_HEADS * RET_DV, D_MODEL), BETA * (RET_HEADS * RET_DV) ** -0.5),
        'w_att_o': nrm(ks[15], (DEPTH, ATT_HEADS * ATT_HD, D_MODEL), BETA * (ATT_HEADS * ATT_HD) ** -0.5),
        'w_out': nrm(ks[16], (DEPTH, D_MODEL, D_MODEL), BETA * D_MODEL ** -0.5),
        'ln1_g': 1.0 + nrm(ks[17], (DEPTH, D_MODEL), 0.02),
        'ln1_b': nrm(ks[18], (DEPTH, D_MODEL), 0.02),
        'peer_wq': nrm(ks[19], (DEPTH, D_MODEL, PEER_HEADS * PEER_DKEY), D_MODEL ** -0.5),
        'peer_subkeys': nrm(ks[20], (DEPTH, PEER_HEADS, 2, PEER_NKEYS, PEER_DKEY // 2), (PEER_DKEY // 2) ** -0.5),
        'peer_u': nrm(ks[21], (DEPTH, PEER_N, D_MODEL), D_MODEL ** -0.5),
        'peer_v': nrm(ks[22], (DEPTH, PEER_N, D_MODEL), BETA * PEER_HEADS ** -0.5),
        'w_ple_gate': nrm(ks[23], (DEPTH, D_MODEL, D_MODEL), D_MODEL ** -0.5),
        'w_ple': nrm(ks[24], (DEPTH, PLE_DIM, D_MODEL), BETA * PLE_DIM ** -0.5),
        'ln2_g': 1.0 + nrm(ks[25], (DEPTH, D_MODEL), 0.02),
        'ln2_b': nrm(ks[26], (DEPTH, D_MODEL), 0.02),
    }


def reference(x_prompt, x_sample, cache_k, cache_v, cache_kidx, state_ret, page_table,
              p_prompt, p_sample, w_in, idx_k_g, idx_k_b, gn_g, gn_b, w_ret_o, w_att_o, w_out,
              ln1_g, ln1_b, peer_wq, peer_subkeys, peer_u, peer_v, w_ple_gate, w_ple, ln2_g, ln2_b):
    pos_p = jnp.arange(x_prompt.shape[1], dtype=jnp.int32)
    pos_s = PAST_LEN + jnp.arange(x_sample.shape[1], dtype=jnp.int32)
    xp, xs = x_prompt, x_sample
    kp, vp, ikp, rp, ksm, vsm, iksm, rsm = [], [], [], [], [], [], [], []
    for i in range(DEPTH):
        tail = (w_ret_o[i], w_att_o[i], w_out[i], ln1_g[i], ln1_b[i], peer_wq[i], peer_subkeys[i],
                peer_u[i], peer_v[i], w_ple_gate[i], w_ple[i], ln2_g[i], ln2_b[i])
        rq, rk, rv, rg, aq, ak, av, iq, ik, iw, ga, gb = project_in(xp, w_in[i], pos_p, idx_k_g[i], idx_k_b[i])
        o_ret, s_fin = retention_prompt(rq, rk, rv)
        ret_o = retention_output(o_ret, rg, gn_g[i], gn_b[i])
        att_o = attention_prompt(aq, ak, av, iq, iw, ik)
        xp = finish_layer(xp, p_prompt[i], ret_o, att_o, ga, gb, *tail)
        kp.append(ak)
        vp.append(av)
        ikp.append(ik)
        rp.append(s_fin.astype(state_ret.dtype))
        rq, rk, rv, rg, aq, ak, av, iq, ik, iw, ga, gb = project_in(xs, w_in[i], pos_s, idx_k_g[i], idx_k_b[i])
        o_ret, s_new = retention_sample(rq, rk, rv, state_ret[i])
        ret_o = retention_output(o_ret, rg, gn_g[i], gn_b[i])
        att_o = attention_sample(aq, ak, av, iq, iw, ik, cache_k[i], cache_v[i], cache_kidx[i], page_table)
        xs = finish_layer(xs, p_sample[i], ret_o, att_o, ga, gb, *tail)
        ksm.append(ak)
        vsm.append(av)
        iksm.append(ik)
        rsm.append(s_new.astype(state_ret.dtype))
    return (xp, xs, jnp.stack(kp), jnp.stack(vp), jnp.stack(ikp), jnp.stack(rp),
            jnp.stack(ksm), jnp.stack(vsm), jnp.stack(iksm), jnp.stack(rsm))
```

```cpp
#include <hip/hip_runtime.h>
#include <stdint.h>
#include <math.h>

namespace nv {
constexpr int TP = 16384, TS = 128, T = 16512;
constexpr int NIN = 10312;
constexpr int C_RQ = 0, C_RK = 1024, C_RV = 2048, C_RG = 4096, C_AQ = 6144, C_AK = 7168, C_AV = 7424,
              C_IQ = 7680, C_IK = 8192, C_IW = 8256, C_GA = 8264, C_GB = 9288;
constexpr float ALPHA = 1.189207115002721f;
constexpr float LN_EPS = 1e-5f;

__device__ __forceinline__ float wave_sum(float v) {
#pragma unroll
    for (int o = 32; o >= 1; o >>= 1) v += __shfl_xor(v, o);
    return v;
}
__device__ __forceinline__ float wave_max(float v) {
#pragma unroll
    for (int o = 32; o >= 1; o >>= 1) v = fmaxf(v, __shfl_xor(v, o));
    return v;
}

__global__ __launch_bounds__(256) void sgemm(const float* __restrict__ A, int lda, const float* __restrict__ B, int ldb,
                                             float* __restrict__ C, int ldc, int M, int N, int K) {
    __shared__ float As[16][68];
    __shared__ float Bs[16][68];
    const int tid = threadIdx.x, tx = tid % 16, ty = tid / 16;
    const int m0 = blockIdx.y * 64, n0 = blockIdx.x * 64;
    float acc[4][4];
#pragma unroll
    for (int i = 0; i < 4; ++i)
#pragma unroll
        for (int j = 0; j < 4; ++j) acc[i][j] = 0.f;
    for (int k0 = 0; k0 < K; k0 += 16) {
#pragma unroll
        for (int i = 0; i < 4; ++i) {
            const int idx = tid + i * 256, m = idx / 16, k = idx % 16;
            As[k][m] = A[(size_t)(m0 + m) * lda + k0 + k];
        }
#pragma unroll
        for (int i = 0; i < 4; ++i) {
            const int idx = tid + i * 256, k = idx / 64, n = idx % 64;
            Bs[k][n] = (n0 + n < N) ? B[(size_t)(k0 + k) * ldb + n0 + n] : 0.f;
        }
        __syncthreads();
#pragma unroll
        for (int k = 0; k < 16; ++k) {
            float a[4], b[4];
#pragma unroll
            for (int i = 0; i < 4; ++i) a[i] = As[k][ty * 4 + i];
#pragma unroll
            for (int j = 0; j < 4; ++j) b[j] = Bs[k][tx * 4 + j];
#pragma unroll
            for (int i = 0; i < 4; ++i)
#pragma unroll
                for (int j = 0; j < 4; ++j) acc[i][j] += a[i] * b[j];
        }
        __syncthreads();
    }
#pragma unroll
    for (int i = 0; i < 4; ++i)
#pragma unroll
        for (int j = 0; j < 4; ++j) {
            const int n = n0 + tx * 4 + j;
            if (n < N) C[(size_t)(m0 + ty * 4 + i) * ldc + n] = acc[i][j];
        }
}

__device__ __forceinline__ void rope_inplace(float* row, int col0, int nheads, int hd, float pos, float scale, int tid) {
    const int half = hd / 2;
    for (int e = tid; e < nheads * half; e += 256) {
        const int h = e / half, i = e % half;
        const float inv = (float)pow(10000.0, -(double)i / (double)half);
        const float ang = pos * inv;
        const float c = (float)cos((double)ang), s = (float)sin((double)ang);
        float* p = row + col0 + h * hd;
        const float x1 = p[i], x2 = p[i + half];
        p[i] = (x1 * c - x2 * s) * scale;
        p[i + half] = (x2 * c + x1 * s) * scale;
    }
}
__global__ __launch_bounds__(256) void post_h(float* H, const float* ikg, const float* ikb, float* kout_p, float* vout_p, float* kidx_p,
                                              float* kout_s, float* vout_s, float* kidx_s) {
    const int r = blockIdx.x, tid = threadIdx.x;
    float* row = H + (size_t)r * NIN;
    const int posi = (r < TP) ? (r % 4096) : (16384 + ((r - TP) % 4));
    const float pos = (float)posi;
    rope_inplace(row, C_RQ, 4, 256, pos, 1.0f, tid);
    rope_inplace(row, C_RK, 4, 256, pos, 0.0625f, tid);
    rope_inplace(row, C_AQ, 8, 128, pos, 1.0f, tid);
    rope_inplace(row, C_AK, 2, 128, pos, 1.0f, tid);
    rope_inplace(row, C_IQ, 8, 64, pos, 1.0f, tid);
    float* kidx_out = (r < TP) ? (kidx_p + (size_t)r * 64) : (kidx_s + (size_t)(r - TP) * 64);
    if (tid < 64) {
        const int l = tid;
        const float v = row[C_IK + l];
        const float mean = wave_sum(v) * (1.0f / 64.0f);
        const float d = v - mean;
        const float var = wave_sum(d * d) * (1.0f / 64.0f);
        const float y = d * rsqrtf(var + LN_EPS) * ikg[l] + ikb[l];
        const float part = __shfl_xor(y, 32);
        const int i = l & 31;
        const float inv = (float)pow(10000.0, -(double)i / 32.0);
        const float ang = pos * inv;
        const float c = (float)cos((double)ang), s = (float)sin((double)ang);
        const float o = (l < 32) ? (y * c - part * s) : (y * c + part * s);
        row[C_IK + l] = o;
        kidx_out[l] = o;
    } else if (tid < 72) {
        row[C_IW + (tid - 64)] *= 0.35355339059327373f;
    }
    __syncthreads();
    float* ko = (r < TP) ? (kout_p + (size_t)r * 256) : (kout_s + (size_t)(r - TP) * 256);
    float* vo = (r < TP) ? (vout_p + (size_t)r * 256) : (vout_s + (size_t)(r - TP) * 256);
    ko[tid] = row[C_AK + tid];
    vo[tid] = row[C_AV + tid];
}

__global__ __launch_bounds__(256) void ret_scan(const float* H, int row0, int ntok, const float* state_in, float* state_out, float* O) {
    __shared__ float qs[256], ks[256];
    const int tid = threadIdx.x, col = tid >> 2, dkq = tid & 3;
    const int vg = blockIdx.x, bh = blockIdx.y, b = bh >> 2, h = bh & 3;
    const float gamma = 1.0f - exp2f(-5.0f - (float)h);
    float S[64];
    const size_t sbase = (size_t)bh * 256 * 512 + (size_t)(dkq * 64) * 512 + vg * 64 + col;
#pragma unroll
    for (int i = 0; i < 64; ++i) S[i] = state_in ? state_in[sbase + (size_t)i * 512] : 0.f;
    for (int t = 0; t < ntok; ++t) {
        const size_t r = (size_t)(row0 + b * ntok + t);
        const float* row = H + r * NIN;
        qs[tid] = row[C_RQ + h * 256 + tid];
        ks[tid] = row[C_RK + h * 256 + tid];
        const float v = row[C_RV + h * 512 + vg * 64 + col];
        __syncthreads();
        float part = 0.f;
#pragma unroll
        for (int i = 0; i < 64; ++i) {
            S[i] = gamma * S[i] + ks[dkq * 64 + i] * v;
            part += qs[dkq * 64 + i] * S[i];
        }
        part += __shfl_xor(part, 1);
        part += __shfl_xor(part, 2);
        if (dkq == 0) O[r * 2048 + h * 512 + vg * 64 + col] = part;
        __syncthreads();
    }
#pragma unroll
    for (int i = 0; i < 64; ++i) state_out[sbase + (size_t)i * 512] = S[i];
}

__global__ __launch_bounds__(256) void ret_gn(float* O, const float* H, const float* gng, const float* gnb) {
    const int wid = threadIdx.x >> 6, lane = threadIdx.x & 63;
    const int item = blockIdx.x * 4 + wid;
    const int r = item >> 2, h = item & 3;
    float* o = O + (size_t)r * 2048 + h * 512;
    float v[8];
    float s = 0.f;
#pragma unroll
    for (int i = 0; i < 8; ++i) { v[i] = o[lane + 64 * i]; s += v[i]; }
    const float mean = wave_sum(s) * (1.0f / 512.0f);
    float q = 0.f;
#pragma unroll
    for (int i = 0; i < 8; ++i) { const float d = v[i] - mean; q += d * d; }
    const float rstd = rsqrtf(wave_sum(q) * (1.0f / 512.0f) + LN_EPS);
#pragma unroll
    for (int i = 0; i < 8; ++i) {
        const int c = h * 512 + lane + 64 * i;
        const float on = (v[i] - mean) * rstd * gng[c] + gnb[c];
        const float g = H[(size_t)r * NIN + C_RG + c];
        o[lane + 64 * i] = g / (1.0f + expf(-g)) * on;
    }
}

__device__ __forceinline__ unsigned fkey(float f) { const unsigned u = __float_as_uint(f); return (u & 0x80000000u) ? ~u : (u | 0x80000000u); }

template <bool SAMPLE>
__global__ __launch_bounds__(256) void attn_naive(const float* H, const float* cache_k, const float* cache_v, const float* cache_kidx,
                                                  const int* page_table, float* ATT_O) {
    extern __shared__ unsigned smem_u[];
    const int LMAX = SAMPLE ? 16388 : 4096;
    unsigned* keys = smem_u;
    float* qi = (float*)(smem_u + LMAX);
    float* qa = qi + 512;
    float* pp = qa + 1024;
    int* sel = (int*)(pp + 2048);
    float* wv = (float*)(sel + 256);
    unsigned* red = (unsigned*)(wv + 8);
    const int tid = threadIdx.x, wid = tid >> 6, lane = tid & 63;
    const int qn = blockIdx.x;
    int b, qpos, r;
    if (!SAMPLE) { b = qn / 4096; qpos = qn % 4096; r = qn; } else { b = qn / 4; qpos = 16384 + (qn % 4); r = TP + qn; }
    const int nvalid = qpos + 1;
    const float* qrow = H + (size_t)r * NIN;
    for (int i = tid; i < 512; i += 256) qi[i] = qrow[C_IQ + i];
    for (int i = tid; i < 1024; i += 256) qa[i] = qrow[C_AQ + i];
    if (tid < 8) wv[tid] = qrow[C_IW + tid];
    __syncthreads();
    for (int s = tid; s < nvalid; s += 256) {
        const float* kr;
        if (!SAMPLE) kr = H + (size_t)(b * 4096 + s) * NIN + C_IK;
        else if (s < 16384) kr = cache_kidx + ((size_t)page_table[b * 128 + (s >> 7)] * 128 + (s & 127)) * 64;
        else kr = H + (size_t)(TP + b * 4 + (s - 16384)) * NIN + C_IK;
        float4 kk[16];
#pragma unroll
        for (int e = 0; e < 16; ++e) kk[e] = *(const float4*)(kr + 4 * e);
        float acc = 0.f;
#pragma unroll 1
        for (int h = 0; h < 8; ++h) {
            float d = 0.f;
#pragma unroll
            for (int e = 0; e < 16; ++e) {
                const float* qq = qi + h * 64 + 4 * e;
                d += qq[0] * kk[e].x + qq[1] * kk[e].y + qq[2] * kk[e].z + qq[3] * kk[e].w;
            }
            acc += wv[h] * fmaxf(d * 0.125f, 0.f);
        }
        keys[s] = fkey(acc);
    }
    __syncthreads();
    int nsel;
    if (nvalid <= 256) {
        if (tid < nvalid) sel[tid] = tid;
        nsel = nvalid;
        __syncthreads();
    } else {
        unsigned prefix = 0u;
        for (int bit = 31; bit >= 0; --bit) {
            const unsigned cand = prefix | (1u << bit);
            int c = 0;
            for (int s = tid; s < nvalid; s += 256) c += (keys[s] >= cand) ? 1 : 0;
            c = (int)wave_sum((float)c);
            if (lane == 0) red[wid] = (unsigned)c;
            __syncthreads();
            const unsigned tot = red[0] + red[1] + red[2] + red[3];
            __syncthreads();
            if (tot >= 256u) prefix = cand;
        }
        const unsigned thr = prefix;
        int c = 0;
        for (int s = tid; s < nvalid; s += 256) c += (keys[s] > thr) ? 1 : 0;
        c = (int)wave_sum((float)c);
        if (lane == 0) red[wid] = (unsigned)c;
        __syncthreads();
        const int ngt = (int)(red[0] + red[1] + red[2] + red[3]);
        const int need = 256 - ngt;
        if (wid == 0) {
            int nout = 0, neq = 0;
            for (int base = 0; base < nvalid; base += 64) {
                const int s = base + lane;
                const unsigned k = (s < nvalid) ? keys[s] : 0u;
                const bool gt = (s < nvalid) && (k > thr);
                const bool eq = (s < nvalid) && (k == thr);
                const unsigned long long meq = __ballot(eq);
                const unsigned long long below = (lane == 0) ? 0ull : (~0ull >> (64 - lane));
                const int eqrank = neq + __popcll(meq & below);
                const bool take = gt || (eq && eqrank < need);
                const unsigned long long mt = __ballot(take);
                if (take) sel[nout + __popcll(mt & below)] = s;
                nout += __popcll(mt);
                neq += __popcll(meq);
            }
        }
        nsel = 256;
        __syncthreads();
    }
    if (tid < nsel) {
        const int s = sel[tid];
#pragma unroll 1
        for (int g = 0; g < 2; ++g) {
            const float* kr;
            if (!SAMPLE) kr = H + (size_t)(b * 4096 + s) * NIN + C_AK + g * 128;
            else if (s < 16384) kr = cache_k + (((size_t)page_table[b * 128 + (s >> 7)] * 128 + (s & 127)) * 2 + g) * 128;
            else kr = H + (size_t)(TP + b * 4 + (s - 16384)) * NIN + C_AK + g * 128;
            float d0 = 0.f, d1 = 0.f, d2 = 0.f, d3 = 0.f;
#pragma unroll 4
            for (int e = 0; e < 128; ++e) {
                const float kv = kr[e];
                d0 += qa[(g * 4 + 0) * 128 + e] * kv;
                d1 += qa[(g * 4 + 1) * 128 + e] * kv;
                d2 += qa[(g * 4 + 2) * 128 + e] * kv;
                d3 += qa[(g * 4 + 3) * 128 + e] * kv;
            }
            const float sc = 0.08838834764831845f;
            pp[(g * 4 + 0) * 256 + tid] = d0 * sc;
            pp[(g * 4 + 1) * 256 + tid] = d1 * sc;
            pp[(g * 4 + 2) * 256 + tid] = d2 * sc;
            pp[(g * 4 + 3) * 256 + tid] = d3 * sc;
        }
    }
    __syncthreads();
    for (int hh = 0; hh < 2; ++hh) {
        const int h = wid * 2 + hh;
        float v[4];
        float m = -3.0e38f;
#pragma unroll
        for (int i = 0; i < 4; ++i) { const int j = lane + 64 * i; v[i] = (j < nsel) ? pp[h * 256 + j] : -3.0e38f; m = fmaxf(m, v[i]); }
        m = wave_max(m);
        float sum = 0.f;
#pragma unroll
        for (int i = 0; i < 4; ++i) { const int j = lane + 64 * i; v[i] = (j < nsel) ? expf(v[i] - m) : 0.f; sum += v[i]; }
        sum = wave_sum(sum);
        const float inv = 1.0f / sum;
#pragma unroll
        for (int i = 0; i < 4; ++i) { const int j = lane + 64 * i; if (j < nsel) pp[h * 256 + j] = v[i] * inv; }
    }
    __syncthreads();
    {
        const int g = tid >> 7, d = tid & 127;
        float o0 = 0.f, o1 = 0.f, o2 = 0.f, o3 = 0.f;
#pragma unroll 2
        for (int j = 0; j < nsel; ++j) {
            const int s = sel[j];
            const float* vr;
            if (!SAMPLE) vr = H + (size_t)(b * 4096 + s) * NIN + C_AV + g * 128;
            else if (s < 16384) vr = cache_v + (((size_t)page_table[b * 128 + (s >> 7)] * 128 + (s & 127)) * 2 + g) * 128;
            else vr = H + (size_t)(TP + b * 4 + (s - 16384)) * NIN + C_AV + g * 128;
            const float vv = vr[d];
            o0 += pp[(g * 4 + 0) * 256 + j] * vv;
            o1 += pp[(g * 4 + 1) * 256 + j] * vv;
            o2 += pp[(g * 4 + 2) * 256 + j] * vv;
            o3 += pp[(g * 4 + 3) * 256 + j] * vv;
        }
        float* out = ATT_O + (size_t)r * 1024;
        out[(g * 4 + 0) * 128 + d] = o0;
        out[(g * 4 + 1) * 128 + d] = o1;
        out[(g * 4 + 2) * 128 + d] = o2;
        out[(g * 4 + 3) * 128 + d] = o3;
    }
}

__global__ __launch_bounds__(256) void branch_mix(const float* H, const float* Y1, const float* Y2, float* BR) {
    const int r = blockIdx.x;
    for (int d = threadIdx.x; d < 1024; d += 256) {
        const float ga = H[(size_t)r * NIN + C_GA + d], gb = H[(size_t)r * NIN + C_GB + d];
        BR[(size_t)r * 1024 + d] = Y1[(size_t)r * 1024 + d] / (1.0f + expf(-ga)) + Y2[(size_t)r * 1024 + d] / (1.0f + expf(-gb));
    }
}
__device__ __forceinline__ float block_sum256(float v, float* red) {
    v = wave_sum(v);
    __syncthreads();
    if ((threadIdx.x & 63) == 0) red[threadIdx.x >> 6] = v;
    __syncthreads();
    return red[0] + red[1] + red[2] + red[3];
}
__global__ __launch_bounds__(256) void ln1_kernel(const float* xp, const float* xs, const float* Z, const float* g, const float* bb, float* X1) {
    __shared__ float red[4];
    const int r = blockIdx.x, tid = threadIdx.x;
    const float* x = (r < TP) ? (xp + (size_t)r * 1024) : (xs + (size_t)(r - TP) * 1024);
    float v[4];
    float s = 0.f;
#pragma unroll
    for (int i = 0; i < 4; ++i) { const int d = tid + 256 * i; v[i] = ALPHA * x[d] + Z[(size_t)r * 1024 + d]; s += v[i]; }
    const float mean = block_sum256(s, red) * (1.0f / 1024.0f);
    float q = 0.f;
#pragma unroll
    for (int i = 0; i < 4; ++i) { const float d = v[i] - mean; q += d * d; }
    const float rstd = rsqrtf(block_sum256(q, red) * (1.0f / 1024.0f) + LN_EPS);
#pragma unroll
    for (int i = 0; i < 4; ++i) { const int d = tid + 256 * i; X1[(size_t)r * 1024 + d] = (v[i] - mean) * rstd * g[d] + bb[d]; }
}

__device__ __forceinline__ void wave_argmax(float& v, int& i) {
#pragma unroll
    for (int o = 32; o >= 1; o >>= 1) {
        const float ov = __shfl_xor(v, o);
        const int oi = __shfl_xor(i, o);
        if (ov > v || (ov == v && oi < i)) { v = ov; i = oi; }
    }
}
__global__ __launch_bounds__(256) void peer_naive(const float* X1, const float* Q, const float* G, const float* PE, const float* subkeys,
                                                  const float* U, const float* V, const float* g2, const float* b2, float* yp, float* ys) {
    __shared__ float xs[1024];
    __shared__ float qs[2048];
    __shared__ float sc[16][128];
    __shared__ float topv[16][16];
    __shared__ int topi[16][16];
    __shared__ float gw[128];
    __shared__ int eid[128];
    __shared__ float red[4];
    const int r = blockIdx.x, tid = threadIdx.x, wid = tid >> 6, lane = tid & 63;
    for (int i = tid; i < 1024; i += 256) xs[i] = X1[(size_t)r * 1024 + i];
    for (int i = tid; i < 2048; i += 256) qs[i] = Q[(size_t)r * 2048 + i];
    __syncthreads();
    for (int it = 0; it < 8; ++it) {
        const int id = tid + 256 * it, list = id >> 7, n = id & 127;
        const float* sk = subkeys + ((size_t)list * 128 + n) * 128;
        const float* qq = qs + list * 128;
        float d = 0.f;
        for (int e = 0; e < 128; ++e) d += qq[e] * sk[e];
        sc[list][n] = d;
    }
    __syncthreads();
    for (int li = 0; li < 4; ++li) {
        const int list = wid * 4 + li;
        float v0 = sc[list][lane], v1 = sc[list][lane + 64];
        for (int k = 0; k < 16; ++k) {
            float bv; int bi;
            if (v1 > v0) { bv = v1; bi = lane + 64; } else { bv = v0; bi = lane; }
            wave_argmax(bv, bi);
            if (lane == 0) { topv[list][k] = bv; topi[list][k] = bi; }
            if (bi == lane) v0 = -3.0e38f;
            if (bi == lane + 64) v1 = -3.0e38f;
        }
    }
    __syncthreads();
    for (int hh = 0; hh < 2; ++hh) {
        const int h = wid * 2 + hh;
        float cv[4];
#pragma unroll
        for (int i = 0; i < 4; ++i) { const int c = lane + 64 * i; cv[i] = topv[2 * h][c >> 4] + topv[2 * h + 1][c & 15]; }
        float myv = 0.f; int myc = 0;
        for (int k = 0; k < 16; ++k) {
            float bv = cv[0]; int bi = lane;
#pragma unroll
            for (int i = 1; i < 4; ++i) if (cv[i] > bv) { bv = cv[i]; bi = lane + 64 * i; }
            wave_argmax(bv, bi);
            if (lane == k) { myv = bv; myc = bi; }
#pragma unroll
            for (int i = 0; i < 4; ++i) if (bi == lane + 64 * i) cv[i] = -3.0e38f;
        }
        float m = (lane < 16) ? myv : -3.0e38f;
        m = wave_max(m);
        const float e = (lane < 16) ? expf(myv - m) : 0.f;
        const float ssum = wave_sum(e);
        if (lane < 16) {
            gw[h * 16 + lane] = e / ssum;
            eid[h * 16 + lane] = topi[2 * h][myc >> 4] * 128 + topi[2 * h + 1][myc & 15];
        }
    }
    __syncthreads();
    for (int pi = 0; pi < 32; ++pi) {
        const int p = wid * 32 + pi;
        const float* u = U + (size_t)eid[p] * 1024;
        float d = 0.f;
#pragma unroll
        for (int i = 0; i < 4; ++i) {
            const float4 uv = *(const float4*)(u + lane * 4 + 256 * i);
            const float* xx = xs + lane * 4 + 256 * i;
            d += xx[0] * uv.x + xx[1] * uv.y + xx[2] * uv.z + xx[3] * uv.w;
        }
        d = wave_sum(d);
        if (lane == 0) gw[p] = gw[p] * 0.5f * d * (1.0f + erff(d * 0.7071067811865476f));
    }
    __syncthreads();
    float4 o = make_float4(0.f, 0.f, 0.f, 0.f);
    for (int p = 0; p < 128; ++p) {
        const float4 vv = *(const float4*)(V + (size_t)eid[p] * 1024 + tid * 4);
        const float w = gw[p];
        o.x += w * vv.x; o.y += w * vv.y; o.z += w * vv.z; o.w += w * vv.w;
    }
    float val[4];
    {
        const float4 gg = *(const float4*)(G + (size_t)r * 1024 + tid * 4);
        const float4 pe = *(const float4*)(PE + (size_t)r * 1024 + tid * 4);
        val[0] = ALPHA * xs[tid * 4 + 0] + o.x + pe.x / (1.0f + expf(-gg.x));
        val[1] = ALPHA * xs[tid * 4 + 1] + o.y + pe.y / (1.0f + expf(-gg.y));
        val[2] = ALPHA * xs[tid * 4 + 2] + o.z + pe.z / (1.0f + expf(-gg.z));
        val[3] = ALPHA * xs[tid * 4 + 3] + o.w + pe.w / (1.0f + expf(-gg.w));
    }
    const float mean = block_sum256(val[0] + val[1] + val[2] + val[3], red) * (1.0f / 1024.0f);
    float q = 0.f;
#pragma unroll
    for (int i = 0; i < 4; ++i) { const float d = val[i] - mean; q += d * d; }
    const float rstd = rsqrtf(block_sum256(q, red) * (1.0f / 1024.0f) + LN_EPS);
    float* y = (r < TP) ? (yp + (size_t)r * 1024) : (ys + (size_t)(r - TP) * 1024);
#pragma unroll
    for (int i = 0; i < 4; ++i) { const int d = tid * 4 + i; y[d] = (val[i] - mean) * rstd * g2[d] + b2[d]; }
}

static void gemm(hipStream_t st, const float* A, int lda, const float* B, int ldb, float* C, int ldc, int M, int N, int K) {
    dim3 grid((N + 63) / 64, M / 64);
    hipLaunchKernelGGL(sgemm, grid, dim3(256), 0, st, A, lda, B, ldb, C, ldc, M, N, K);
}
}

extern "C" void kernel_launch(void* const* d_in, const int* in_sizes, int n_in, void* d_out, int out_size, void* d_ws, size_t ws_size,
                              hipStream_t stream) {
    using namespace nv;
    const float* x_prompt = (const float*)d_in[0];
    const float* x_sample = (const float*)d_in[1];
    const float* cache_k = (const float*)d_in[2];
    const float* cache_v = (const float*)d_in[3];
    const float* cache_kidx = (const float*)d_in[4];
    const float* state_ret = (const float*)d_in[5];
    const int* page_table = (const int*)d_in[6];
    const float* p_prompt = (const float*)d_in[7];
    const float* p_sample = (const float*)d_in[8];
    const float* w_in = (const float*)d_in[9];
    const float* idx_k_g = (const float*)d_in[10];
    const float* idx_k_b = (const float*)d_in[11];
    const float* gn_g = (const float*)d_in[12];
    const float* gn_b = (const float*)d_in[13];
    const float* w_ret_o = (const float*)d_in[14];
    const float* w_att_o = (const float*)d_in[15];
    const float* w_out = (const float*)d_in[16];
    const float* ln1_g = (const float*)d_in[17];
    const float* ln1_b = (const float*)d_in[18];
    const float* peer_wq = (const float*)d_in[19];
    const float* peer_subkeys = (const float*)d_in[20];
    const float* peer_u = (const float*)d_in[21];
    const float* peer_v = (const float*)d_in[22];
    const float* w_ple_gate = (const float*)d_in[23];
    const float* w_ple = (const float*)d_in[24];
    const float* ln2_g = (const float*)d_in[25];
    const float* ln2_b = (const float*)d_in[26];

    float* out = (float*)d_out;
    float* y_prompt = out;
    float* y_sample = y_prompt + 16777216;
    float* k_prompt = y_sample + 131072;
    float* v_prompt = k_prompt + 4194304;
    float* kidx_prompt = v_prompt + 4194304;
    float* ret_prompt = kidx_prompt + 1048576;
    float* k_sample = ret_prompt + 2097152;
    float* v_sample = k_sample + 32768;
    float* kidx_sample = v_sample + 32768;
    float* ret_sample = kidx_sample + 8192;

    float* ws = (float*)d_ws;
    float* H = ws;                                   ws += (size_t)T * NIN;
    float* RO = ws;                                  ws += (size_t)T * 2048;
    float* AO = ws;                                  ws += (size_t)T * 1024;
    float* Y1 = ws;                                  ws += (size_t)T * 1024;
    float* Y2 = ws;                                  ws += (size_t)T * 1024;
    float* BR = ws;                                  ws += (size_t)T * 1024;
    float* Z = ws;                                   ws += (size_t)T * 1024;
    float* X1 = ws;                                  ws += (size_t)T * 1024;
    float* Q = ws;                                   ws += (size_t)T * 2048;
    float* G = ws;                                   ws += (size_t)T * 1024;
    float* PE = ws;                                  ws += (size_t)T * 1024;

    gemm(stream, x_prompt, 1024, w_in, NIN, H, NIN, TP, NIN, 1024);
    gemm(stream, x_sample, 1024, w_in, NIN, H + (size_t)TP * NIN, NIN, TS, NIN, 1024);
    hipLaunchKernelGGL(post_h, dim3(T), dim3(256), 0, stream, H, idx_k_g, idx_k_b, k_prompt, v_prompt, kidx_prompt, k_sample, v_sample, kidx_sample);
    hipLaunchKernelGGL(ret_scan, dim3(8, 16), dim3(256), 0, stream, (const float*)H, 0, 4096, (const float*)nullptr, ret_prompt, RO);
    hipLaunchKernelGGL(ret_scan, dim3(8, 128), dim3(256), 0, stream, (const float*)H, TP, 4, state_ret, ret_sample, RO);
    hipLaunchKernelGGL(ret_gn, dim3(T), dim3(256), 0, stream, RO, (const float*)H, gn_g, gn_b);
    {
        const size_t lds_p = (size_t)(4096 + 512 + 1024 + 2048 + 256 + 8 + 8) * 4;
        const size_t lds_s = (size_t)(16388 + 512 + 1024 + 2048 + 256 + 8 + 8) * 4;
        hipFuncSetAttribute((const void*)attn_naive<true>, hipFuncAttributeMaxDynamicSharedMemorySize, (int)lds_s);
        hipLaunchKernelGGL(attn_naive<false>, dim3(TP), dim3(256), lds_p, stream, (const float*)H, cache_k, cache_v, cache_kidx, page_table, AO);
        hipLaunchKernelGGL(attn_naive<true>, dim3(TS), dim3(256), lds_s, stream, (const float*)H, cache_k, cache_v, cache_kidx, page_table, AO);
    }
    gemm(stream, RO, 2048, w_ret_o, 1024, Y1, 1024, T, 1024, 2048);
    gemm(stream, AO, 1024, w_att_o, 1024, Y2, 1024, T, 1024, 1024);
    hipLaunchKernelGGL(branch_mix, dim3(T), dim3(256), 0, stream, (const float*)H, (const float*)Y1, (const float*)Y2, BR);
    gemm(stream, BR, 1024, w_out, 1024, Z, 1024, T, 1024, 1024);
    hipLaunchKernelGGL(ln1_kernel, dim3(T), dim3(256), 0, stream, x_prompt, x_sample, (const float*)Z, ln1_g, ln1_b, X1);
    gemm(stream, X1, 1024, peer_wq, 2048, Q, 2048, T, 2048, 1024);
    gemm(stream, X1, 1024, w_ple_gate, 1024, G, 1024, T, 1024, 1024);
    gemm(stream, p_prompt, 256, w_ple, 1024, PE, 1024, TP, 1024, 256);
    gemm(stream, p_sample, 256, w_ple, 1024, PE + (size_t)TP * 1024, 1024, TS, 1024, 256);
    hipLaunchKernelGGL(peer_naive, dim3(T), dim3(256), 0, stream, (const float*)X1, (const float*)Q, (const float*)G, (const float*)PE,
                       peer_subkeys, peer_u, peer_v, ln2_g, ln2_b, y_prompt, y_sample);
}
```

```cpp
#include <hip/hip_runtime.h>
#include <stdint.h>
#include <math.h>

#define LAS3 __attribute__((address_space(3)))
typedef unsigned short bf16_t;
typedef _Float16 f16_t;

namespace mk {
constexpr int TP = 16384, TS = 128, T = 16512, MP = 16640;
constexpr int NIN = 10312, NINP = 10496;
constexpr int C_RQ = 0, C_RK = 1024, C_RV = 2048, C_RG = 4096, C_AQ = 6144, C_AK = 7168, C_AV = 7424,
              C_IQ = 7680, C_IK = 8192, C_IW = 8256, C_GA = 8264, C_GB = 9288;
constexpr float ALPHA = 1.189207115002721f;
constexpr float LN_EPS = 1e-5f;
constexpr int NPOS = 4100;
constexpr int LDS_TOTAL = 147456;
constexpr int LDS_BAR = LDS_TOTAL - 16;
constexpr int NT = 512;

__device__ __forceinline__ float wave_sum(float v) {
#pragma unroll
    for (int o = 32; o >= 1; o >>= 1) v += __shfl_xor(v, o);
    return v;
}
__device__ __forceinline__ float wave_max(float v) {
#pragma unroll
    for (int o = 32; o >= 1; o >>= 1) v = fmaxf(v, __shfl_xor(v, o));
    return v;
}
__device__ __forceinline__ bf16_t f2bf(float f) { unsigned u = __float_as_uint(f); u += 0x7FFFu + ((u >> 16) & 1u); return (bf16_t)(u >> 16); }
__device__ __forceinline__ float bf2f(bf16_t b) { return __uint_as_float(((unsigned)b) << 16); }
__device__ __forceinline__ unsigned pack_bf2(float lo, float hi) { return (unsigned)f2bf(lo) | ((unsigned)f2bf(hi) << 16); }
__device__ __forceinline__ float sigmoidf_(float x) { return __builtin_amdgcn_rcpf(1.0f + __builtin_amdgcn_exp2f(-1.4426950408889634f * x)); }
__device__ __forceinline__ int posidx_of_row(int r) { return (r < TP) ? (r & 4095) : ((r < T) ? (4096 + ((r - TP) & 3)) : 0); }
}
namespace pg8 {
#define PG8_LAS __attribute__((address_space(3)))
typedef unsigned short bf16_t;
typedef short bf16x8 __attribute__((ext_vector_type(8)));
typedef float f32x4 __attribute__((ext_vector_type(4)));
typedef unsigned u32x4 __attribute__((ext_vector_type(4)));
constexpr int BM = 256, BK = 64, HALF = 128, HTB = HALF * BK * 2  , STAGE_BYTES = 8 * HTB, NXCD = 8, WGM = 8;

__host__ __device__ __forceinline__ int lds_byte(int r, int c) { const int st = (r >> 4) * 2 + (c >> 5), rr = r & 15, cc = c & 31, ob = rr * 64 + cc * 2; return st * 1024 + (ob ^ (((ob >> 9) & 1) << 5)); }
__host__ __device__ __forceinline__ void stage_rc(int b, int& R, int& C) { const int st = b / 1024, sb = b % 1024, swz = sb ^ (((sb >> 9) & 1) << 5); R = (st >> 1) * 16 + swz / 64; C = (st & 1) * 32 + (swz % 64) / 2; }
__host__ __device__ __forceinline__ int perm32(int rho) { const int n = rho >> 4, i = rho & 15; return 8 * (i >> 2) + 4 * n + (i & 3); }

struct Unit { int pm, pn; };
struct Gemm { const bf16_t* A; const bf16_t* Bt; int M, N, K; };

struct StaticOrder {
    int nM, nN, nwg, G, c;
    __host__ __device__ void init(int M, int N, int G_, int c_) { nM = M / BM; nN = N / BM; nwg = nM * nN; G = G_; c = c_; }
    __host__ __device__ bool next(int i, Unit& u) const {
        const long L = (long)i * G + c; if (L >= nwg) return false;
        int wgid = (int)L; { const int q = nwg / NXCD, r = nwg % NXCD, xcd = wgid % NXCD, off = wgid / NXCD; wgid = (xcd < r ? xcd * (q + 1) : r * (q + 1) + (xcd - r) * q) + off; }
        const int nig = WGM * nN, gid = wgid / nig, fm = gid * WGM, gsz = (nM - fm) < WGM ? (nM - fm) : WGM;
        u.pm = fm + ((wgid % nig) % gsz); u.pn = (wgid % nig) / gsz; return true;
    }
    __device__ __forceinline__ void a_ready(const Unit&) const {}
    __device__ __forceinline__ void done(const Unit&) const {}
};
__device__ __forceinline__ unsigned cvt_pk_bf16(float lo, float hi) { unsigned r; asm volatile("v_cvt_pk_bf16_f32 %0, %1, %2" : "=v"(r) : "v"(lo), "v"(hi)); return r; }
template <class Epi, class Sched, bool STAMP = false>
__device__ __forceinline__ void gemm_phase(PG8_LAS unsigned char* lds, const Gemm g, const Sched& S, const Epi& E, unsigned long long* stamps) {
    int tid_raw = threadIdx.x; asm volatile("" : "+v"(tid_raw));
    const int tid = tid_raw, wid = __builtin_amdgcn_readfirstlane(tid >> 6), lane = tid & 63, wr = wid >> 2, wc = wid & 3, fr = lane & 15, fq = lane >> 4;
    const int K = g.K, nt = K / BK;
    int ts_lo = 0, ts_hi = 0, nts = 0; const unsigned long long rt_entry = STAMP ? (unsigned long long)wall_clock64() : 0ull;
#define PG8_STAMP() do { if (STAMP && wid == 0 && nts < 64) { const unsigned long long _c = (unsigned long long)clock64(); \
        ts_lo = (lane == nts) ? (int)(unsigned)_c : ts_lo; ts_hi = (lane == nts) ? (int)(unsigned)(_c >> 32) : ts_hi; ++nts; } } while (0)
    PG8_STAMP();
    unsigned voffA[2], voffB[2];
#pragma unroll
    for (int i = 0; i < 2; ++i) { int R, C; stage_rc(tid * 16 + i * 8192, R, C); const int Rb = Epi::PERM ? ((R & ~31) + perm32(R & 31)) : R;
        voffA[i] = (unsigned)(R * K + C) * 2u; voffB[i] = (unsigned)(Rb * K + C) * 2u; }
    const size_t kstep = (size_t)(BK * 2);
    const size_t hstep = (size_t)HALF * K * 2;
    const size_t tstep = 2 * hstep;
    const unsigned ldsw = (unsigned)wid * 1024u;
    const int aoff = lds_byte(wr * 64 + fr, fq * 8), boff = lds_byte(wc * 32 + fr, fq * 8);
#define PG8_SA(b, h) (((b) * 2 + (h)) * HTB)
#define PG8_SB(b, h) ((4 + (b) * 2 + (h)) * HTB)
#define PG8_STAGE(bufoff, gbase, voff) do { _Pragma("unroll") for (int _i = 0; _i < 2; ++_i) \
        __builtin_amdgcn_global_load_lds((const unsigned*)((const char*)(gbase) + (voff)[_i]), (PG8_LAS unsigned*)(lds + (bufoff) + ldsw + _i * 8192), 16, 0, 0); } while (0)
#define PG8_LDA(dst, b, h) do { _Pragma("unroll") for (int m = 0; m < 4; ++m) _Pragma("unroll") for (int k = 0; k < 2; ++k) dst[m][k] = *(const PG8_LAS bf16x8*)(lds + PG8_SA(b, h) + aoff + m * 2048 + k * 1024); } while (0)
#define PG8_LDB(dst, b, h) do { _Pragma("unroll") for (int n = 0; n < 2; ++n) _Pragma("unroll") for (int k = 0; k < 2; ++k) dst[n][k] = *(const PG8_LAS bf16x8*)(lds + PG8_SB(b, h) + boff + n * 2048 + k * 1024); } while (0)
#define PG8_MMA(ai, bj, At, Bt) do { __builtin_amdgcn_s_setprio(1); _Pragma("unroll") for (int m = 0; m < 4; ++m) _Pragma("unroll") for (int n = 0; n < 2; ++n) _Pragma("unroll") for (int k = 0; k < 2; ++k) \
        acc[ai][bj][m][n] = __builtin_amdgcn_mfma_f32_16x16x32_bf16(Bt[n][k], At[m][k], acc[ai][bj][m][n], 0, 0, 0); __builtin_amdgcn_s_setprio(0); } while (0)
#define PG8_WAIT_V(n) asm volatile("s_waitcnt vmcnt(" #n ")" ::: "memory")
#define PG8_WAIT_L(n) asm volatile("s_waitcnt lgkmcnt(" #n ")" ::: "memory")
#define PG8_BAR __builtin_amdgcn_s_barrier()
#define PG8_SCHED __builtin_amdgcn_sched_barrier(0)
    Unit cur, nxt; int ui = 0;
    if (!S.next(0, cur)) return;
    f32x4 acc[2][2][4][2];
#pragma unroll
    for (int a = 0; a < 2; ++a)
#pragma unroll
        for (int b = 0; b < 2; ++b)
#pragma unroll
            for (int m = 0; m < 4; ++m)
#pragma unroll
                for (int n = 0; n < 2; ++n) acc[a][b][m][n] = (f32x4){0.f, 0.f, 0.f, 0.f};
    bf16x8 At[4][2], B0[2][2], B1[2][2];
    const char* cA = (const char*)g.A + (size_t)cur.pm * tstep; const char* cB = (const char*)g.Bt + (size_t)cur.pn * tstep;
    S.a_ready(cur);
    PG8_STAGE(PG8_SB(0, 0), cB, voffB); PG8_STAGE(PG8_SA(0, 0), cA, voffA); PG8_STAGE(PG8_SB(0, 1), cB + hstep, voffB); PG8_STAGE(PG8_SA(0, 1), cA + hstep, voffA);
    if (wr == 1) PG8_BAR;
    PG8_WAIT_V(4); PG8_BAR;
    PG8_STAGE(PG8_SB(1, 0), cB + kstep, voffB); PG8_STAGE(PG8_SA(1, 0), cA + kstep, voffA); PG8_STAGE(PG8_SB(1, 1), cB + hstep + kstep, voffB);
    PG8_WAIT_V(6); PG8_BAR;
    PG8_STAMP();
    for (;;) {
        const bool has_next = S.next(ui + 1, nxt);
        const char* nA = has_next ? (const char*)g.A + (size_t)nxt.pm * tstep : cA; const char* nB = has_next ? (const char*)g.Bt + (size_t)nxt.pn * tstep : cB;
        for (int t = 0; t < nt; t += 2) {
            const bool last = (t == nt - 2);
            const char* a1 = cA + (size_t)(t + 1) * kstep;
            const char* a2 = last ? nA : cA + (size_t)(t + 2) * kstep; const char* b2 = last ? nB : cB + (size_t)(t + 2) * kstep;
            const char* a3 = a2 + kstep; const char* b3 = b2 + kstep;
            if (last && has_next) S.a_ready(nxt);
            PG8_LDB(B0, 0, 0); PG8_SCHED; PG8_LDA(At, 0, 0); PG8_STAGE(PG8_SA(1, 1), a1 + hstep, voffA);
            PG8_WAIT_L(8); PG8_BAR; PG8_WAIT_L(0); PG8_MMA(0, 0, At, B0); PG8_BAR; PG8_SCHED;
            PG8_LDB(B1, 0, 1); PG8_STAGE(PG8_SB(0, 0), b2, voffB);
            PG8_BAR; PG8_WAIT_L(0); PG8_MMA(0, 1, At, B1); PG8_BAR;
            PG8_LDA(At, 0, 1); PG8_STAGE(PG8_SA(0, 0), a2, voffA);
            PG8_BAR; PG8_WAIT_L(0); PG8_MMA(1, 0, At, B0); PG8_BAR; PG8_SCHED;
            PG8_STAGE(PG8_SB(0, 1), b2 + hstep, voffB);
            PG8_WAIT_V(6); PG8_BAR; PG8_MMA(1, 1, At, B1); PG8_BAR;
            PG8_LDB(B0, 1, 0); PG8_SCHED; PG8_LDA(At, 1, 0); PG8_STAGE(PG8_SA(0, 1), a2 + hstep, voffA);
            PG8_WAIT_L(8); PG8_BAR; PG8_WAIT_L(0); PG8_MMA(0, 0, At, B0); PG8_BAR; PG8_SCHED;
            PG8_LDB(B1, 1, 1); PG8_STAGE(PG8_SB(1, 0), b3, voffB);
            PG8_BAR; PG8_WAIT_L(0); PG8_MMA(0, 1, At, B1); PG8_BAR;
            PG8_LDA(At, 1, 1); PG8_STAGE(PG8_SA(1, 0), a3, voffA);
            PG8_BAR; PG8_WAIT_L(0); PG8_MMA(1, 0, At, B0); PG8_BAR; PG8_SCHED;
            PG8_STAGE(PG8_SB(1, 1), b3 + hstep, voffB);
            PG8_WAIT_V(6); PG8_BAR; PG8_MMA(1, 1, At, B1); PG8_BAR;
        }
        PG8_STAMP();
        if constexpr (!Epi::AFTER_DRAIN) { E(acc, cur, wr, wc, fr, fq); S.done(cur); }
        PG8_STAMP();
        if (!has_next) break;
#pragma unroll
        for (int a = 0; a < 2; ++a)
#pragma unroll
            for (int b = 0; b < 2; ++b)
#pragma unroll
                for (int m = 0; m < 4; ++m)
#pragma unroll
                    for (int n = 0; n < 2; ++n) acc[a][b][m][n] = (f32x4){0.f, 0.f, 0.f, 0.f};
        cur = nxt; cA = nA; cB = nB; ++ui;
    }
    PG8_WAIT_V(0);
    if (wr == 0) PG8_BAR;
    PG8_BAR;
    if constexpr (Epi::AFTER_DRAIN) { E.fused(acc, cur, wr, wc, fr, fq, lds, wid, lane); S.done(cur); }
    PG8_STAMP();
    if (STAMP && wid == 0) { stamps[lane] = lane < nts ? (((unsigned long long)(unsigned)ts_hi << 32) | (unsigned)ts_lo) : 0ull;
        if (lane == 62) stamps[62] = rt_entry; if (lane == 63) stamps[63] = (unsigned long long)wall_clock64(); }
#undef PG8_STAMP
#undef PG8_SA
#undef PG8_SB
#undef PG8_STAGE
#undef PG8_LDA
#undef PG8_LDB
#undef PG8_MMA
#undef PG8_WAIT_V
#undef PG8_WAIT_L
#undef PG8_BAR
#undef PG8_SCHED
}
}
#define XB_TMO      128
#define XB_XCNT(j)  (256  + 64 * (j))
#define XB_XSUB(j)  (1280 + 64 * (j))
#define XB_XGEN(j)  (2304 + 64 * (j))
#define XB_TOP      3328
#define XB_TOPGEN   3392
#define XCD_BAR_WORDS 3456
#define XB_SPIN_CAP (1u << 18)
#define LAS __attribute__((address_space(3)))

__device__ __forceinline__ unsigned xb_ld(unsigned* p)              { return __hip_atomic_load(p, __ATOMIC_RELAXED, __HIP_MEMORY_SCOPE_AGENT); }
__device__ __forceinline__ unsigned xb_add(unsigned* p, unsigned v) { return __hip_atomic_fetch_add(p, v, __ATOMIC_RELAXED, __HIP_MEMORY_SCOPE_AGENT); }
__device__ __forceinline__ unsigned xb_xcc_id() { return (unsigned)__builtin_amdgcn_s_getreg((3 << 11) | 20) & 0xFu; }
#define XB_SPIN(cond, bar) do { unsigned _sp = 0; while (cond) { __builtin_amdgcn_s_sleep(1); \
    if ((++_sp & 255u) == 0u) { if (xb_ld(&(bar)[XB_TMO])) break; if (_sp > XB_SPIN_CAP) { atomicAdd(&(bar)[XB_TMO], 1u); break; } } } } while (0)

struct XcdBarrier {
    unsigned* bar; unsigned x;
    volatile LAS unsigned* st;
};

__device__ __forceinline__ XcdBarrier xcd_barrier_post(unsigned* bar, volatile LAS unsigned* st) {
    XcdBarrier b; b.bar = bar; b.x = xb_xcc_id(); b.st = st;
    if (threadIdx.x == 0) (void)xb_add(&bar[XB_XCNT(b.x)], 1u);
    return b;
}
__device__ __forceinline__ void xcd_barrier_complete(unsigned* bar, unsigned x, unsigned& nloc, unsigned& nx) {
    const unsigned G = gridDim.x * gridDim.y * gridDim.z;
    unsigned sum, cnt, mine, sp = 0u;
    for (;;) {
        sum = 0u; cnt = 0u; mine = 0u;
#pragma unroll
        for (unsigned j = 0; j < 16; ++j) { const unsigned c = xb_ld(&bar[XB_XCNT(j)]); sum += c; cnt += (c > 0u) ? 1u : 0u; mine = (j == x) ? c : mine; }
        if (sum == G) break;
        __builtin_amdgcn_s_sleep(1);
        if ((++sp & 255u) == 0u) { if (xb_ld(&bar[XB_TMO])) break; if (sp > XB_SPIN_CAP) { atomicAdd(&bar[XB_TMO], 1u); break; } }
    }
    nloc = mine > 0u ? mine : 1u; nx = cnt > 0u ? cnt : 1u;
}

__device__ __forceinline__ void xcd_barrier(const XcdBarrier& b) {
    asm volatile("s_waitcnt vmcnt(0)" ::: "memory");
    __syncthreads();
    if (threadIdx.x == 0) {
        unsigned* bar = b.bar;
        __builtin_amdgcn_s_waitcnt(0);
        unsigned nloc = b.st[0], nx = b.st[1];
        if (nloc == 0u) { xcd_barrier_complete(bar, b.x, nloc, nx); b.st[0] = nloc; b.st[1] = nx; }
        const unsigned old = xb_add(&bar[XB_XSUB(b.x)], 1u);
        const unsigned gen = old / nloc;
        if (old + 1u == (gen + 1u) * nloc) {
            __builtin_amdgcn_fence(__ATOMIC_RELEASE, "agent");
            asm volatile("s_waitcnt vmcnt(0)" ::: "memory");
            const unsigned og = xb_add(&bar[XB_TOP], 1u);
            const unsigned tg = og / nx;
            if (og + 1u == (tg + 1u) * nx) xb_add(&bar[XB_TOPGEN], 1u);
            else XB_SPIN(xb_ld(&bar[XB_TOPGEN]) == tg, bar);
            __builtin_amdgcn_fence(__ATOMIC_ACQUIRE, "agent");
            xb_add(&bar[XB_XGEN(b.x)], 1u);
            asm volatile("s_waitcnt vmcnt(0)" ::: "memory");
        } else {
            XB_SPIN(xb_ld(&bar[XB_XGEN(b.x)]) == gen, bar);
            __builtin_amdgcn_fence(__ATOMIC_ACQUIRE, "agent");
            asm volatile("s_waitcnt vmcnt(0)" ::: "memory");
        }
    }
    __syncthreads();
}
namespace mk {
using pg8::f32x4;
using pg8::Unit;
using pg8::cvt_pk_bf16;
using pg8::u32x4;
typedef unsigned u32x2 __attribute__((ext_vector_type(2)));
typedef unsigned u32x6 __attribute__((ext_vector_type(6)));
typedef float f32x16 __attribute__((ext_vector_type(16)));
typedef _Float16 h16x4 __attribute__((ext_vector_type(4)));

__device__ __forceinline__ int opaque(int x) { asm volatile("" : "+v"(x)); return x; }
struct Params {
    const float *x_prompt, *x_sample, *cache_k, *cache_v, *cache_kidx, *state_ret;
    const int* page_table;
    const float *p_prompt, *p_sample, *w_in, *idx_k_g, *idx_k_b, *gn_g, *gn_b, *w_ret_o, *w_att_o, *w_out, *ln1_g, *ln1_b, *peer_wq,
        *peer_subkeys, *peer_u, *peer_v, *w_ple_gate, *w_ple, *ln2_g, *ln2_b;
    float *y_prompt, *y_sample, *k_prompt, *v_prompt, *kidx_prompt, *ret_prompt, *k_sample, *v_sample, *kidx_sample, *ret_sample;
    unsigned* bar;
    bf16_t *XB, *PB, *WinT, *WretT, *WattT, *WoutT, *WqgT, *WpleT;
    float *c256, *s256, *c128, *s128, *c64, *s64;
    bf16_t *RQ, *RK, *RV, *SG, *AQ, *AK, *AV, *GA, *GB;
    f16_t *IQ, *IK;
    float* IW;
    float* RO;
    bf16_t* SC;
    bf16_t *RETO, *ATTO;
    bf16_t* BRP;
    bf16_t* BR;
    bf16_t* VPRE;
    float* X1;
    bf16_t *X1B, *QP;
    float* PE;
    bf16_t* PLE;
    bf16_t* SUBK;
    unsigned char *U8, *V8;
    int* EIDX;
    float* GW;
    float *SCO, *SS;
};

__device__ __forceinline__ void store4_bf16(bf16_t* dst, const f32x4 v) {
    u32x2 w; w.x = cvt_pk_bf16(v[0], v[1]); w.y = cvt_pk_bf16(v[2], v[3]);
    *(u32x2*)dst = w;
}
__device__ __forceinline__ void store4_f16(f16_t* dst, const f32x4 v) {
    h16x4 h; h[0] = (_Float16)v[0]; h[1] = (_Float16)v[1]; h[2] = (_Float16)v[2]; h[3] = (_Float16)v[3];
    *(h16x4*)dst = h;
}
__device__ __forceinline__ f32x4 load4_bf16(const bf16_t* src) {
    const u32x2 g = *(const u32x2*)src;
    f32x4 r; r[0] = __uint_as_float(g.x << 16); r[1] = __uint_as_float(g.x & 0xffff0000u); r[2] = __uint_as_float(g.y << 16); r[3] = __uint_as_float(g.y & 0xffff0000u);
    return r;
}
__device__ __forceinline__ f32x4 sigmoid4(const f32x4 v) {
    f32x4 r; r[0] = sigmoidf_(v[0]); r[1] = sigmoidf_(v[1]); r[2] = sigmoidf_(v[2]); r[3] = sigmoidf_(v[3]); return r;
}

__device__ __forceinline__ int win_orig(int j) {
    const int pn = j >> 8, jj = j & 255, bj = jj >> 7, w = jj & 127;
    if (pn < 24) return j;
    if (pn < 28) { const int t = pn - 24, hh = w >> 6, i = w & 63; return C_AQ + (2 * t + hh) * 128 + bj * 64 + i; }
    if (pn == 28) { const int hh = w >> 6, i = w & 63; return C_AK + hh * 128 + bj * 64 + i; }
    if (pn == 29) return C_AV + jj;
    if (pn < 32) { const int t = pn - 30, hh = w >> 5, i = w & 31; return C_IQ + (4 * t + hh) * 64 + bj * 32 + i; }
    if (pn < 36) return C_GA + (pn - 32) * 256 + jj;
    if (pn < 40) return C_GB + (pn - 36) * 256 + jj;
    if (w < 32) return C_IK + bj * 32 + w;
    if (bj == 0 && w < 40) return C_IW + (w - 32);
    return -1;
}

__device__ __forceinline__ f32x4 rope_irev(int i0, float l2theta_over_half) {
    f32x4 r;
#pragma unroll
    for (int e = 0; e < 4; ++e) r[e] = __builtin_amdgcn_exp2f(-(float)(i0 + e) * l2theta_over_half) * 0.15915494309189535f;
    return r;
}
__device__ __forceinline__ void rope_cs(float posf, const f32x4 irev, f32x4& c, f32x4& s) {
#pragma unroll
    for (int e = 0; e < 4; ++e) {
        const float hi = posf * irev[e], lo = __builtin_fmaf(posf, irev[e], -hi);
        const float fr = __builtin_amdgcn_fractf(hi) + lo;
        c[e] = __builtin_amdgcn_cosf(fr); s[e] = __builtin_amdgcn_sinf(fr);
    }
}
__device__ __forceinline__ float posf_of_row(int r) { return (float)((r < TP) ? (r & 4095) : ((r < T) ? (16384 + ((r - TP) & 3)) : 0)); }
struct EpiIn {
    static constexpr bool PERM = false, AFTER_DRAIN = false;
    const Params& p;
    __device__ __forceinline__ void operator()(const f32x4 (&acc)[2][2][4][2], const Unit& u, int wr, int wc, int fr_in, int fq_in) const {
        int fr = fr_in, fq = fq_in; asm volatile("" : "+v"(fr), "+v"(fq));
        const int pn = u.pn;
        const int rbase = u.pm * 256 + wr * 64 + fr;
        const int wbase = wc * 32 + fq * 4;
        if (pn < 8) {
            const bool isk = pn >= 4; const int h = pn & 3; bf16_t* dst = isk ? p.RK : p.RQ; const float sc = isk ? 0.0625f : 1.0f;
#pragma unroll
            for (int ai = 0; ai < 2; ++ai)
#pragma unroll
                for (int m = 0; m < 4; ++m) {
                    const int r = rbase + ai * 128 + m * 16; const float posf = posf_of_row(r);
#pragma unroll
                    for (int n = 0; n < 2; ++n) {
                        const int w0 = wbase + 16 * n;
                        f32x4 c, s; rope_cs(posf, rope_irev(w0, 0.10381025296523008f), c, s);
                        const f32x4 x1 = acc[ai][0][m][n], x2 = acc[ai][1][m][n];
                        store4_bf16(dst + (size_t)r * 1024 + h * 256 + w0, (x1 * c - x2 * s) * sc);
                        store4_bf16(dst + (size_t)r * 1024 + h * 256 + 128 + w0, (x2 * c + x1 * s) * sc);
                    }
                }
        } else if (pn < 24) {
            const bool isg = pn >= 16; bf16_t* dst = isg ? p.SG : p.RV; const int cb = (isg ? pn - 16 : pn - 8) * 256;
#pragma unroll
            for (int ai = 0; ai < 2; ++ai)
#pragma unroll
                for (int m = 0; m < 4; ++m) {
                    const int r = rbase + ai * 128 + m * 16;
#pragma unroll
                    for (int bj = 0; bj < 2; ++bj)
#pragma unroll
                        for (int n = 0; n < 2; ++n) {
                            f32x4 v = acc[ai][bj][m][n];
                            if (isg) v = v * sigmoid4(v);
                            store4_bf16(dst + (size_t)r * 2048 + cb + bj * 128 + wbase + 16 * n, v);
                        }
                }
        } else if (pn < 29) {
            const bool isk = pn == 28; const int t = isk ? 0 : pn - 24; const float sc = isk ? 1.0f : 0.08838834764831845f;
#pragma unroll
            for (int ai = 0; ai < 2; ++ai)
#pragma unroll
                for (int m = 0; m < 4; ++m) {
                    const int r = rbase + ai * 128 + m * 16; const float posf = posf_of_row(r);
#pragma unroll
                    for (int n = 0; n < 2; ++n) {
                        const int w0 = wbase + 16 * n, hh = w0 >> 6, i0 = w0 & 63;
                        f32x4 c, s; rope_cs(posf, rope_irev(i0, 0.20762050593046015f), c, s);
                        const f32x4 x1 = acc[ai][0][m][n], x2 = acc[ai][1][m][n];
                        const f32x4 o1 = (x1 * c - x2 * s) * sc, o2 = (x2 * c + x1 * s) * sc;
                        if (!isk) {
                            bf16_t* d = p.AQ + (size_t)r * 1024 + (2 * t + hh) * 128 + i0;
                            store4_bf16(d, o1); store4_bf16(d + 64, o2);
                        } else {
                            bf16_t* d = p.AK + (size_t)r * 256 + hh * 128 + i0;
                            store4_bf16(d, o1); store4_bf16(d + 64, o2);
                            if (r < T) {
                                float* o = (r < TP) ? (p.k_prompt + (size_t)r * 256) : (p.k_sample + (size_t)(r - TP) * 256);
                                *(f32x4*)(o + hh * 128 + i0) = o1; *(f32x4*)(o + hh * 128 + 64 + i0) = o2;
                            }
                        }
                    }
                }
        } else if (pn == 29) {
#pragma unroll
            for (int ai = 0; ai < 2; ++ai)
#pragma unroll
                for (int m = 0; m < 4; ++m) {
                    const int r = rbase + ai * 128 + m * 16;
                    float* o = (r < TP) ? (p.v_prompt + (size_t)r * 256) : (p.v_sample + (size_t)(r - TP) * 256);
#pragma unroll
                    for (int bj = 0; bj < 2; ++bj)
#pragma unroll
                        for (int n = 0; n < 2; ++n) {
                            const int c = bj * 128 + wbase + 16 * n;
                            store4_bf16(p.AV + (size_t)r * 256 + c, acc[ai][bj][m][n]);
                            if (r < T) *(f32x4*)(o + c) = acc[ai][bj][m][n];
                        }
                }
        } else if (pn < 32) {
            const int t = pn - 30;
#pragma unroll
            for (int ai = 0; ai < 2; ++ai)
#pragma unroll
                for (int m = 0; m < 4; ++m) {
                    const int r = rbase + ai * 128 + m * 16; const float posf = posf_of_row(r);
#pragma unroll
                    for (int n = 0; n < 2; ++n) {
                        const int w0 = wbase + 16 * n, hh = w0 >> 5, i0 = w0 & 31;
                        f32x4 c, s; rope_cs(posf, rope_irev(i0, 0.4152410118609203f), c, s);
                        const f32x4 x1 = acc[ai][0][m][n], x2 = acc[ai][1][m][n];
                        f16_t* d = p.IQ + (size_t)r * 512 + (4 * t + hh) * 64 + i0;
                        store4_f16(d, x1 * c - x2 * s); store4_f16(d + 32, x2 * c + x1 * s);
                    }
                }
        } else if (pn < 40) {
            const bool isb = pn >= 36; bf16_t* dst = isb ? p.GB : p.GA; const int cb = (isb ? pn - 36 : pn - 32) * 256;
#pragma unroll
            for (int ai = 0; ai < 2; ++ai)
#pragma unroll
                for (int m = 0; m < 4; ++m) {
                    const int r = rbase + ai * 128 + m * 16;
#pragma unroll
                    for (int bj = 0; bj < 2; ++bj)
#pragma unroll
                        for (int n = 0; n < 2; ++n)
                            store4_bf16(dst + (size_t)r * 1024 + cb + bj * 128 + wbase + 16 * n, sigmoid4(acc[ai][bj][m][n]));
                }
        } else {
            if (wc == 0) {
#pragma unroll
                for (int ai = 0; ai < 2; ++ai)
#pragma unroll
                    for (int m = 0; m < 4; ++m) {
                        const int r = rbase + ai * 128 + m * 16; const int pi = posidx_of_row(r);
                        float s = 0.f;
#pragma unroll
                        for (int bj = 0; bj < 2; ++bj)
#pragma unroll
                            for (int n = 0; n < 2; ++n) { const f32x4 x = acc[ai][bj][m][n]; s += (x[0] + x[1]) + (x[2] + x[3]); }
                        s += __shfl_xor(s, 16); s += __shfl_xor(s, 32);
                        const float mean = s * (1.0f / 64.0f);
                        float q = 0.f;
#pragma unroll
                        for (int bj = 0; bj < 2; ++bj)
#pragma unroll
                            for (int n = 0; n < 2; ++n) { const f32x4 d = acc[ai][bj][m][n] - mean; q += (d[0] * d[0] + d[1] * d[1]) + (d[2] * d[2] + d[3] * d[3]); }
                        q += __shfl_xor(q, 16); q += __shfl_xor(q, 32);
                        const float rstd = rsqrtf(q * (1.0f / 64.0f) + LN_EPS);
                        float* ko = (r < TP) ? (p.kidx_prompt + (size_t)r * 64) : (p.kidx_sample + (size_t)(r - TP) * 64);
#pragma unroll
                        for (int n = 0; n < 2; ++n) {
                            const int w0 = wbase + 16 * n;
                            const f32x4 g1 = *(const f32x4*)(p.idx_k_g + w0), g2 = *(const f32x4*)(p.idx_k_g + 32 + w0);
                            const f32x4 b1 = *(const f32x4*)(p.idx_k_b + w0), b2 = *(const f32x4*)(p.idx_k_b + 32 + w0);
                            const f32x4 x1 = (acc[ai][0][m][n] - mean) * rstd * g1 + b1, x2 = (acc[ai][1][m][n] - mean) * rstd * g2 + b2;
                            f32x4 c, sn; rope_cs(posf_of_row(r), rope_irev(w0, 0.4152410118609203f), c, sn);
                            const f32x4 o1 = x1 * c - x2 * sn, o2 = x2 * c + x1 * sn;
                            store4_f16(p.IK + (size_t)r * 64 + w0, o1); store4_f16(p.IK + (size_t)r * 64 + 32 + w0, o2);
                            if (r < T) { *(f32x4*)(ko + w0) = o1; *(f32x4*)(ko + 32 + w0) = o2; }
                        }
                    }
            } else if (wc == 1 && fq < 2) {
#pragma unroll
                for (int ai = 0; ai < 2; ++ai)
#pragma unroll
                    for (int m = 0; m < 4; ++m) {
                        const int r = rbase + ai * 128 + m * 16;
                        *(f32x4*)(p.IW + (size_t)r * 8 + 4 * fq) = acc[ai][0][m][0] * (0.35355339059327373f * 0.125f);
                    }
            }
        }
    }
};

struct EpiBr1 {
    static constexpr bool PERM = false, AFTER_DRAIN = false;
    const bf16_t* G; bf16_t* O;
    __device__ __forceinline__ void operator()(const f32x4 (&acc)[2][2][4][2], const Unit& u, int wr, int wc, int fr_in, int fq_in) const {
        int fr = fr_in, fq = fq_in; asm volatile("" : "+v"(fr), "+v"(fq));
        const int rbase = u.pm * 256 + wr * 64 + fr, cbase = u.pn * 256 + wc * 32 + fq * 4;
#pragma unroll
        for (int ai = 0; ai < 2; ++ai) {
            u32x2 gv[4][2][2];
#pragma unroll
            for (int m = 0; m < 4; ++m)
#pragma unroll
                for (int bj = 0; bj < 2; ++bj)
#pragma unroll
                    for (int n = 0; n < 2; ++n) gv[m][bj][n] = *(const u32x2*)(G + (size_t)(rbase + ai * 128 + m * 16) * 1024 + cbase + bj * 128 + 16 * n);
            asm volatile("" ::: "memory");
#pragma unroll
            for (int m = 0; m < 4; ++m)
#pragma unroll
                for (int bj = 0; bj < 2; ++bj)
#pragma unroll
                    for (int n = 0; n < 2; ++n) {
                        const u32x2 g = gv[m][bj][n];
                        f32x4 gf; gf[0] = __uint_as_float(g.x << 16); gf[1] = __uint_as_float(g.x & 0xffff0000u); gf[2] = __uint_as_float(g.y << 16); gf[3] = __uint_as_float(g.y & 0xffff0000u);
                        store4_bf16(O + (size_t)(rbase + ai * 128 + m * 16) * 1024 + cbase + bj * 128 + 16 * n, gf * acc[ai][bj][m][n]);
                    }
            asm volatile("" ::: "memory");
        }
    }
};
struct EpiBr2 {
    static constexpr bool PERM = false, AFTER_DRAIN = false;
    const bf16_t* G; const bf16_t* I; bf16_t* O;
    __device__ __forceinline__ void operator()(const f32x4 (&acc)[2][2][4][2], const Unit& u, int wr, int wc, int fr_in, int fq_in) const {
        int fr = fr_in, fq = fq_in; asm volatile("" : "+v"(fr), "+v"(fq));
        const int rbase = u.pm * 256 + wr * 64 + fr, cbase = u.pn * 256 + wc * 32 + fq * 4;
#pragma unroll
        for (int ai = 0; ai < 2; ++ai)
#pragma unroll
            for (int mh = 0; mh < 2; ++mh) {
                u32x2 gv[2][2][2]; f32x4 iv[2][2][2];
#pragma unroll
                for (int m2 = 0; m2 < 2; ++m2)
#pragma unroll
                    for (int bj = 0; bj < 2; ++bj)
#pragma unroll
                        for (int n = 0; n < 2; ++n) {
                            const size_t o = (size_t)(rbase + ai * 128 + (2 * mh + m2) * 16) * 1024 + cbase + bj * 128 + 16 * n;
                            gv[m2][bj][n] = *(const u32x2*)(G + o); iv[m2][bj][n] = load4_bf16(I + o);
                        }
                asm volatile("" ::: "memory");
#pragma unroll
                for (int m2 = 0; m2 < 2; ++m2)
#pragma unroll
                    for (int bj = 0; bj < 2; ++bj)
#pragma unroll
                        for (int n = 0; n < 2; ++n) {
                            const size_t o = (size_t)(rbase + ai * 128 + (2 * mh + m2) * 16) * 1024 + cbase + bj * 128 + 16 * n;
                            const u32x2 g = gv[m2][bj][n];
                            f32x4 gf; gf[0] = __uint_as_float(g.x << 16); gf[1] = __uint_as_float(g.x & 0xffff0000u); gf[2] = __uint_as_float(g.y << 16); gf[3] = __uint_as_float(g.y & 0xffff0000u);
                            store4_bf16(O + o, iv[m2][bj][n] + gf * acc[ai][2 * 0 + bj][2 * mh + m2][n]);
                        }
                asm volatile("" ::: "memory");
            }
    }
};
struct EpiF32 {
    static constexpr bool PERM = false, AFTER_DRAIN = false;
    bf16_t* O; int ldc;
    __device__ __forceinline__ void operator()(const f32x4 (&acc)[2][2][4][2], const Unit& u, int wr, int wc, int fr_in, int fq_in) const {
        int fr = fr_in, fq = fq_in; asm volatile("" : "+v"(fr), "+v"(fq));
        const int rbase = u.pm * 256 + wr * 64 + fr, cbase = u.pn * 256 + wc * 32 + fq * 4;
#pragma unroll
        for (int ai = 0; ai < 2; ++ai)
#pragma unroll
            for (int m = 0; m < 4; ++m) {
                const size_t ro = (size_t)(rbase + ai * 128 + m * 16) * ldc;
#pragma unroll
                for (int bj = 0; bj < 2; ++bj)
#pragma unroll
                    for (int n = 0; n < 2; ++n) store4_bf16(O + ro + cbase + bj * 128 + 16 * n, acc[ai][bj][m][n]);
                asm volatile("" ::: "memory");
            }
    }
};
struct EpiOutV {
    static constexpr bool PERM = false, AFTER_DRAIN = false;
    const float *xp, *xs; bf16_t* O;
    __device__ __forceinline__ void operator()(const f32x4 (&acc)[2][2][4][2], const Unit& u, int wr, int wc, int fr_in, int fq_in) const {
        int fr = fr_in, fq = fq_in; asm volatile("" : "+v"(fr), "+v"(fq));
        const int rbase = u.pm * 256 + wr * 64 + fr, cbase = u.pn * 256 + wc * 32 + fq * 4;
#pragma unroll
        for (int ai = 0; ai < 2; ++ai)
#pragma unroll
            for (int mh = 0; mh < 2; ++mh) {
                f32x4 xv[2][2][2];
#pragma unroll
                for (int m2 = 0; m2 < 2; ++m2)
#pragma unroll
                    for (int bj = 0; bj < 2; ++bj)
#pragma unroll
                        for (int n = 0; n < 2; ++n) {
                            const int r = rbase + ai * 128 + (2 * mh + m2) * 16;
                            xv[m2][bj][n] = (r < TP) ? *(const f32x4*)(xp + (size_t)r * 1024 + cbase + bj * 128 + 16 * n) : (f32x4){0.f, 0.f, 0.f, 0.f};
                        }
                asm volatile("" ::: "memory");
#pragma unroll
                for (int m2 = 0; m2 < 2; ++m2)
#pragma unroll
                    for (int bj = 0; bj < 2; ++bj)
#pragma unroll
                        for (int n = 0; n < 2; ++n) {
                            const int r = rbase + ai * 128 + (2 * mh + m2) * 16;
                            store4_bf16(O + (size_t)r * 1024 + cbase + bj * 128 + 16 * n, xv[m2][bj][n] * ALPHA + acc[ai][bj][2 * mh + m2][n]);
                        }
                asm volatile("" ::: "memory");
            }
    }
};
struct EpiQG {
    static constexpr bool PERM = false, AFTER_DRAIN = false;
    bf16_t* QP; const bf16_t* PE; bf16_t* PLE;
    __device__ __forceinline__ void operator()(const f32x4 (&acc)[2][2][4][2], const Unit& u, int wr, int wc, int fr_in, int fq_in) const {
        int fr = fr_in, fq = fq_in; asm volatile("" : "+v"(fr), "+v"(fq));
        const int rbase = u.pm * 256 + wr * 64 + fr, cbase = u.pn * 256 + wc * 32 + fq * 4;
        if (u.pn < 8) {
#pragma unroll
            for (int ai = 0; ai < 2; ++ai)
#pragma unroll
                for (int m = 0; m < 4; ++m) {
                    const int r = rbase + ai * 128 + m * 16;
#pragma unroll
                    for (int bj = 0; bj < 2; ++bj)
#pragma unroll
                        for (int n = 0; n < 2; ++n) store4_bf16(QP + (size_t)r * 2048 + cbase + bj * 128 + 16 * n, acc[ai][bj][m][n]);
                }
        } else {
#pragma unroll
            for (int ai = 0; ai < 2; ++ai)
#pragma unroll
                for (int mh = 0; mh < 2; ++mh) {
                    u32x2 pv[2][2][2];
#pragma unroll
                    for (int m2 = 0; m2 < 2; ++m2)
#pragma unroll
                        for (int bj = 0; bj < 2; ++bj)
#pragma unroll
                            for (int n = 0; n < 2; ++n) pv[m2][bj][n] = *(const u32x2*)(PE + (size_t)(rbase + ai * 128 + (2 * mh + m2) * 16) * 1024 + (cbase - 2048) + bj * 128 + 16 * n);
                    asm volatile("" ::: "memory");
#pragma unroll
                    for (int m2 = 0; m2 < 2; ++m2)
#pragma unroll
                        for (int bj = 0; bj < 2; ++bj)
#pragma unroll
                            for (int n = 0; n < 2; ++n) {
                                const u32x2 g = pv[m2][bj][n];
                                f32x4 pf; pf[0] = __uint_as_float(g.x << 16); pf[1] = __uint_as_float(g.x & 0xffff0000u); pf[2] = __uint_as_float(g.y << 16); pf[3] = __uint_as_float(g.y & 0xffff0000u);
                                store4_bf16(PLE + (size_t)(rbase + ai * 128 + (2 * mh + m2) * 16) * 1024 + (cbase - 2048) + bj * 128 + 16 * n, sigmoid4(acc[ai][bj][2 * mh + m2][n]) * pf);
                            }
                    asm volatile("" ::: "memory");
                }
        }
    }
};

__device__ __forceinline__ void phase_peer_tables(const Params& p, size_t gtid, size_t gstride) {
    for (size_t i = gtid; i < (size_t)2 * 16384 * 32; i += gstride) {
        const bool isv = i >= (size_t)16384 * 32;
        const size_t j = isv ? i - (size_t)16384 * 32 : i;
        const float* src = (isv ? p.peer_v : p.peer_u) + j * 32;
        const float sc = isv ? 7.0f : 48.0f;
        f32x16 fa, fb;
#pragma unroll
        for (int q = 0; q < 4; ++q) {
            const float4 a = *(const float4*)(src + 4 * q), b = *(const float4*)(src + 16 + 4 * q);
            fa[4 * q] = a.x * sc; fa[4 * q + 1] = a.y * sc; fa[4 * q + 2] = a.z * sc; fa[4 * q + 3] = a.w * sc;
            fb[4 * q] = b.x * sc; fb[4 * q + 1] = b.y * sc; fb[4 * q + 2] = b.z * sc; fb[4 * q + 3] = b.w * sc;
        }
        const u32x6 w6 = __builtin_amdgcn_cvt_scalef32_2xpk16_fp6_f32(fa, fb, 1.0f);
        unsigned* dst = (unsigned*)((isv ? p.V8 : p.U8) + j * 24);
        *(u32x2*)dst = (u32x2){w6[0], w6[1]}; *(u32x2*)(dst + 2) = (u32x2){w6[2], w6[3]}; *(u32x2*)(dst + 4) = (u32x2){w6[4], w6[5]};
    }
    for (size_t i = gtid; i < (size_t)32768; i += gstride) {
        const float4 a = *(const float4*)(p.peer_subkeys + i * 8), b = *(const float4*)(p.peer_subkeys + i * 8 + 4);
        uint4 o; o.x = pack_bf2(a.x, a.y); o.y = pack_bf2(a.z, a.w); o.z = pack_bf2(b.x, b.y); o.w = pack_bf2(b.z, b.w);
        *(uint4*)(p.SUBK + i * 8) = o;
    }
}

__device__ __forceinline__ void phase_prologue(const Params& p, unsigned char* smem) {
    const int tid = opaque((int)threadIdx.x);
    const size_t gtid = (size_t)blockIdx.x * NT + tid, gstride = (size_t)gridDim.x * NT;
    for (size_t i = gtid; i < (size_t)MP * 128; i += gstride) {
        const int r = (int)(i >> 7), c8 = (int)(i & 127);
        uint4 o = make_uint4(0u, 0u, 0u, 0u);
        if (r < T) {
            const float* src = (r < TP) ? (p.x_prompt + (size_t)r * 1024) : (p.x_sample + (size_t)(r - TP) * 1024);
            const float4 a = *(const float4*)(src + c8 * 8), b = *(const float4*)(src + c8 * 8 + 4);
            o.x = pack_bf2(a.x, a.y); o.y = pack_bf2(a.z, a.w); o.z = pack_bf2(b.x, b.y); o.w = pack_bf2(b.z, b.w);
        }
        *(uint4*)(p.XB + (size_t)r * 1024 + c8 * 8) = o;
    }
    for (size_t i = gtid; i < (size_t)MP * 32; i += gstride) {
        const int r = (int)(i >> 5), c8 = (int)(i & 31);
        uint4 o = make_uint4(0u, 0u, 0u, 0u);
        if (r < T) {
            const float* src = (r < TP) ? (p.p_prompt + (size_t)r * 256) : (p.p_sample + (size_t)(r - TP) * 256);
            const float4 a = *(const float4*)(src + c8 * 8), b = *(const float4*)(src + c8 * 8 + 4);
            o.x = pack_bf2(a.x, a.y); o.y = pack_bf2(a.z, a.w); o.z = pack_bf2(b.x, b.y); o.w = pack_bf2(b.z, b.w);
        }
        *(uint4*)(p.PB + (size_t)r * 256 + c8 * 8) = o;
    }
    float* tile = (float*)smem;
    for (int task = blockIdx.x; task < 4480; task += gridDim.x) {
        const float* src; bf16_t* dst; int K, N, ntk, t, mapped = 0;
        if (task < 2624) { t = task; src = p.w_in; dst = p.WinT; K = 1024; N = NIN; ntk = 16; mapped = 1; }
        else if (task < 3136) { t = task - 2624; src = p.w_ret_o; dst = p.WretT; K = 2048; N = 1024; ntk = 32; }
        else if (task < 3392) { t = task - 3136; src = p.w_att_o; dst = p.WattT; K = 1024; N = 1024; ntk = 16; }
        else if (task < 3648) { t = task - 3392; src = p.w_out; dst = p.WoutT; K = 1024; N = 1024; ntk = 16; }
        else if (task < 4160) { t = task - 3648; src = p.peer_wq; dst = p.WqgT; K = 1024; N = 2048; ntk = 16; }
        else if (task < 4416) { t = task - 4160; src = p.w_ple_gate; dst = p.WqgT + (size_t)2048 * 1024; K = 1024; N = 1024; ntk = 16; }
        else { t = task - 4416; src = p.w_ple; dst = p.WpleT; K = 256; N = 1024; ntk = 4; }
        const int j0 = (t / ntk) * 64, k0 = (t % ntk) * 64;
        {
            const int jj = tid & 63, kk0 = tid >> 6;
            const int oc = mapped ? win_orig(j0 + jj) : (j0 + jj);
#pragma unroll
            for (int i = 0; i < 8; ++i) {
                const int kk = kk0 + 8 * i;
                tile[kk * 65 + jj] = (oc >= 0) ? src[(size_t)(k0 + kk) * N + oc] : 0.f;
            }
        }
        __syncthreads();
        {
            const int kk2 = (tid & 31) * 2, jj2 = tid >> 5;
#pragma unroll
            for (int i = 0; i < 4; ++i) {
                const int jj = jj2 + 16 * i;
                *(unsigned*)(dst + (size_t)(j0 + jj) * K + k0 + kk2) = pack_bf2(tile[kk2 * 65 + jj], tile[(kk2 + 1) * 65 + jj]);
            }
        }
        __syncthreads();
    }
}

typedef short s16x4 __attribute__((ext_vector_type(4)));
typedef short bf16x8 __attribute__((ext_vector_type(8)));
typedef float f32x16 __attribute__((ext_vector_type(16)));
typedef float f32x2v __attribute__((ext_vector_type(2)));
typedef __bf16 bf16v2 __attribute__((ext_vector_type(2)));
typedef LAS3 unsigned char* ldsp;
__device__ __forceinline__ unsigned pk2(float a, float b) { const f32x2v v = {a, b}; const bf16v2 r = __builtin_convertvector(v, bf16v2); return __builtin_bit_cast(unsigned, r); }
__device__ __forceinline__ bf16x8 ld_tr8(ldsp lo, int hi_delta) {
    const s16x4 a = __builtin_amdgcn_ds_read_tr16_b64_v4i16((LAS3 s16x4*)lo);
    const s16x4 b = __builtin_amdgcn_ds_read_tr16_b64_v4i16((LAS3 s16x4*)(lo + hi_delta));
    return __builtin_shufflevector(a, b, 0, 1, 2, 3, 4, 5, 6, 7);
}
__device__ __forceinline__ bf16x8 ld_b128(ldsp a) { return *(LAS3 bf16x8*)a; }
#define MFMA32(a, b, c) __builtin_amdgcn_mfma_f32_32x32x16_bf16((a), (b), (c), 0, 0, 0)
__device__ __forceinline__ int crow(int reg, int lh) { return (reg & 3) + 8 * (reg >> 2) + 4 * lh; }
__device__ __forceinline__ u32x4 scale8_bf16(u32x4 v, float d) {
    u32x4 o;
    o.x = pk2(__uint_as_float(v.x << 16) * d, __uint_as_float(v.x & 0xffff0000u) * d);
    o.y = pk2(__uint_as_float(v.y << 16) * d, __uint_as_float(v.y & 0xffff0000u) * d);
    o.z = pk2(__uint_as_float(v.z << 16) * d, __uint_as_float(v.z & 0xffff0000u) * d);
    o.w = pk2(__uint_as_float(v.w << 16) * d, __uint_as_float(v.w & 0xffff0000u) * d);
    return o;
}

__device__ __forceinline__ void ret_state_item(const Params& p, int item, ldsp lds) {
    const int tid = opaque((int)threadIdx.x), lane = tid & 63, w = __builtin_amdgcn_readfirstlane(tid >> 6);
    const int bh = item >> 4, dkh = (item >> 3) & 1, dvs = item & 7, b = bh >> 2, hd = bh & 3;
    const float l2g = log2f(1.0f - exp2f(-5.0f - (float)hd));
    constexpr int PK = 320, PV = 192;
    ldsp KT = lds, VS = lds + 128 * PK;
    const int r31 = lane & 31, lh = lane >> 5, q = (lane & 15) >> 2, p4 = lane & 3, blk = (lane >> 4) & 1;
    const int dkt = w >> 1, dvt = w & 1;
    const int offA = (8 * lh + q) * PK + 2 * (32 * dkt + 16 * blk + 4 * p4);
    const int offB = (8 * lh + q) * PV + 2 * (32 * dvt + 16 * blk + 4 * p4);
    f32x16 acc;
#pragma unroll
    for (int i = 0; i < 16; ++i) acc[i] = 0.f;
    const float gC = exp2f(128.0f * l2g);
    const bf16_t* kbase = p.RK + (size_t)(b * 4096) * 1024 + hd * 256 + dkh * 128;
    const bf16_t* vbase = p.RV + (size_t)(b * 4096) * 2048 + hd * 512 + dvs * 64;
    u32x4 kreg[4], vreg[2];
#pragma unroll
    for (int i = 0; i < 4; ++i) { const int id = tid + 512 * i, tok = id >> 4, pc = id & 15; kreg[i] = *(const u32x4*)(kbase + (size_t)tok * 1024 + pc * 8); }
#pragma unroll
    for (int i = 0; i < 2; ++i) { const int id = tid + 512 * i, tok = id >> 3, pc = id & 7; vreg[i] = *(const u32x4*)(vbase + (size_t)tok * 2048 + pc * 8); }
    for (int c = 0; c < 32; ++c) {
#pragma unroll
        for (int i = 0; i < 4; ++i) { const int id = tid + 512 * i, tok = id >> 4, pc = id & 15; *(LAS3 u32x4*)(KT + tok * PK + pc * 16) = kreg[i]; }
#pragma unroll
        for (int i = 0; i < 2; ++i) { const int id = tid + 512 * i, tok = id >> 3, pc = id & 7;
            *(LAS3 u32x4*)(VS + tok * PV + pc * 16) = scale8_bf16(vreg[i], exp2f((float)(127 - tok) * l2g)); }
        __syncthreads();
        if (c + 1 < 32) {
#pragma unroll
            for (int i = 0; i < 4; ++i) { const int id = tid + 512 * i, tok = id >> 4, pc = id & 15; kreg[i] = *(const u32x4*)(kbase + (size_t)((c + 1) * 128 + tok) * 1024 + pc * 8); }
#pragma unroll
            for (int i = 0; i < 2; ++i) { const int id = tid + 512 * i, tok = id >> 3, pc = id & 7; vreg[i] = *(const u32x4*)(vbase + (size_t)((c + 1) * 128 + tok) * 2048 + pc * 8); }
        }
        bf16_t* sc = p.SC + ((size_t)(bh * 32 + c) * 256 + dkh * 128 + dkt * 32) * 512 + dvs * 64 + dvt * 32 + r31;
#pragma unroll
        for (int reg = 0; reg < 16; ++reg) sc[(size_t)crow(reg, lh) * 512] = (bf16_t)(pk2(acc[reg], 0.f) & 0xffffu);
        acc = acc * gC;
#pragma unroll
        for (int s = 0; s < 8; ++s) {
            const bf16x8 A = ld_tr8(KT + offA + 16 * s * PK, 4 * PK);
            const bf16x8 B = ld_tr8(VS + offB + 16 * s * PV, 4 * PV);
            acc = MFMA32(A, B, acc);
        }
        __syncthreads();
    }
    float* so = p.ret_prompt + ((size_t)bh * 256 + dkh * 128 + dkt * 32) * 512 + dvs * 64 + dvt * 32 + r31;
#pragma unroll
    for (int reg = 0; reg < 16; ++reg) so[(size_t)crow(reg, lh) * 512] = acc[reg];
}

__device__ __forceinline__ void ret_out_item(const Params& p, int item, ldsp lds) {
    const int tid = opaque((int)threadIdx.x), lane = tid & 63, w = __builtin_amdgcn_readfirstlane(tid >> 6);
    const int bh = item >> 5, c = item & 31, b = bh >> 2, hd = bh & 3;
    const float l2g = log2f(1.0f - exp2f(-5.0f - (float)hd));
    constexpr int PQ = 528, PS = 1088, SLB = 32 * PS;
    ldsp QI = lds, KI = lds + 128 * PQ, RED = KI + 2 * SLB;
    const int r31 = lane & 31, lh = lane >> 5;
    const int it = w & 3, dvh = w >> 2;
    const unsigned row0 = (unsigned)(b * 4096 + c * 128);
    const char* qg = (const char*)(p.RQ + (size_t)row0 * 1024 + hd * 256);
    const char* kg = (const char*)(p.RK + (size_t)row0 * 1024 + hd * 256);
    const char* sg_ = (const char*)(p.SC + (size_t)(bh * 32 + c) * 256 * 512);
    const char* vg = (const char*)(p.RV + (size_t)row0 * 2048 + hd * 512);
#pragma unroll
    for (int i = 0; i < 8; ++i) {
        const int id = tid + 512 * i, tok = id >> 5, pc = id & 31;
        const unsigned go = (unsigned)(tok * 2048 + pc * 16);
        *(LAS3 u32x4*)(QI + tok * PQ + pc * 16) = *(const u32x4*)(qg + go);
        *(LAS3 u32x4*)(KI + tok * PQ + pc * 16) = *(const u32x4*)(kg + go);
    }
    u32x4 sreg[4];
    {
        const int tt = opaque(tid);
#pragma unroll
        for (int i = 0; i < 4; ++i) { const int id = tt + 512 * i, rr = id >> 6, pc = id & 63; sreg[i] = *(const u32x4*)(sg_ + (unsigned)(rr * 1024 + pc * 16)); }
    }
    __syncthreads();
    bf16x8 pf[4][2];
    const int ig = 32 * it + r31;
#pragma unroll
    for (int jt = 0; jt < 4; ++jt) {
        if (jt <= it) {
            f32x16 a;
#pragma unroll
            for (int i = 0; i < 16; ++i) a[i] = 0.f;
            ldsp ka = KI + (32 * jt + r31) * PQ + 16 * lh, qa = QI + (32 * it + r31) * PQ + 16 * lh;
#pragma unroll 4
            for (int s = 0; s < 16; ++s) a = MFMA32(ld_b128(ka + 32 * s), ld_b128(qa + 32 * s), a);
#pragma unroll
            for (int reg = 0; reg < 16; ++reg) {
                const int j = 32 * jt + crow(reg, lh);
                a[reg] = (ig >= j) ? a[reg] * exp2f((float)(ig - j) * l2g) : 0.f;
            }
#pragma unroll
            for (int s2 = 0; s2 < 2; ++s2) {
                u32x4 pkd;
                pkd.x = pk2(a[8 * s2 + 0], a[8 * s2 + 1]); pkd.y = pk2(a[8 * s2 + 2], a[8 * s2 + 3]);
                pkd.z = pk2(a[8 * s2 + 4], a[8 * s2 + 5]); pkd.w = pk2(a[8 * s2 + 6], a[8 * s2 + 7]);
                pf[jt][s2] = __builtin_bit_cast(bf16x8, pkd);
            }
        } else {
            const u32x4 z = {0u, 0u, 0u, 0u};
            pf[jt][0] = __builtin_bit_cast(bf16x8, z); pf[jt][1] = __builtin_bit_cast(bf16x8, z);
        }
    }
    __syncthreads();
    f32x16 acc[8];
#pragma unroll
    for (int t = 0; t < 8; ++t)
#pragma unroll
        for (int i = 0; i < 16; ++i) acc[t][i] = 0.f;
    for (int d = 0; d < 8; ++d) {
        ldsp buf = KI + (d & 1) * SLB;
        const int tt = opaque(tid);
#pragma unroll
        for (int i = 0; i < 4; ++i) { const int id = tt + 512 * i, rr = id >> 6, pc = id & 63; *(LAS3 u32x4*)(buf + rr * PS + pc * 16) = sreg[i]; }
        __syncthreads();
        {
            const char* src = (d + 1 < 8) ? (sg_ + (size_t)(32 * (d + 1)) * 1024) : vg;
            const int pitch = (d + 1 < 8) ? 1024 : 4096;
#pragma unroll
            for (int i = 0; i < 4; ++i) { const int id = tt + 512 * i, rr = id >> 6, pc = id & 63; sreg[i] = *(const u32x4*)(src + (unsigned)(rr * pitch + pc * 16)); }
        }
        const int ln = opaque(lane);
        ldsp qa = QI + (32 * it + (ln & 31)) * PQ + 64 * d + 16 * (ln >> 5);
        ldsp sa = buf + (8 * (ln >> 5) + ((ln & 15) >> 2)) * PS + 2 * (256 * dvh + 16 * ((ln >> 4) & 1) + 4 * (ln & 3));
#pragma unroll
        for (int s = 0; s < 2; ++s) {
            const bf16x8 B = ld_b128(qa + 32 * s);
#pragma unroll
            for (int t = 0; t < 8; ++t) acc[t] = MFMA32(ld_tr8(sa + 16 * s * PS + 64 * t, 4 * PS), B, acc[t]);
        }
    }
    {
        const float rowdec = exp2f((float)(ig + 1) * l2g);
#pragma unroll
        for (int t = 0; t < 8; ++t) acc[t] = acc[t] * rowdec;
    }
#pragma unroll
    for (int u = 0; u < 4; ++u) {
        ldsp buf = KI + (u & 1) * SLB;
        const int tt = opaque(tid);
#pragma unroll
        for (int i = 0; i < 4; ++i) { const int id = tt + 512 * i, rr = id >> 6, pc = id & 63; *(LAS3 u32x4*)(buf + rr * PS + pc * 16) = sreg[i]; }
        __syncthreads();
        if (u + 1 < 4) {
#pragma unroll
            for (int i = 0; i < 4; ++i) { const int id = tt + 512 * i, rr = id >> 6, pc = id & 63; sreg[i] = *(const u32x4*)(vg + (unsigned)((32 * (u + 1) + rr) * 4096 + pc * 16)); }
        }
        if (u <= it) {
            const int ln = opaque(lane);
            ldsp sa = buf + (4 * (ln >> 5) + ((ln & 15) >> 2)) * PS + 2 * (256 * dvh + 16 * ((ln >> 4) & 1) + 4 * (ln & 3));
#pragma unroll
            for (int s2 = 0; s2 < 2; ++s2)
#pragma unroll
                for (int t = 0; t < 8; ++t) acc[t] = MFMA32(ld_tr8(sa + 16 * s2 * PS + 64 * t, 8 * PS), pf[u][s2], acc[t]);
        }
    }
    float sm = 0.f, sq = 0.f;
#pragma unroll
    for (int t = 0; t < 8; ++t)
#pragma unroll
        for (int i = 0; i < 16; ++i) { sm += acc[t][i]; sq += acc[t][i] * acc[t][i]; }
    sm += __shfl_xor(sm, 32); sq += __shfl_xor(sq, 32);
    LAS3 float* red = (LAS3 float*)RED;
    if (lh == 0) { red[(w * 32 + r31) * 2] = sm; red[(w * 32 + r31) * 2 + 1] = sq; }
    __syncthreads();
    {
        const int ln = opaque(lane), r31b = ln & 31, lhb = ln >> 5;
        const float osm = red[((w ^ 4) * 32 + r31b) * 2], osq = red[((w ^ 4) * 32 + r31b) * 2 + 1];
        const float mean = (sm + osm) * (1.0f / 512.0f);
        const float var = (sq + osq) * (1.0f / 512.0f) - mean * mean;
        const float rstd = rsqrtf(fmaxf(var, 0.f) + LN_EPS);
        ldsp ot = lds + (32 * it + r31b) * 1040 + 2 * (256 * dvh + 4 * lhb);
#pragma unroll
        for (int t = 0; t < 8; ++t)
#pragma unroll
            for (int g = 0; g < 4; ++g) {
                u32x2 o; o.x = pk2((acc[t][4 * g] - mean) * rstd, (acc[t][4 * g + 1] - mean) * rstd); o.y = pk2((acc[t][4 * g + 2] - mean) * rstd, (acc[t][4 * g + 3] - mean) * rstd);
                *(LAS3 u32x2*)(ot + 2 * (32 * t + 8 * g)) = o;
            }
    }
    __syncthreads();
    {
        const int tt = opaque(tid);
        const bf16_t* sgp = p.SG + (size_t)row0 * 2048 + hd * 512;
        bf16_t* outp = p.RETO + (size_t)row0 * 2048 + hd * 512;
#pragma unroll 4
        for (int i = 0; i < 16; ++i) {
            const int id = tt + 512 * i, rr = id >> 6, pc = id & 63;
            const u32x4 xn = *(LAS3 u32x4*)(lds + rr * 1040 + pc * 16);
            const u32x4 sg = *(const u32x4*)(sgp + (size_t)rr * 2048 + pc * 8);
            const f32x4 g0 = *(const f32x4*)(p.gn_g + hd * 512 + pc * 8), g1 = *(const f32x4*)(p.gn_g + hd * 512 + pc * 8 + 4);
            const f32x4 b0 = *(const f32x4*)(p.gn_b + hd * 512 + pc * 8), b1 = *(const f32x4*)(p.gn_b + hd * 512 + pc * 8 + 4);
            u32x4 o;
            o.x = pk2((__uint_as_float(xn.x << 16) * g0[0] + b0[0]) * __uint_as_float(sg.x << 16), (__uint_as_float(xn.x & 0xffff0000u) * g0[1] + b0[1]) * __uint_as_float(sg.x & 0xffff0000u));
            o.y = pk2((__uint_as_float(xn.y << 16) * g0[2] + b0[2]) * __uint_as_float(sg.y << 16), (__uint_as_float(xn.y & 0xffff0000u) * g0[3] + b0[3]) * __uint_as_float(sg.y & 0xffff0000u));
            o.z = pk2((__uint_as_float(xn.z << 16) * g1[0] + b1[0]) * __uint_as_float(sg.z << 16), (__uint_as_float(xn.z & 0xffff0000u) * g1[1] + b1[1]) * __uint_as_float(sg.z & 0xffff0000u));
            o.w = pk2((__uint_as_float(xn.w << 16) * g1[2] + b1[2]) * __uint_as_float(sg.w << 16), (__uint_as_float(xn.w & 0xffff0000u) * g1[3] + b1[3]) * __uint_as_float(sg.w & 0xffff0000u));
            *(u32x4*)(outp + (size_t)rr * 2048 + pc * 8) = o;
        }
    }
    __syncthreads();
}

__device__ __forceinline__ void ret_scan_load(const Params& p, int item, int row0, const float* state_in, float (&S)[32], float (&qk)[4], float (&vt)[4]) {
    const int tid = opaque((int)threadIdx.x), col = tid & 63, dkq = tid >> 6;
    const int bh = item >> 3, vg = item & 7, b = bh >> 2, h = bh & 3;
    const size_t sbase = (size_t)bh * 256 * 512 + (size_t)(dkq * 32) * 512 + vg * 64 + col;
#pragma unroll
    for (int i = 0; i < 32; ++i) S[i] = state_in ? state_in[sbase + (size_t)i * 512] : 0.f;
#pragma unroll
    for (int t = 0; t < 4; ++t) {
        const size_t r = (size_t)(row0 + b * 4 + t);
        qk[t] = (tid < 256) ? bf2f(p.RQ[r * 1024 + h * 256 + tid]) : bf2f(p.RK[r * 1024 + h * 256 + (tid - 256)]);
        vt[t] = bf2f(p.RV[r * 2048 + h * 512 + vg * 64 + col]);
    }
}
__device__ __forceinline__ void ret_scan_item(const Params& p, int item, int next_item, int row0, const float* state_in, float* state_out, float* qs, float* ks,
                                              float (&S)[32], float (&qk)[4], float (&vt)[4]) {
    const int tid = opaque((int)threadIdx.x), col = tid & 63, dkq = tid >> 6;
    float* redp = ks + 1024;
    const int bh = item >> 3, vg = item & 7, b = bh >> 2, h = bh & 3;
    const float gamma = 1.0f - exp2f(-5.0f - (float)h);
    const size_t sbase = (size_t)bh * 256 * 512 + (size_t)(dkq * 32) * 512 + vg * 64 + col;
    float vtok[4];
#pragma unroll
    for (int t = 0; t < 4; ++t) {
        if (tid < 256) qs[t * 256 + tid] = qk[t]; else ks[t * 256 + tid - 256] = qk[t];
        vtok[t] = vt[t];
    }
    __syncthreads();
    float Sn[32], qkn[4], vtn[4];
    if (next_item >= 0) ret_scan_load(p, next_item, row0, state_in, Sn, qkn, vtn);
#pragma unroll
    for (int t = 0; t < 4; ++t) {
        const size_t r = (size_t)(row0 + b * 4 + t);
        float part = 0.f;
#pragma unroll
        for (int i = 0; i < 32; ++i) {
            S[i] = gamma * S[i] + ks[t * 256 + dkq * 32 + i] * vtok[t];
            part += qs[t * 256 + dkq * 32 + i] * S[i];
        }
        redp[dkq * 64 + col] = part;
        __syncthreads();
        if (tid < 64) {
            float tot = 0.f;
#pragma unroll
            for (int w = 0; w < 8; ++w) tot += redp[w * 64 + tid];
            p.RO[r * 2048 + h * 512 + vg * 64 + tid] = tot;
        }
        __syncthreads();
    }
#pragma unroll
    for (int i = 0; i < 32; ++i) state_out[sbase + (size_t)i * 512] = S[i];
    if (next_item >= 0) {
#pragma unroll
        for (int i = 0; i < 32; ++i) S[i] = Sn[i];
#pragma unroll
        for (int t = 0; t < 4; ++t) { qk[t] = qkn[t]; vt[t] = vtn[t]; }
    }
    __syncthreads();
}
__device__ __forceinline__ void phase_ret_scan(const Params& p, unsigned char* smem) {
    for (int it = blockIdx.x; it < 256; it += gridDim.x) ret_state_item(p, it, (ldsp)smem);
    float* qs = (float*)smem; float* ks = qs + 1024;
    {
        float S[32], qk[4], vt[4];
        int it = blockIdx.x;
        if (it < 1024) ret_scan_load(p, it, TP, p.state_ret, S, qk, vt);
        for (; it < 1024; it += gridDim.x) { const int nx = it + (int)gridDim.x; ret_scan_item(p, it, nx < 1024 ? nx : -1, TP, p.state_ret, p.ret_sample, qs, ks, S, qk, vt); }
    }
}
__device__ __forceinline__ void phase_ret_out(const Params& p, unsigned char* smem) {
    for (int it = blockIdx.x; it < 512; it += gridDim.x) ret_out_item(p, it, (ldsp)smem);
}
__device__ __forceinline__ void phase_ret_gn(const Params& p) {
    const int tid_ = opaque((int)threadIdx.x), wid = tid_ >> 6, lane = tid_ & 63;
    for (int item = TP * 4 + blockIdx.x * 8 + wid; item < T * 4; item += gridDim.x * 8) {
        const int r = item >> 2, h = item & 3;
        const float* o = p.RO + (size_t)r * 2048 + h * 512;
        float v[8]; float s = 0.f;
#pragma unroll
        for (int i = 0; i < 8; ++i) { v[i] = o[lane + 64 * i]; s += v[i]; }
        const float mean = wave_sum(s) * (1.0f / 512.0f);
        float q = 0.f;
#pragma unroll
        for (int i = 0; i < 8; ++i) { const float d = v[i] - mean; q += d * d; }
        const float rstd = rsqrtf(wave_sum(q) * (1.0f / 512.0f) + LN_EPS);
#pragma unroll
        for (int i = 0; i < 8; ++i) {
            const int c = h * 512 + lane + 64 * i;
            const float on = (v[i] - mean) * rstd * p.gn_g[c] + p.gn_b[c];
            p.RETO[(size_t)r * 2048 + c] = f2bf(bf2f(p.SG[(size_t)r * 2048 + c]) * on);
        }
    }
}


__device__ __forceinline__ unsigned fkey(float f) { const unsigned u = __float_as_uint(f); return (u & 0x80000000u) ? ~u : (u | 0x80000000u); }

__device__ __forceinline__ float block_sum512(float v, float* red) {
    v = wave_sum(v);
    __syncthreads();
    if ((threadIdx.x & 63) == 0) red[threadIdx.x >> 6] = v;
    __syncthreads();
    float t = 0.f;
#pragma unroll
    for (int w = 0; w < 8; ++w) t += red[w];
    return t;
}
__device__ __forceinline__ void phase_ln1(const Params& p) {
    const int tid_ = opaque((int)threadIdx.x), wid = tid_ >> 6, lane = tid_ & 63;
    const int stride = gridDim.x * 8;
    int r = blockIdx.x * 8 + wid;
    u32x4 v8[2], n8[2];
    if (r < T) {
#pragma unroll
        for (int i = 0; i < 2; ++i) v8[i] = *(const u32x4*)(p.VPRE + (size_t)r * 1024 + lane * 8 + 512 * i);
    }
    for (; r < T; r += stride) {
        const int rn = r + stride;
        if (rn < T) {
#pragma unroll
            for (int i = 0; i < 2; ++i) n8[i] = *(const u32x4*)(p.VPRE + (size_t)rn * 1024 + lane * 8 + 512 * i);
        }
        float v[16];
#pragma unroll
        for (int i = 0; i < 2; ++i)
#pragma unroll
            for (int e = 0; e < 4; ++e) { v[8 * i + 2 * e] = __uint_as_float(v8[i][e] << 16); v[8 * i + 2 * e + 1] = __uint_as_float(v8[i][e] & 0xffff0000u); }
        float s = 0.f;
#pragma unroll
        for (int i = 0; i < 16; ++i) s += v[i];
        const float mean = wave_sum(s) * (1.0f / 1024.0f);
        float q = 0.f;
#pragma unroll
        for (int i = 0; i < 16; ++i) { const float d = v[i] - mean; q += d * d; }
        const float rstd = rsqrtf(wave_sum(q) * (1.0f / 1024.0f) + LN_EPS);
#pragma unroll
        for (int i = 0; i < 2; ++i) {
            const int c = lane * 8 + 512 * i;
            const float4 g0 = *(const float4*)(p.ln1_g + c), g1 = *(const float4*)(p.ln1_g + c + 4), b0 = *(const float4*)(p.ln1_b + c), b1 = *(const float4*)(p.ln1_b + c + 4);
            uint4 ob;
            ob.x = pack_bf2((v[8 * i] - mean) * rstd * g0.x + b0.x, (v[8 * i + 1] - mean) * rstd * g0.y + b0.y);
            ob.y = pack_bf2((v[8 * i + 2] - mean) * rstd * g0.z + b0.z, (v[8 * i + 3] - mean) * rstd * g0.w + b0.w);
            ob.z = pack_bf2((v[8 * i + 4] - mean) * rstd * g1.x + b1.x, (v[8 * i + 5] - mean) * rstd * g1.y + b1.y);
            ob.w = pack_bf2((v[8 * i + 6] - mean) * rstd * g1.z + b1.z, (v[8 * i + 7] - mean) * rstd * g1.w + b1.w);
            *(uint4*)(p.X1B + (size_t)r * 1024 + c) = ob;
        }
#pragma unroll
        for (int i = 0; i < 2; ++i) v8[i] = n8[i];
    }
}

__device__ __forceinline__ void wave_argmax(float& v, int& i) {
#pragma unroll
    for (int o = 32; o >= 1; o >>= 1) {
        const float ov = __shfl_xor(v, o);
        const int oi = __shfl_xor(i, o);
        if (ov > v || (ov == v && oi < i)) { v = ov; i = oi; }
    }
}
__device__ __forceinline__ void peer_item(const Params& p, int r, unsigned char* smem) {
    float* xs = (float*)smem;
    float* qs = xs + 1024;
    float* sc = qs + 2048;
    float* topv = sc + 2048;
    int* topi = (int*)(topv + 256);
    float* gw = (float*)(topi + 256);
    int* eid = (int*)(gw + 128);
    float* red = (float*)(eid + 128);
    const int tid = opaque((int)threadIdx.x), wid = tid >> 6, lane = tid & 63;
    xs[tid] = p.X1[(size_t)r * 1024 + tid]; xs[tid + 512] = p.X1[(size_t)r * 1024 + 512 + tid];
#pragma unroll
    for (int i = 0; i < 4; ++i) qs[tid + 512 * i] = bf2f(p.QP[(size_t)r * 2048 + tid + 512 * i]);
    __syncthreads();
    for (int it = 0; it < 4; ++it) {
        const int id = tid + NT * it, list = id >> 7, n = id & 127;
        const float* sk = p.peer_subkeys + ((size_t)list * 128 + n) * 128;
        const float* qq = qs + list * 128;
        float d = 0.f;
#pragma unroll 8
        for (int e = 0; e < 128; ++e) d += qq[e] * sk[e];
        sc[list * 128 + n] = d;
    }
    __syncthreads();
    for (int li = 0; li < 2; ++li) {
        const int list = wid * 2 + li;
        float v0 = sc[list * 128 + lane], v1 = sc[list * 128 + lane + 64];
        for (int k = 0; k < 16; ++k) {
            float bv; int bi;
            if (v1 > v0) { bv = v1; bi = lane + 64; } else { bv = v0; bi = lane; }
            wave_argmax(bv, bi);
            if (lane == 0) { topv[list * 16 + k] = bv; topi[list * 16 + k] = bi; }
            if (bi == lane) v0 = -3.0e38f;
            if (bi == lane + 64) v1 = -3.0e38f;
        }
    }
    __syncthreads();
    {
        const int h = wid;
        float cv[4];
#pragma unroll
        for (int i = 0; i < 4; ++i) { const int c = lane + 64 * i; cv[i] = topv[(2 * h) * 16 + (c >> 4)] + topv[(2 * h + 1) * 16 + (c & 15)]; }
        float myv = 0.f; int myc = 0;
        for (int k = 0; k < 16; ++k) {
            float bv = cv[0]; int bi = lane;
#pragma unroll
            for (int i = 1; i < 4; ++i) if (cv[i] > bv) { bv = cv[i]; bi = lane + 64 * i; }
            wave_argmax(bv, bi);
            if (lane == k) { myv = bv; myc = bi; }
#pragma unroll
            for (int i = 0; i < 4; ++i) if (bi == lane + 64 * i) cv[i] = -3.0e38f;
        }
        float m = (lane < 16) ? myv : -3.0e38f;
        m = wave_max(m);
        const float e = (lane < 16) ? __expf(myv - m) : 0.f;
        const float ssum = wave_sum(e);
        if (lane < 16) {
            gw[h * 16 + lane] = e / ssum;
            eid[h * 16 + lane] = topi[(2 * h) * 16 + (myc >> 4)] * 128 + topi[(2 * h + 1) * 16 + (myc & 15)];
        }
    }
    __syncthreads();
    for (int pi = 0; pi < 16; ++pi) {
        const int pr = wid * 16 + pi;
        const float* uu = p.peer_u + (size_t)eid[pr] * 1024;
        float d = 0.f;
#pragma unroll
        for (int i = 0; i < 4; ++i) {
            const float4 uv = *(const float4*)(uu + lane * 4 + 256 * i);
            const float* xx = xs + lane * 4 + 256 * i;
            d += xx[0] * uv.x + xx[1] * uv.y + xx[2] * uv.z + xx[3] * uv.w;
        }
        d = wave_sum(d);
        if (lane == 0) gw[pr] = gw[pr] * 0.5f * d * (1.0f + erff(d * 0.7071067811865476f));
    }
    __syncthreads();
    float o0 = 0.f, o1 = 0.f;
#pragma unroll 4
    for (int pr = 0; pr < 128; ++pr) {
        const float2 vv = *(const float2*)(p.peer_v + (size_t)eid[pr] * 1024 + tid * 2);
        const float w = gw[pr];
        o0 += w * vv.x; o1 += w * vv.y;
    }
    float2 ple; ple.x = bf2f(p.PLE[(size_t)r * 1024 + tid * 2]); ple.y = bf2f(p.PLE[(size_t)r * 1024 + tid * 2 + 1]);
    const float v0 = ALPHA * xs[tid * 2] + o0 + ple.x, v1 = ALPHA * xs[tid * 2 + 1] + o1 + ple.y;
    const float mean = block_sum512(v0 + v1, red) * (1.0f / 1024.0f);
    const float d0 = v0 - mean, d1 = v1 - mean;
    const float rstd = rsqrtf(block_sum512(d0 * d0 + d1 * d1, red) * (1.0f / 1024.0f) + LN_EPS);
    float* y = (r < TP) ? (p.y_prompt + (size_t)r * 1024) : (p.y_sample + (size_t)(r - TP) * 1024);
    float2 o; o.x = d0 * rstd * p.ln2_g[tid * 2] + p.ln2_b[tid * 2]; o.y = d1 * rstd * p.ln2_g[tid * 2 + 1] + p.ln2_b[tid * 2 + 1];
    *(float2*)(y + tid * 2) = o;
    __syncthreads();
}
__device__ __forceinline__ void phase_peer(const Params& p, unsigned char* smem) {
    for (int r = blockIdx.x; r < T; r += gridDim.x) peer_item(p, r, smem);
}


typedef _Float16 f16x8 __attribute__((ext_vector_type(8)));
#define MFMA32H(a, b, c) __builtin_amdgcn_mfma_f32_32x32x16_f16((a), (b), (c), 0, 0, 0)
struct IdxChunk { int b, nt, m0, m1; };
__device__ __forceinline__ IdxChunk idx_chunk_decode(int chunk) {
    IdxChunk c; c.b = chunk / 187; int idx = chunk - c.b * 187;
    int nt = 0;
    for (;;) { const int nc = (nt + 3) / 3; if (idx < nc) break; idx -= nc; ++nt; }
    c.nt = nt; c.m0 = 3 * idx; c.m1 = (c.m0 + 2 < nt) ? (c.m0 + 2) : nt;
    return c;
}
__device__ __forceinline__ void idx_chunk_load_q(const Params& p, const IdxChunk& c, u32x4 (&qpre)[16], float2& wv) {
    const int tid = opaque((int)threadIdx.x);
    const char* qg = (const char*)(p.IQ + (size_t)(c.b * 4096 + 128 * c.nt) * 512);
#pragma unroll
    for (int i = 0; i < 16; ++i) { const int id = tid + 512 * i, row = id >> 6, pc = id & 63; qpre[i] = *(const u32x4*)(qg + (size_t)row * 1024 + pc * 16); }
    const int q = tid >> 2, h2 = (tid & 3) * 2;
    wv = *(const float2*)(p.IW + (size_t)(c.b * 4096 + 128 * c.nt + q) * 8 + h2);
}
__device__ __forceinline__ void idx_chunk_load_k(const Params& p, int b, int mt, f16x8 (&kf)[2][4]) {
    const int tid = opaque((int)threadIdx.x), lane = tid & 63, w = __builtin_amdgcn_readfirstlane(tid >> 6);
    const int r31 = lane & 31, lh = lane >> 5, kmp = w >> 2;
#pragma unroll
    for (int kk = 0; kk < 2; ++kk) {
        const int krow = b * 4096 + 128 * mt + 32 * (2 * kmp + kk) + r31;
#pragma unroll
        for (int s = 0; s < 4; ++s) kf[kk][s] = *(const f16x8*)(p.IK + (size_t)krow * 64 + 16 * s + 8 * lh);
    }
}
__device__ __forceinline__ void idx_score_chunk(const Params& p, const IdxChunk& ck, const bool has_next, const IdxChunk& cn, u32x4 (&qpre)[16], float2& wvp, f16x8 (&kf)[2][4], ldsp lds) {
    const int tid = opaque((int)threadIdx.x), lane = tid & 63, w = __builtin_amdgcn_readfirstlane(tid >> 6);
    const int b = ck.b, nt = ck.nt, m0 = ck.m0, m1 = ck.m1;
    const int r31 = lane & 31, lh = lane >> 5, qn = w & 3, kmp = w >> 2;
    constexpr int PQI = 1040;
    LAS3 float* wT = (LAS3 float*)(lds + 128 * PQI);
    {
#pragma unroll
        for (int i = 0; i < 16; ++i) { const int id = tid + 512 * i, row = id >> 6, pc = id & 63; *(LAS3 u32x4*)(lds + row * PQI + pc * 16) = qpre[i]; }
        const int q = tid >> 2, h2 = (tid & 3) * 2;
        wT[h2 * 128 + q] = wvp.x; wT[(h2 + 1) * 128 + q] = wvp.y;
    }
    __syncthreads();
    ldsp qa = lds + (32 * qn + r31) * PQI + 16 * lh;
#pragma unroll 1
    for (int mt = m0; mt <= m1; ++mt) {
        f16x8 nk[2][4];
        const bool more = mt < m1;
        if (more) idx_chunk_load_k(p, b, mt + 1, nk);
        else if (has_next) idx_chunk_load_q(p, cn, qpre, wvp);
#pragma unroll
        for (int kk = 0; kk < 2; ++kk) {
            f32x16 score;
#pragma unroll
            for (int i = 0; i < 16; ++i) score[i] = 0.f;
#pragma unroll 2
            for (int h = 0; h < 8; ++h) {
                f32x16 acc;
#pragma unroll
                for (int i = 0; i < 16; ++i) acc[i] = 0.f;
#pragma unroll
                for (int s = 0; s < 4; ++s) acc = MFMA32H(*(LAS3 f16x8*)(qa + 2 * (h * 64 + 16 * s)), kf[kk][s], acc);
#pragma unroll
                for (int g = 0; g < 4; ++g) {
                    const f32x4 wv = *(LAS3 f32x4*)(wT + h * 128 + 32 * qn + 8 * g + 4 * lh);
#pragma unroll
                    for (int e = 0; e < 4; ++e) score[4 * g + e] += wv[e] * fmaxf(acc[4 * g + e], 0.f);
                }
            }
            float* so = p.SCO + (size_t)(b * 4096 + 128 * nt + 32 * qn) * 4096 + 128 * mt + 32 * (2 * kmp + kk) + r31;
#pragma unroll
            for (int reg = 0; reg < 16; ++reg) __builtin_nontemporal_store(score[reg], so + (size_t)crow(reg, lh) * 4096);
        }
        if (more) {
#pragma unroll
            for (int kk = 0; kk < 2; ++kk)
#pragma unroll
                for (int s = 0; s < 4; ++s) kf[kk][s] = nk[kk][s];
        }
    }
    if (has_next) idx_chunk_load_k(p, cn.b, cn.m0, kf);
    __syncthreads();
}
__device__ __forceinline__ void idx_score_sample_item(const Params& p, int item) {
    const int tid = opaque((int)threadIdx.x), lane = tid & 63, w = __builtin_amdgcn_readfirstlane(tid >> 6);
    const int bd = item >> 3, kb = item & 7;
    const int r31 = lane & 31, lh = lane >> 5, tq = r31 >> 3, hq = r31 & 7;
    const size_t qrow = (size_t)(TP + bd * 4 + tq);
    f16x8 bq[4];
#pragma unroll
    for (int s = 0; s < 4; ++s) bq[s] = *(const f16x8*)(p.IQ + qrow * 512 + hq * 64 + 16 * s + 8 * lh);
    const float wv = p.IW[qrow * 8 + hq];
    const int ntile = (kb == 7 && w == 7) ? 9 : 8;
    const float* krp[8];
#pragma unroll
    for (int tile = 0; tile < 8; ++tile) {
        const int key = kb * 2048 + (w * 8 + tile) * 32 + r31;
        krp[tile] = p.cache_kidx + ((size_t)p.page_table[bd * 128 + (key >> 7)] * 128 + (key & 127)) * 64 + 8 * lh;
    }
    float4 cur[8], nxt[8];
#pragma unroll
    for (int s = 0; s < 4; ++s) { cur[2 * s] = *(const float4*)(krp[0] + 16 * s); cur[2 * s + 1] = *(const float4*)(krp[0] + 16 * s + 4); }
#pragma unroll
    for (int tile = 0; tile < 9; ++tile) {
        if (tile < ntile) {
            f16x8 af[4];
            int key0;
            if (tile < 8) {
                key0 = kb * 2048 + (w * 8 + tile) * 32;
                if (tile + 1 < 8) {
#pragma unroll
                    for (int s = 0; s < 4; ++s) { nxt[2 * s] = *(const float4*)(krp[(tile + 1) & 7] + 16 * s); nxt[2 * s + 1] = *(const float4*)(krp[(tile + 1) & 7] + 16 * s + 4); }
                }
#pragma unroll
                for (int s = 0; s < 4; ++s) {
                    const float4 x0 = cur[2 * s], x1 = cur[2 * s + 1];
                    f16x8 v; v[0] = (_Float16)x0.x; v[1] = (_Float16)x0.y; v[2] = (_Float16)x0.z; v[3] = (_Float16)x0.w; v[4] = (_Float16)x1.x; v[5] = (_Float16)x1.y; v[6] = (_Float16)x1.z; v[7] = (_Float16)x1.w;
                    af[s] = v;
                }
            } else {
                key0 = 16384;
                const f16_t* kr = p.IK + (size_t)(TP + bd * 4 + (r31 & 3)) * 64 + 8 * lh;
#pragma unroll
                for (int s = 0; s < 4; ++s) af[s] = *(const f16x8*)(kr + 16 * s);
            }
            f32x16 acc;
#pragma unroll
            for (int i = 0; i < 16; ++i) acc[i] = 0.f;
#pragma unroll
            for (int s = 0; s < 4; ++s) acc = MFMA32H(af[s], bq[s], acc);
            const int nkeys = (tile < 8) ? 32 : 4;
#pragma unroll
            for (int reg = 0; reg < 16; ++reg) {
                float v = wv * fmaxf(acc[reg], 0.f);
                v += __shfl_xor(v, 1); v += __shfl_xor(v, 2); v += __shfl_xor(v, 4);
                const int kin = crow(reg, lh);
                if (hq == 0 && kin < nkeys) p.SS[(size_t)(bd * 4 + tq) * 16392 + key0 + kin] = v;
            }
            if (tile + 1 < 8) {
#pragma unroll
                for (int i = 0; i < 8; ++i) cur[i] = nxt[i];
            }
        }
    }
}
__device__ __forceinline__ float dot2bf_(unsigned a, unsigned b, float c) {
    typedef __bf16 bf2 __attribute__((ext_vector_type(2)));
    return __builtin_amdgcn_fdot2_f32_bf16(__builtin_bit_cast(bf2, a), __builtin_bit_cast(bf2, b), c, false);
}

template <bool SAMPLE>
__device__ __forceinline__ const void* kv_row_ptr(const Params& p, int bidx, int row, int g, bool isv, bool& f32src) {
    f32src = SAMPLE;
    if (SAMPLE) {
        const bool past = row < 16384;
        const int prow = past ? row : 0;
        const size_t ph = (size_t)p.page_table[bidx * 128 + (prow >> 7)] * 128 + (prow & 127);
        const size_t off = past ? (ph * 2 + g) * 128 : (size_t)((bidx * 4 + (row - 16384)) * 2 + g) * 128;
        const float* cb = isv ? p.cache_v : p.cache_k; const float* nb = isv ? p.v_sample : p.k_sample;
        return (past ? cb : nb) + off;
    }
    return (isv ? p.AV : p.AK) + (size_t)(bidx * 4096 + row) * 256 + g * 128;
}
template <bool SAMPLE>
__device__ __forceinline__ u32x4 ld8_kv(const void* rowp, bool f32src, int e0) {
    if (SAMPLE) {
        const float4 a = *(const float4*)((const float*)rowp + e0), b = *(const float4*)((const float*)rowp + e0 + 4);
        u32x4 o; o.x = pk2(a.x, a.y); o.y = pk2(a.z, a.w); o.z = pk2(b.x, b.y); o.w = pk2(b.z, b.w);
        return o;
    }
    return *(const u32x4*)((const bf16_t*)rowp + e0);
}
#define MFMA16(a, b, c) __builtin_amdgcn_mfma_f32_16x16x32_bf16((a), (b), (c), 0, 0, 0)
template <bool SAMPLE>
__device__ __forceinline__ void attend_unit(const Params& p, int r, int bidx, int g, LAS3 int* list, int nsel, ldsp wp) {
    const int lane = opaque((int)threadIdx.x) & 63, n16 = lane & 15, kg = lane >> 4;
    LAS3 float* pw = (LAS3 float*)(wp + 1024);
    ldsp Pt = wp + 5120, Vs = wp + 7168;
    const u32x4 zero4 = {0u, 0u, 0u, 0u};
    bf16x8 qf[4];
    {
        const bf16_t* qp = p.AQ + (size_t)r * 1024 + (4 * g + (n16 & 3)) * 128 + 8 * kg;
#pragma unroll
        for (int s = 0; s < 4; ++s) { u32x4 t = *(const u32x4*)(qp + 32 * s); if (n16 >= 4) t = zero4; qf[s] = __builtin_bit_cast(bf16x8, t); }
    }
    asm volatile("" ::: "memory");
    {
        constexpr int KD = SAMPLE ? 2 : 3;
        u32x4 kk[KD][8];
#pragma unroll
        for (int d = 0; d < KD; ++d) {
#pragma unroll
            for (int u = 0; u < 8; ++u) { bool f32src; const void* rp = kv_row_ptr<SAMPLE>(p, bidx, list[32 * d + 4 * u + kg], g, false, f32src); kk[d][u] = ld8_kv<SAMPLE>(rp, f32src, 8 * n16); }
        }
#pragma unroll
        for (int kt = 0; kt < 8; ++kt) {
#pragma unroll
            for (int u = 0; u < 8; ++u) *(LAS3 u32x4*)(Vs + (4 * u + kg) * 320 + 16 * n16) = kk[kt % KD][u];
            asm volatile("" ::: "memory");
            if (kt + KD < 8) {
#pragma unroll
                for (int u = 0; u < 8; ++u) { bool f32src; const void* rp = kv_row_ptr<SAMPLE>(p, bidx, list[32 * (kt + KD) + 4 * u + kg], g, false, f32src); kk[kt % KD][u] = ld8_kv<SAMPLE>(rp, f32src, 8 * n16); }
            }
#pragma unroll
            for (int tl = 0; tl < 2; ++tl) {
                f32x4 acc = {0.f, 0.f, 0.f, 0.f};
#pragma unroll
                for (int s = 0; s < 4; ++s) acc = MFMA16(qf[s], ld_b128(Vs + (16 * tl + n16) * 320 + 64 * s + 16 * kg), acc);
                if (kg == 0) *(LAS3 f32x4*)(pw + (32 * kt + 16 * tl + n16) * 4) = acc;
            }
            asm volatile("" ::: "memory");
        }
    }
    asm volatile("" ::: "memory");
    const int nb = (nsel + 31) >> 5;
    constexpr int PD = SAMPLE ? 2 : 3;
    u32x4 vv[PD][8];
#pragma unroll
    for (int d = 0; d < PD; ++d) {
        if (d < nb) {
#pragma unroll
            for (int u = 0; u < 8; ++u) { bool f32src; const void* rp = kv_row_ptr<SAMPLE>(p, bidx, list[32 * d + 4 * u + kg], g, true, f32src); vv[d][u] = ld8_kv<SAMPLE>(rp, f32src, 8 * n16); }
        }
    }
#pragma unroll
    for (int hh = 0; hh < 4; ++hh) {
        float sc[4];
#pragma unroll
        for (int ks = 0; ks < 4; ++ks) sc[ks] = (64 * ks + lane < nsel) ? pw[(64 * ks + lane) * 4 + hh] : -3.0e38f;
        float m = fmaxf(fmaxf(sc[0], sc[1]), fmaxf(sc[2], sc[3]));
        m = wave_max(m);
        float e[4], sum = 0.f;
#pragma unroll
        for (int ks = 0; ks < 4; ++ks) { e[ks] = (64 * ks + lane < nsel) ? __expf(sc[ks] - m) : 0.f; sum += e[ks]; }
        sum = wave_sum(sum);
        const float inv = 1.0f / sum;
#pragma unroll
        for (int ks = 0; ks < 4; ++ks) *(LAS3 unsigned short*)(Pt + hh * 512 + 2 * (64 * ks + lane)) = (unsigned short)(pk2(e[ks] * inv, 0.f) & 0xffffu);
    }
    asm volatile("" ::: "memory");
    f32x4 o[8];
#pragma unroll
    for (int nt = 0; nt < 8; ++nt) o[nt] = (f32x4){0.f, 0.f, 0.f, 0.f};
    const int q4 = n16 >> 2, p4 = n16 & 3;
#pragma unroll
    for (int bt = 0; bt < 8; ++bt) {
        if (bt < nb) {
#pragma unroll
            for (int u = 0; u < 8; ++u) *(LAS3 u32x4*)(Vs + (4 * u + kg) * 320 + 16 * n16) = vv[bt % PD][u];
            asm volatile("" ::: "memory");
            if (bt + PD < nb) {
#pragma unroll
                for (int u = 0; u < 8; ++u) { bool f32src; const void* rp = kv_row_ptr<SAMPLE>(p, bidx, list[32 * (bt + PD) + 4 * u + kg], g, true, f32src); vv[bt % PD][u] = ld8_kv<SAMPLE>(rp, f32src, 8 * n16); }
            }
            u32x4 pa = *(LAS3 u32x4*)(Pt + (n16 & 3) * 512 + 2 * (32 * bt + 8 * kg));
            if (n16 >= 4) pa = zero4;
            const bf16x8 A = __builtin_bit_cast(bf16x8, pa);
            ldsp vb = Vs + (8 * kg + q4) * 320 + 8 * p4;
#pragma unroll
            for (int nt = 0; nt < 8; ++nt) o[nt] = MFMA16(A, ld_tr8(vb + 32 * nt, 4 * 320), o[nt]);
            asm volatile("" ::: "memory");
        }
    }
    if (kg == 0) {
#pragma unroll
        for (int nt = 0; nt < 8; ++nt)
#pragma unroll
            for (int j = 0; j < 4; ++j) p.ATTO[(size_t)r * 1024 + (4 * g + j) * 128 + 16 * nt + n16] = (bf16_t)(pk2(o[nt][j], 0.f) & 0xffffu);
    }
}
__device__ __forceinline__ int wave_sum_i(int v) {
    v += __builtin_amdgcn_update_dpp(0, v, 0xB1, 0xf, 0xf, true);
    v += __builtin_amdgcn_update_dpp(0, v, 0x4E, 0xf, 0xf, true);
    v += __builtin_amdgcn_update_dpp(0, v, 0x141, 0xf, 0xf, true);
    v += __builtin_amdgcn_update_dpp(0, v, 0x140, 0xf, 0xf, true);
    v += __builtin_amdgcn_update_dpp(0, v, 0x142, 0xa, 0xf, false);
    v += __builtin_amdgcn_update_dpp(0, v, 0x143, 0xc, 0xf, false);
    return __builtin_amdgcn_readlane(v, 63);
}
__device__ __forceinline__ void attn_query_wave(const Params& p, int b, int t, ldsp wl) {
    const int lane = opaque((int)threadIdx.x) & 63;
    LAS3 int* list = (LAS3 int*)wl;
    const int r = b * 4096 + t, nvalid = t + 1;
    int nsel;
    if (nvalid <= 256) {
#pragma unroll
        for (int i = 0; i < 4; ++i) { const int j = lane + 64 * i; list[j] = (j < nvalid) ? j : 0; }
        nsel = nvalid;
    } else {
        const int ngrp = (nvalid + 511) >> 9;
        const float* srow = p.SCO + (size_t)r * 4096;
        unsigned key[64];
#pragma unroll
        for (int gq = 0; gq < 8; ++gq) {
            if (gq < ngrp) {
#pragma unroll
                for (int s = 8 * gq; s < 8 * gq + 8; ++s) { const int j = 64 * s + lane; key[s] = (j < nvalid) ? fkey(__builtin_nontemporal_load(srow + j)) : 0u; }
            } else {
#pragma unroll
                for (int s = 8 * gq; s < 8 * gq + 8; ++s) key[s] = 0u;
            }
        }
        unsigned lo, hi; int clo = nvalid, chi = 0;
        {
            unsigned kmx = 0u, kmn = 0xffffffffu;
#pragma unroll
            for (int gq = 0; gq < 8; ++gq) {
                if (gq < ngrp) {
#pragma unroll
                    for (int s = 8 * gq; s < 8 * gq + 8; ++s) { kmx = kmx > key[s] ? kmx : key[s]; const unsigned kv = (64 * s + lane < nvalid) ? key[s] : 0xffffffffu; kmn = kmn < kv ? kmn : kv; }
                }
            }
#pragma unroll
            for (int o = 32; o >= 1; o >>= 1) { const unsigned a = (unsigned)__shfl_xor((int)kmx, o), b2 = (unsigned)__shfl_xor((int)kmn, o); kmx = kmx > a ? kmx : a; kmn = kmn < b2 ? kmn : b2; }
            lo = (unsigned)__builtin_amdgcn_readfirstlane((int)kmn); hi = (unsigned)__builtin_amdgcn_readfirstlane((int)kmx);
            if (hi != 0xffffffffu) hi += 1u; else chi = -1;
        }
        for (int it = 0; hi - lo > 1u; ++it) {
            const unsigned wdt = hi - lo;
            unsigned cand;
            if ((it & 1) || chi < 0 || wdt < 8u) cand = lo + (wdt >> 1);
            else {
                const float fr = (float)(clo - 256) / (float)(clo - chi);
                unsigned off = (unsigned)((float)wdt * fr);
                off = off < 1u ? 1u : off; off = off > wdt - 1u ? wdt - 1u : off;
                cand = lo + off;
            }
            int cl = 0;
#pragma unroll
            for (int gq = 0; gq < 8; ++gq) {
                if (gq < ngrp) {
#pragma unroll
                    for (int s = 8 * gq; s < 8 * gq + 8; ++s) cl += (key[s] >= cand) ? 1 : 0;
                }
            }
            const int c = wave_sum_i(cl);
            if (c >= 256) { lo = cand; clo = c; } else { hi = cand; chi = c; }
            if (c == 256) break;
        }
        int ngl = 0, nql = 0;
#pragma unroll
        for (int s = 0; s < 64; ++s) { ngl += (key[s] > lo) ? 1 : 0; nql += (key[s] == lo) ? 1 : 0; }
        const int need = 256 - wave_sum_i(ngl), neqt = wave_sum_i(nql);
        if (neqt == need) {
            int incl = ngl + nql;
#pragma unroll
            for (int d = 1; d < 64; d <<= 1) { const int t2 = __shfl_up(incl, d); if (lane >= d) incl += t2; }
            int pos = incl - (ngl + nql);
#pragma unroll
            for (int gq = 0; gq < 8; ++gq) {
                if (gq < ngrp) {
#pragma unroll
                    for (int s = 8 * gq; s < 8 * gq + 8; ++s) { if (key[s] >= lo) { list[pos] = 64 * s + lane; ++pos; } }
                }
            }
        } else {
            int nout = 0, neq = 0;
            const unsigned long long below = (lane == 0) ? 0ull : (~0ull >> (64 - lane));
#pragma unroll
            for (int gq = 0; gq < 8; ++gq) {
                if (gq < ngrp) {
#pragma unroll
                    for (int s = 8 * gq; s < 8 * gq + 8; ++s) {
                        const bool gt = key[s] > lo, eq = key[s] == lo;
                        const unsigned long long meq = __ballot(eq);
                        const bool take = gt || (eq && (neq + __popcll(meq & below)) < need);
                        const unsigned long long mt = __ballot(take);
                        if (take) list[nout + __popcll(mt & below)] = 64 * s + lane;
                        nout += __popcll(mt); neq += __popcll(meq);
                    }
                }
            }
        }
        nsel = 256;
    }
#pragma unroll 1
    for (int g = 0; g < 2; ++g) attend_unit<false>(p, r, b, g, list, nsel, wl);
}
__device__ __forceinline__ void attn_item(const Params& p, int qn, bool sample, unsigned char* smem) {
    unsigned* keys = (unsigned*)smem;
    int* sel = (int*)(keys + 16400);
    unsigned* red = (unsigned*)(sel + 256);
    const int tid = opaque((int)threadIdx.x), wid = tid >> 6, lane = tid & 63;
    const int b = qn >> 2, qpos = 16384 + (qn & 3), r = TP + qn;
    const int nvalid = qpos + 1;
    for (int s = tid; s < nvalid; s += NT) keys[s] = fkey(p.SS[(size_t)qn * 16392 + s]);
    __syncthreads();
    unsigned prefix = 0u;
    for (int bit = 31; bit >= 0; --bit) {
        const unsigned cand = prefix | (1u << bit);
        int c = 0;
        for (int s = tid; s < nvalid; s += NT) c += (keys[s] >= cand) ? 1 : 0;
        c = (int)wave_sum((float)c);
        if (lane == 0) red[wid] = (unsigned)c;
        __syncthreads();
        unsigned tot = 0;
#pragma unroll
        for (int w = 0; w < 8; ++w) tot += red[w];
        __syncthreads();
        if (tot >= 256u) prefix = cand;
        if (tot == 256u) break;
    }
    const unsigned thr = prefix;
    int c = 0;
    for (int s = tid; s < nvalid; s += NT) c += (keys[s] > thr) ? 1 : 0;
    c = (int)wave_sum((float)c);
    if (lane == 0) red[wid] = (unsigned)c;
    __syncthreads();
    int ngt = 0;
#pragma unroll
    for (int w = 0; w < 8; ++w) ngt += (int)red[w];
    const int need = 256 - ngt;
    if (wid == 0) {
        int nout = 0, neq = 0;
        for (int base = 0; base < nvalid; base += 64) {
            const int s = base + lane;
            const unsigned k = (s < nvalid) ? keys[s] : 0u;
            const bool gt = (s < nvalid) && (k > thr);
            const bool eq = (s < nvalid) && (k == thr);
            const unsigned long long meq = __ballot(eq);
            const unsigned long long below = (lane == 0) ? 0ull : (~0ull >> (64 - lane));
            const int eqrank = neq + __popcll(meq & below);
            const bool take = gt || (eq && eqrank < need);
            const unsigned long long mt = __ballot(take);
            if (take) sel[nout + __popcll(mt & below)] = s;
            nout += __popcll(mt);
            neq += __popcll(meq);
        }
    }
    __syncthreads();
}
__device__ __forceinline__ void attn_sample_units(const Params& p, int qn, unsigned char* smem) {
    const int tid_ = opaque((int)threadIdx.x), wid = tid_ >> 6, lane = tid_ & 63;
    ldsp priv = (ldsp)smem + wid * 17408;
    int mine[4];
    if (wid < 2) {
#pragma unroll
        for (int i = 0; i < 4; ++i) mine[i] = *(LAS3 int*)((ldsp)smem + 65600 + 4 * (lane + 64 * i));
    }
    __syncthreads();
    if (wid < 2) {
#pragma unroll
        for (int i = 0; i < 4; ++i) ((LAS3 int*)priv)[lane + 64 * i] = mine[i];
        attend_unit<true>(p, TP + qn, qn >> 2, wid, (LAS3 int*)priv, 256, priv);
    }
}
__device__ __forceinline__ void phase_attn(const Params& p, unsigned char* smem) {
    for (int it = blockIdx.x; it < TS; it += gridDim.x) { attn_item(p, it, true, smem); attn_sample_units(p, it, smem); __syncthreads(); }
}
__device__ __forceinline__ void phase_idx_scores(const Params& p, unsigned char* smem) {
    for (int it = blockIdx.x; it < 256; it += gridDim.x) idx_score_sample_item(p, it);
    {
        u32x4 qpre[16]; float2 wvp; f16x8 kf[2][4];
        int it = blockIdx.x;
        IdxChunk ck = idx_chunk_decode(it < 748 ? it : 0);
        if (it < 748) { idx_chunk_load_q(p, ck, qpre, wvp); idx_chunk_load_k(p, ck.b, ck.m0, kf); }
        for (; it < 748; it += gridDim.x) {
            const int nx = it + (int)gridDim.x; const bool has_next = nx < 748;
            const IdxChunk cn = idx_chunk_decode(has_next ? nx : 0);
            idx_score_chunk(p, ck, has_next, cn, qpre, wvp, kf, (ldsp)smem);
            ck = cn;
        }
    }
}
__device__ __forceinline__ void phase_attn_prompt(const Params& p, unsigned char* smem, bool has_sample) {
    const int tid_ = opaque((int)threadIdx.x), wl = tid_ >> 6, lane = tid_ & 63;
    if (has_sample) attn_sample_units(p, (int)blockIdx.x, smem);
    ldsp priv = (ldsp)smem + wl * 17408;
    unsigned* ctr = p.bar + 3600;
    for (;;) {
        unsigned pi = 0;
        if (lane == 0) pi = atomicAdd(ctr, 1u);
        pi = (unsigned)__builtin_amdgcn_readfirstlane((int)pi);
        if (pi >= 8192u) break;
        const int b = pi >> 11, tt = pi & 2047;
        attn_query_wave(p, b, tt, priv);
        attn_query_wave(p, b, 4095 - tt, priv);
    }
}

__device__ __forceinline__ unsigned med3u(unsigned a, unsigned b, unsigned c) { unsigned r; asm("v_med3_u32 %0, %1, %2, %3" : "=v"(r) : "v"(a), "v"(b), "v"(c)); return r; }
__device__ __forceinline__ void ins16(unsigned (&top)[16], unsigned x) {
#pragma unroll
    for (int j = 15; j >= 1; --j) top[j] = med3u(top[j - 1], top[j], x);
    top[0] = top[0] > x ? top[0] : x;
}
template <int NT0, int NT1>
__device__ __forceinline__ void peer_score_load(const Params& p, int item, u32x4 (&af)[8], u32x4 (&bf)[4][8]) {
    const int tid = opaque((int)threadIdx.x), lane = tid & 63, w = __builtin_amdgcn_readfirstlane(tid >> 6);
    const int tile = item >> 3, hd = item & 7, row0 = tile * 128;
    const int r31 = lane & 31, lh = lane >> 5, l = w >> 2, mt = w & 3;
    const char* ag = (const char*)(p.QP + (size_t)(row0 + 32 * mt + r31) * 2048 + hd * 256 + l * 128 + 8 * lh);
    if (NT0 == 0) {
#pragma unroll
        for (int s2 = 0; s2 < 8; ++s2) af[s2] = *(const u32x4*)(ag + 32 * s2);
    }
#pragma unroll
    for (int nt = NT0; nt < NT1; ++nt) {
        const char* bg = (const char*)(p.SUBK + (size_t)((hd * 2 + l) * 128 + 32 * nt + r31) * 128 + 8 * lh);
#pragma unroll
        for (int s2 = 0; s2 < 8; ++s2) bf[nt][s2] = *(const u32x4*)(bg + 32 * s2);
    }
}
__device__ __forceinline__ void peer_score_item(const Params& p, int item, int next_item, u32x4 (&af)[8], u32x4 (&bf)[4][8], ldsp lds) {
    const int tid = opaque((int)threadIdx.x), lane = tid & 63, w = __builtin_amdgcn_readfirstlane(tid >> 6);
    const int tile = item >> 3, hd = item & 7, row0 = tile * 128;
    constexpr int PT = 257;
    LAS3 float* sc = (LAS3 float*)lds;
    const int r31 = lane & 31, lh = lane >> 5;
    peer_score_load<2, 4>(p, item, af, bf);
    {
        const int l = w >> 2, mt = w & 3;
#pragma unroll
        for (int nt = 0; nt < 4; ++nt) {
            f32x16 a;
#pragma unroll
            for (int i = 0; i < 16; ++i) a[i] = 0.f;
#pragma unroll
            for (int s2 = 0; s2 < 8; ++s2) a = MFMA32(__builtin_bit_cast(bf16x8, af[s2]), __builtin_bit_cast(bf16x8, bf[nt][s2]), a);
#pragma unroll
            for (int reg = 0; reg < 16; ++reg) sc[(32 * mt + crow(reg, lh)) * PT + l * 128 + 32 * nt + r31] = a[reg];
        }
    }
    __syncthreads();
    if (next_item >= 0) peer_score_load<0, 2>(p, next_item, af, bf);
    const int part = tid & 1, tok = (tid >> 1) & 127, l = tid >> 8;
    unsigned top[16];
#pragma unroll
    for (int j = 0; j < 16; ++j) top[j] = 0u;
    {
        LAS3 float* base = sc + tok * PT + l * 128 + part;
#pragma unroll 4
        for (int e = 0; e < 64; ++e) {
            const int n = 2 * e + part;
            ins16(top, (fkey(base[2 * e]) & ~127u) | (unsigned)(127 - n));
        }
    }
    {
        unsigned oth[16];
#pragma unroll
        for (int j = 0; j < 16; ++j) oth[j] = (unsigned)__shfl_xor((int)top[j], 1);
#pragma unroll
        for (int j = 0; j < 16; ++j) ins16(top, oth[j]);
    }
    float tv[16]; int tix[16];
#pragma unroll
    for (int j = 0; j < 16; ++j) { tix[j] = 127 - (int)(top[j] & 127u); tv[j] = sc[tok * PT + l * 128 + tix[j]]; }
    __syncthreads();
    LAS3 float* TV = (LAS3 float*)lds;
    LAS3 int* TI = (LAS3 int*)(lds + 32768);
    if (part == 0) {
#pragma unroll
        for (int j = 0; j < 16; ++j) { TV[(tok * 2 + l) * 17 + j] = tv[j]; TI[(tok * 2 + l) * 17 + j] = tix[j]; }
    }
    __syncthreads();
    if (tid < 128) {
        const int tk = tid;
        float v1[16], v2[16];
#pragma unroll
        for (int j = 0; j < 16; ++j) { v1[j] = TV[(tk * 2) * 17 + j]; v2[j] = TV[(tk * 2 + 1) * 17 + j]; }
        unsigned ct[16];
#pragma unroll
        for (int j = 0; j < 16; ++j) ct[j] = 0u;
#pragma unroll
        for (int a = 0; a < 16; ++a)
#pragma unroll
            for (int b = 0; b < 16; ++b)
                if ((a + 1) * (b + 1) <= 16) ins16(ct, (fkey(v1[a] + v2[b]) & ~255u) | (unsigned)(255 - (a * 16 + b)));
        float sv[16]; int ei[16];
        float m = -3.0e38f;
#pragma unroll
        for (int j = 0; j < 16; ++j) {
            const int cidx = 255 - (int)(ct[j] & 255u), a = cidx >> 4, b = cidx & 15;
            sv[j] = TV[(tk * 2) * 17 + a] + TV[(tk * 2 + 1) * 17 + b];
            ei[j] = TI[(tk * 2) * 17 + a] * 128 + TI[(tk * 2 + 1) * 17 + b];
            m = fmaxf(m, sv[j]);
        }
        float sum = 0.f;
#pragma unroll
        for (int j = 0; j < 16; ++j) { sv[j] = __expf(sv[j] - m); sum += sv[j]; }
        const float inv = 1.0f / sum;
        int* eo = p.EIDX + (size_t)(row0 + tk) * 128 + hd * 16;
        float* go = p.GW + (size_t)(row0 + tk) * 128 + hd * 16;
#pragma unroll
        for (int j = 0; j < 16; j += 4) {
            *(int4*)(eo + j) = make_int4(ei[j], ei[j + 1], ei[j + 2], ei[j + 3]);
            *(float4*)(go + j) = make_float4(sv[j] * inv, sv[j + 1] * inv, sv[j + 2] * inv, sv[j + 3] * inv);
        }
    }
    __syncthreads();
}
__device__ __forceinline__ void phase_peer_score(const Params& p, unsigned char* smem) {
    u32x4 af[8], bf[4][8];
    int it = blockIdx.x;
    if (it < 129 * 8) peer_score_load<0, 2>(p, it, af, bf);
    for (; it < 129 * 8; it += gridDim.x) { const int nx = it + (int)gridDim.x; peer_score_item(p, it, nx < 129 * 8 ? nx : -1, af, bf, (ldsp)smem); }
}

__device__ __forceinline__ float dot2bf(unsigned a, unsigned b, float c) {
    typedef __bf16 bf2 __attribute__((ext_vector_type(2)));
    return __builtin_amdgcn_fdot2_f32_bf16(__builtin_bit_cast(bf2, a), __builtin_bit_cast(bf2, b), c, false);
}
typedef unsigned u32x3 __attribute__((ext_vector_type(3)));
typedef float f32x32 __attribute__((ext_vector_type(32)));
template <bool SPLIT>
__device__ __forceinline__ void gather_token(const Params& p, const int r, const int kb0, const int kb1, LAS3 float* xrow, const int (&pidx)[16], const int lane, const int wl) {
#pragma unroll
        for (int q = 0; q < 2; ++q) {
            const u32x4 xb = *(const u32x4*)(p.X1B + (size_t)r * 1024 + lane * 16 + 8 * q);
            *(LAS3 f32x4*)(xrow + lane * 16 + 8 * q) = (f32x4){__uint_as_float(xb[0] << 16), __uint_as_float(xb[0] & 0xffff0000u), __uint_as_float(xb[1] << 16), __uint_as_float(xb[1] & 0xffff0000u)};
            *(LAS3 f32x4*)(xrow + lane * 16 + 8 * q + 4) = (f32x4){__uint_as_float(xb[2] << 16), __uint_as_float(xb[2] & 0xffff0000u), __uint_as_float(xb[3] << 16), __uint_as_float(xb[3] & 0xffff0000u)};
        }
        asm volatile("" ::: "memory");
        float x[16];
#pragma unroll
        for (int m = 0; m < 16; ++m) x[m] = xrow[pidx[m]];
        const int e0 = p.EIDX[(size_t)r * 128 + lane], e1 = p.EIDX[(size_t)r * 128 + 64 + lane];
        const float g0 = p.GW[(size_t)r * 128 + lane], g1 = p.GW[(size_t)r * 128 + 64 + lane];
        float o[16];
#pragma unroll
        for (int i = 0; i < 16; ++i) o[i] = 0.f;
#pragma unroll 1
        for (int kb = kb0; kb < kb1; ++kb) {
            u32x3 uu[8], vv[8];
            const int esel = (kb < 8) ? e0 : e1;
#pragma unroll
            for (int j = 0; j < 8; ++j) {
                const int e = __builtin_amdgcn_readlane(esel, (kb * 8 + j) & 63);
                uu[j] = *(const u32x3*)(p.U8 + (size_t)e * 768 + lane * 12);
                vv[j] = *(const u32x3*)(p.V8 + (size_t)e * 768 + lane * 12);
            }
            float d[8];
#pragma unroll
            for (int j = 0; j < 8; j += 2) {
                const u32x6 w6 = {uu[j][0], uu[j][1], uu[j][2], uu[j + 1][0], uu[j + 1][1], uu[j + 1][2]};
                const f32x32 f = __builtin_amdgcn_cvt_scalef32_pk32_f32_fp6(w6, 1.0f);
                float t0 = 0.f, t1 = 0.f;
#pragma unroll
                for (int m = 0; m < 16; ++m) { t0 += x[m] * f[m]; t1 += x[m] * f[16 + m]; }
                d[j] = t0; d[j + 1] = t1;
            }
            float r4[4], r2[2], r1;
#pragma unroll
            for (int j = 0; j < 4; ++j) { const float keep = (lane & 1) ? d[2 * j + 1] : d[2 * j], send = (lane & 1) ? d[2 * j] : d[2 * j + 1]; r4[j] = keep + __shfl_xor(send, 1); }
#pragma unroll
            for (int j = 0; j < 2; ++j) { const float keep = (lane & 2) ? r4[2 * j + 1] : r4[2 * j], send = (lane & 2) ? r4[2 * j] : r4[2 * j + 1]; r2[j] = keep + __shfl_xor(send, 2); }
            { const float keep = (lane & 4) ? r2[1] : r2[0], send = (lane & 4) ? r2[0] : r2[1]; r1 = keep + __shfl_xor(send, 4); }
            r1 += __shfl_xor(r1, 8); r1 += __shfl_xor(r1, 16); r1 += __shfl_xor(r1, 32);
            const float gk = __shfl((kb < 8) ? g0 : g1, (kb * 8 + (lane & 7)) & 63);
            const float dt = r1 * (1.0f / 48.0f);
            const float wk = gk * 0.5f * dt * (1.0f + erff(dt * 0.7071067811865476f)) * (1.0f / 7.0f);
#pragma unroll
            for (int j = 0; j < 8; j += 2) {
                const float wa = __uint_as_float((unsigned)__builtin_amdgcn_readlane((int)__float_as_uint(wk), j));
                const float wb = __uint_as_float((unsigned)__builtin_amdgcn_readlane((int)__float_as_uint(wk), j + 1));
                const u32x6 w6 = {vv[j][0], vv[j][1], vv[j][2], vv[j + 1][0], vv[j + 1][1], vv[j + 1][2]};
                const f32x32 f = __builtin_amdgcn_cvt_scalef32_pk32_f32_fp6(w6, 1.0f);
#pragma unroll
                for (int m = 0; m < 16; ++m) o[m] += wa * f[m] + wb * f[16 + m];
            }
        }
        asm volatile("" ::: "memory");
#pragma unroll
        for (int m = 0; m < 16; ++m) xrow[pidx[m]] = o[m];
        asm volatile("" ::: "memory");
        if (SPLIT) { __syncthreads(); if (wl != 0) { __syncthreads(); return; } }
        float v[16];
        float sm = 0.f;
#pragma unroll
        for (int q = 0; q < 4; ++q) {
            f32x4 on = *(LAS3 f32x4*)(xrow + lane * 16 + 4 * q);
            if (SPLIT) {
#pragma unroll
                for (int w8 = 1; w8 < 8; ++w8) on += *(LAS3 f32x4*)(xrow + w8 * 2048 + lane * 16 + 4 * q);
            }
            const u32x2 pw_ = *(const u32x2*)(p.PLE + (size_t)r * 1024 + lane * 16 + 4 * q);
            float4 pl; pl.x = __uint_as_float(pw_[0] << 16); pl.y = __uint_as_float(pw_[0] & 0xffff0000u); pl.z = __uint_as_float(pw_[1] << 16); pl.w = __uint_as_float(pw_[1] & 0xffff0000u);
            const u32x2 xw = *(const u32x2*)(p.X1B + (size_t)r * 1024 + lane * 16 + 4 * q);
            float4 xn; xn.x = __uint_as_float(xw[0] << 16); xn.y = __uint_as_float(xw[0] & 0xffff0000u); xn.z = __uint_as_float(xw[1] << 16); xn.w = __uint_as_float(xw[1] & 0xffff0000u);
            v[4 * q] = ALPHA * xn.x + on[0] + pl.x; v[4 * q + 1] = ALPHA * xn.y + on[1] + pl.y;
            v[4 * q + 2] = ALPHA * xn.z + on[2] + pl.z; v[4 * q + 3] = ALPHA * xn.w + on[3] + pl.w;
            sm += (v[4 * q] + v[4 * q + 1]) + (v[4 * q + 2] + v[4 * q + 3]);
        }
        asm volatile("" ::: "memory");
        const float mean = wave_sum(sm) * (1.0f / 1024.0f);
        float sq = 0.f;
#pragma unroll
        for (int i = 0; i < 16; ++i) { const float dd = v[i] - mean; sq += dd * dd; }
        const float rstd = rsqrtf(wave_sum(sq) * (1.0f / 1024.0f) + LN_EPS);
        float* y = (r < TP) ? (p.y_prompt + (size_t)r * 1024) : (p.y_sample + (size_t)(r - TP) * 1024);
#pragma unroll
        for (int q = 0; q < 4; ++q) {
            const int c = lane * 16 + 4 * q;
            const float4 g4 = *(const float4*)(p.ln2_g + c), b4 = *(const float4*)(p.ln2_b + c);
            float4 ov; ov.x = (v[4 * q] - mean) * rstd * g4.x + b4.x; ov.y = (v[4 * q + 1] - mean) * rstd * g4.y + b4.y;
            ov.z = (v[4 * q + 2] - mean) * rstd * g4.z + b4.z; ov.w = (v[4 * q + 3] - mean) * rstd * g4.w + b4.w;
            *(float4*)(y + c) = ov;
        }
        if (SPLIT) __syncthreads();
}
__device__ __forceinline__ void phase_peer_gather(const Params& p, unsigned char* smem) {
    const int tid_ = opaque((int)threadIdx.x), lane = tid_ & 63, wl = tid_ >> 6;
    LAS3 float* xrow = (LAS3 float*)((ldsp)smem + wl * 8192);
    int pidx[16];
    {
        f32x16 fa, fb;
#pragma unroll
        for (int k = 0; k < 16; ++k) { fa[k] = (k < 8) ? 0.125f * k : (1.0f + 0.125f * (k & 7)); const int k2 = 16 + k; fb[k] = (1.0f + 0.125f * (k2 & 7)) * ((k2 < 24) ? 2.0f : 4.0f); }
        const u32x6 w6 = __builtin_amdgcn_cvt_scalef32_2xpk16_fp6_f32(fa, fb, 1.0f);
        const f32x32 rr = __builtin_amdgcn_cvt_scalef32_pk32_f32_fp6(w6, 1.0f);
        const int hsel = lane & 1;
#pragma unroll
        for (int m = 0; m < 16; ++m) {
            const float v = hsel ? rr[16 + m] : rr[m];
            const unsigned bits = __float_as_uint(v);
            const int kk = (v < 1.0f) ? (int)(v * 8.0f) : (8 * ((int)(bits >> 23) - 126) + (int)((bits >> 20) & 7u));
            pidx[m] = 32 * (lane >> 1) + kk;
        }
    }
    for (int r = blockIdx.x * 8 + wl; r < TP; r += gridDim.x * 8) gather_token<false>(p, r, 0, 16, xrow, pidx, lane, wl);
    for (int sb = blockIdx.x; sb < TS; sb += gridDim.x) gather_token<true>(p, TP + sb, 2 * wl, 2 * wl + 2, xrow, pidx, lane, wl);
}

struct SEpiBr1 { const bf16_t* G; bf16_t* O; __device__ __forceinline__ void operator()(int r, int c, float v) const { O[(size_t)r * 1024 + c] = f2bf(bf2f(G[(size_t)r * 1024 + c]) * v); } };
struct SEpiBr2 { const bf16_t* G; const bf16_t* I; bf16_t* O; __device__ __forceinline__ void operator()(int r, int c, float v) const { O[(size_t)r * 1024 + c] = f2bf(bf2f(I[(size_t)r * 1024 + c]) + bf2f(G[(size_t)r * 1024 + c]) * v); } };
struct SEpiF32 { bf16_t* O; __device__ __forceinline__ void operator()(int r, int c, float v) const { O[(size_t)r * 1024 + c] = f2bf(v); } };
struct SEpiOutV { const float* xs; bf16_t* O; __device__ __forceinline__ void operator()(int r, int c, float v) const { O[(size_t)r * 1024 + c] = f2bf(ALPHA * xs[(size_t)(r - TP) * 1024 + c] + v); } };
struct SEpiQG { bf16_t* QP; const bf16_t* PE; bf16_t* PLE;
    __device__ __forceinline__ void operator()(int r, int c, float v) const {
        if (c < 2048) QP[(size_t)r * 2048 + c] = f2bf(v);
        else { const size_t o = (size_t)r * 1024 + (c - 2048); PLE[o] = f2bf(sigmoidf_(v) * bf2f(PE[o])); } } };
template <class SE>
__device__ __forceinline__ void small_gemm(const bf16_t* A, int K, const bf16_t* Bt, int N, const SE& E, ldsp lds, int first, int stride) {
    const int tid = opaque((int)threadIdx.x), lane = tid & 63, w = __builtin_amdgcn_readfirstlane(tid >> 6);
    const int r31 = lane & 31, lh = lane >> 5;
    const int nitems = 4 * (N >> 5), ks = K >> 3;
    LAS3 float* part = (LAS3 float*)lds;
    for (int it = first; it < nitems; it += stride) {
        const int mt = it & 3, nt = it >> 2;
        const bf16_t* ap = A + (size_t)(TP + 32 * mt + r31) * K + w * ks + 8 * lh;
        const bf16_t* bp = Bt + (size_t)(32 * nt + r31) * K + w * ks + 8 * lh;
        f32x16 acc;
#pragma unroll
        for (int i = 0; i < 16; ++i) acc[i] = 0.f;
#pragma unroll 8
        for (int s = 0; s < ks; s += 16) {
            const bf16x8 a = __builtin_bit_cast(bf16x8, *(const u32x4*)(ap + s));
            const bf16x8 b = __builtin_bit_cast(bf16x8, *(const u32x4*)(bp + s));
            acc = MFMA32(a, b, acc);
        }
#pragma unroll
        for (int reg = 0; reg < 16; ++reg) part[(w * 32 + crow(reg, lh)) * 33 + r31] = acc[reg];
        __syncthreads();
#pragma unroll
        for (int h = 0; h < 2; ++h) {
            const int e = tid + 512 * h, rr = e >> 5, cc = e & 31;
            float v = 0.f;
#pragma unroll
            for (int ww = 0; ww < 8; ++ww) v += part[(ww * 32 + rr) * 33 + cc];
            E(TP + 32 * mt + rr, 32 * nt + cc, v);
        }
        __syncthreads();
    }
}

__global__ void __launch_bounds__(512, 2) mega(Params p) {
    extern __shared__ __attribute__((aligned(16))) unsigned char smem[];
    if (threadIdx.x == 0) *(uint4*)(smem + LDS_BAR) = make_uint4(0u, 0u, 0u, 0u);
    __syncthreads();
    XcdBarrier bar = xcd_barrier_post(p.bar, (volatile LAS unsigned*)(smem + LDS_BAR));
    PG8_LAS unsigned char* lds = (PG8_LAS unsigned char*)smem;
    const int G = (int)gridDim.x, c = (int)blockIdx.x;

    phase_prologue(p, smem);
    xcd_barrier(bar);
    {
        pg8::Gemm g{p.XB, p.WinT, MP, NINP, 1024};
        pg8::StaticOrder S; S.init(MP, NINP, G, c);
        EpiIn E{p};
        pg8::gemm_phase<EpiIn, pg8::StaticOrder, false>(lds, g, S, E, nullptr);
        const int nunits = (MP / 256) * (NINP / 256), rem = nunits % G;
        const int first = (rem > 0) ? rem : 0, nidle = G - first;
        if (c >= first) phase_peer_tables(p, (size_t)(c - first) * NT + threadIdx.x, (size_t)nidle * NT);
    }
    xcd_barrier(bar);
    phase_ret_scan(p, smem);
    phase_idx_scores(p, smem);
    xcd_barrier(bar);
    phase_ret_out(p, smem);
    phase_ret_gn(p);
    __syncthreads();
    {
        const bool one_each = (int)gridDim.x >= TS;
        const bool has_sample = one_each && (int)blockIdx.x < TS;
        if (!one_each) phase_attn(p, smem);
        else if (has_sample) attn_item(p, (int)blockIdx.x, true, smem);
        phase_attn_prompt(p, smem, has_sample);
    }
    xcd_barrier(bar);
    {
        const int sfirst = G - 1 - c;
        { SEpiBr1 E{p.GA, p.BRP}; small_gemm(p.RETO, 2048, p.WretT, 1024, E, (ldsp)smem, sfirst, G); }
        asm volatile("s_waitcnt vmcnt(0)" ::: "memory"); __syncthreads();
        { SEpiBr2 E{p.GB, p.BRP, p.BR}; small_gemm(p.ATTO, 1024, p.WattT, 1024, E, (ldsp)smem, sfirst, G); }
        { SEpiF32 E{(bf16_t*)p.PE}; small_gemm(p.PB, 256, p.WpleT, 1024, E, (ldsp)smem, sfirst, G); }
        pg8::StaticOrder S; S.init(TP, 1024, G, c);
        { pg8::Gemm g{p.RETO, p.WretT, TP, 1024, 2048}; EpiBr1 E{p.GA, p.BRP}; pg8::gemm_phase<EpiBr1, pg8::StaticOrder, false>(lds, g, S, E, nullptr); }
        asm volatile("s_waitcnt vmcnt(0)" ::: "memory"); __syncthreads();
        { pg8::Gemm g{p.ATTO, p.WattT, TP, 1024, 1024}; EpiBr2 E{p.GB, p.BRP, p.BR}; pg8::gemm_phase<EpiBr2, pg8::StaticOrder, false>(lds, g, S, E, nullptr); }
        asm volatile("s_waitcnt vmcnt(0)" ::: "memory"); __syncthreads();
        { pg8::Gemm g{p.PB, p.WpleT, TP, 1024, 256}; EpiF32 E{(bf16_t*)p.PE, 1024}; pg8::gemm_phase<EpiF32, pg8::StaticOrder, false>(lds, g, S, E, nullptr); }
    }
    xcd_barrier(bar);
    {
        { SEpiOutV E{p.x_sample, p.VPRE}; small_gemm(p.BR, 1024, p.WoutT, 1024, E, (ldsp)smem, G - 1 - c, G); }
        pg8::StaticOrder S; S.init(TP, 1024, G, c);
        pg8::Gemm g{p.BR, p.WoutT, TP, 1024, 1024}; EpiOutV E{p.x_prompt, p.x_sample, p.VPRE};
        pg8::gemm_phase<EpiOutV, pg8::StaticOrder, false>(lds, g, S, E, nullptr);
    }
    xcd_barrier(bar);
    phase_ln1(p);
    xcd_barrier(bar);
    {
        { SEpiQG E{p.QP, (const bf16_t*)p.PE, p.PLE}; small_gemm(p.X1B, 1024, p.WqgT, 3072, E, (ldsp)smem, G - 1 - c, G); }
        pg8::StaticOrder S; S.init(TP, 3072, G, c);
        pg8::Gemm g{p.X1B, p.WqgT, TP, 3072, 1024}; EpiQG E{p.QP, (const bf16_t*)p.PE, p.PLE};
        pg8::gemm_phase<EpiQG, pg8::StaticOrder, false>(lds, g, S, E, nullptr);
    }
    xcd_barrier(bar);
    phase_peer_score(p, smem);
    xcd_barrier(bar);
    phase_peer_gather(p, smem);
}
}

extern "C" void kernel_launch(void* const* d_in, const int* in_sizes, int n_in, void* d_out, int out_size, void* d_ws, size_t ws_size,
                              hipStream_t stream) {
    using namespace mk;
    Params p{};
    p.x_prompt = (const float*)d_in[0]; p.x_sample = (const float*)d_in[1]; p.cache_k = (const float*)d_in[2]; p.cache_v = (const float*)d_in[3];
    p.cache_kidx = (const float*)d_in[4]; p.state_ret = (const float*)d_in[5]; p.page_table = (const int*)d_in[6];
    p.p_prompt = (const float*)d_in[7]; p.p_sample = (const float*)d_in[8]; p.w_in = (const float*)d_in[9];
    p.idx_k_g = (const float*)d_in[10]; p.idx_k_b = (const float*)d_in[11]; p.gn_g = (const float*)d_in[12]; p.gn_b = (const float*)d_in[13];
    p.w_ret_o = (const float*)d_in[14]; p.w_att_o = (const float*)d_in[15]; p.w_out = (const float*)d_in[16];
    p.ln1_g = (const float*)d_in[17]; p.ln1_b = (const float*)d_in[18]; p.peer_wq = (const float*)d_in[19]; p.peer_subkeys = (const float*)d_in[20];
    p.peer_u = (const float*)d_in[21]; p.peer_v = (const float*)d_in[22]; p.w_ple_gate = (const float*)d_in[23]; p.w_ple = (const float*)d_in[24];
    p.ln2_g = (const float*)d_in[25]; p.ln2_b = (const float*)d_in[26];
    float* out = (float*)d_out;
    p.y_prompt = out; p.y_sample = p.y_prompt + 16777216; p.k_prompt = p.y_sample + 131072; p.v_prompt = p.k_prompt + 4194304;
    p.kidx_prompt = p.v_prompt + 4194304; p.ret_prompt = p.kidx_prompt + 1048576; p.k_sample = p.ret_prompt + 2097152;
    p.v_sample = p.k_sample + 32768; p.kidx_sample = p.v_sample + 32768; p.ret_sample = p.kidx_sample + 8192;

    unsigned char* w = (unsigned char*)d_ws;
    size_t off = 0;
    auto take = [&](size_t bytes) { unsigned char* r = w + off; off += (bytes + 255) & ~(size_t)255; return r; };
    p.bar = (unsigned*)take(16384);
    p.XB = (bf16_t*)take((size_t)MP * 1024 * 2); p.PB = (bf16_t*)take((size_t)MP * 256 * 2);
    p.WinT = (bf16_t*)take((size_t)NINP * 1024 * 2); p.WretT = (bf16_t*)take((size_t)1024 * 2048 * 2); p.WattT = (bf16_t*)take((size_t)1024 * 1024 * 2);
    p.WoutT = (bf16_t*)take((size_t)1024 * 1024 * 2); p.WqgT = (bf16_t*)take((size_t)3072 * 1024 * 2); p.WpleT = (bf16_t*)take((size_t)1024 * 256 * 2);
    p.c256 = (float*)take((size_t)NPOS * 128 * 4); p.s256 = (float*)take((size_t)NPOS * 128 * 4);
    p.c128 = (float*)take((size_t)NPOS * 64 * 4); p.s128 = (float*)take((size_t)NPOS * 64 * 4);
    p.c64 = (float*)take((size_t)NPOS * 32 * 4); p.s64 = (float*)take((size_t)NPOS * 32 * 4);
    p.RQ = (bf16_t*)take((size_t)MP * 1024 * 2); p.RK = (bf16_t*)take((size_t)MP * 1024 * 2);
    p.RV = (bf16_t*)take((size_t)MP * 2048 * 2); p.SG = (bf16_t*)take((size_t)MP * 2048 * 2);
    p.AQ = (bf16_t*)take((size_t)MP * 1024 * 2); p.AK = (bf16_t*)take((size_t)MP * 256 * 2); p.AV = (bf16_t*)take((size_t)MP * 256 * 2);
    p.GA = (bf16_t*)take((size_t)MP * 1024 * 2); p.GB = (bf16_t*)take((size_t)MP * 1024 * 2);
    p.IQ = (f16_t*)take((size_t)MP * 512 * 2); p.IK = (f16_t*)take((size_t)MP * 64 * 2); p.IW = (float*)take((size_t)MP * 8 * 4);
    p.RO = (float*)take((size_t)MP * 2048 * 4);
    p.SC = (bf16_t*)take((size_t)16 * 32 * 256 * 512 * 2);
    p.RETO = (bf16_t*)take((size_t)MP * 2048 * 2); p.ATTO = (bf16_t*)take((size_t)MP * 1024 * 2);
    p.BRP = (bf16_t*)take((size_t)MP * 1024 * 2); p.BR = (bf16_t*)take((size_t)MP * 1024 * 2);
    p.VPRE = (bf16_t*)take((size_t)MP * 1024 * 2); p.X1 = (float*)take((size_t)256);
    p.X1B = (bf16_t*)take((size_t)MP * 1024 * 2); p.QP = (bf16_t*)take((size_t)MP * 2048 * 2);
    p.PE = (float*)take((size_t)MP * 1024 * 4); p.PLE = (bf16_t*)take((size_t)MP * 1024 * 2);
    p.U8 = (unsigned char*)take((size_t)16384 * 1024); p.V8 = (unsigned char*)take((size_t)16384 * 1024); p.SUBK = (bf16_t*)take((size_t)16 * 128 * 128 * 2);
    p.EIDX = (int*)take((size_t)MP * 128 * 4); p.GW = (float*)take((size_t)MP * 128 * 4);
    p.SCO = (float*)take((size_t)TP * 4096 * 4); p.SS = (float*)take((size_t)TS * 16392 * 4);

    static int grid = 0;
    if (!grid) {
        int dev = 0, cus = 0;
        hipGetDevice(&dev);
        hipDeviceGetAttribute(&cus, hipDeviceAttributeMultiprocessorCount, dev);
        (void)hipFuncSetAttribute((const void*)mega, hipFuncAttributeMaxDynamicSharedMemorySize, LDS_TOTAL);
        grid = cus > 0 ? cus : 256;
        if (grid > 256) grid = 256;
    }
    (void)hipMemsetAsync(p.bar, 0, 16384, stream);
    hipLaunchKernelGGL(mega, dim3(grid), dim3(NT), LDS_TOTAL, stream, p);
}
```

```cpp
#include <hip/hip_runtime.h>
#include <stdint.h>
#include <math.h>

#define LAS3 __attribute__((address_space(3)))
typedef unsigned short bf16_t;
typedef _Float16 f16_t;

namespace mk {
constexpr int TP = 16384, TS = 128, T = 16512, MP = 16640;
constexpr int NIN = 10312, NINP = 10496;
constexpr int C_RQ = 0, C_RK = 1024, C_RV = 2048, C_RG = 4096, C_AQ = 6144, C_AK = 7168, C_AV = 7424,
              C_IQ = 7680, C_IK = 8192, C_IW = 8256, C_GA = 8264, C_GB = 9288;
constexpr float ALPHA = 1.189207115002721f;
constexpr float LN_EPS = 1e-5f;
constexpr int NPOS = 4100;
constexpr int LDS_TOTAL = 147456;
constexpr int LDS_BAR = LDS_TOTAL - 16;
constexpr int NT = 512;

__device__ __forceinline__ float wave_sum(float v) {
#pragma unroll
    for (int o = 32; o >= 1; o >>= 1) v += __shfl_xor(v, o);
    return v;
}
__device__ __forceinline__ float wave_max(float v) {
#pragma unroll
    for (int o = 32; o >= 1; o >>= 1) v = fmaxf(v, __shfl_xor(v, o));
    return v;
}
__device__ __forceinline__ bf16_t f2bf(float f) { unsigned u = __float_as_uint(f); u += 0x7FFFu + ((u >> 16) & 1u); return (bf16_t)(u >> 16); }
__device__ __forceinline__ float bf2f(bf16_t b) { return __uint_as_float(((unsigned)b) << 16); }
__device__ __forceinline__ unsigned pack_bf2(float lo, float hi) { return (unsigned)f2bf(lo) | ((unsigned)f2bf(hi) << 16); }
__device__ __forceinline__ float sigmoidf_(float x) { return __builtin_amdgcn_rcpf(1.0f + __builtin_amdgcn_exp2f(-1.4426950408889634f * x)); }
__device__ __forceinline__ int posidx_of_row(int r) { return (r < TP) ? (r & 4095) : ((r < T) ? (4096 + ((r - TP) & 3)) : 0); }
}
namespace pg8 {
#define PG8_LAS __attribute__((address_space(3)))
typedef unsigned short bf16_t;
typedef short bf16x8 __attribute__((ext_vector_type(8)));
typedef float f32x4 __attribute__((ext_vector_type(4)));
typedef unsigned u32x4 __attribute__((ext_vector_type(4)));
constexpr int BM = 256, BK = 64, HALF = 128, HTB = HALF * BK * 2  , STAGE_BYTES = 8 * HTB, NXCD = 8, WGM = 4;

__host__ __device__ __forceinline__ int lds_byte(int r, int c) { const int st = (r >> 4) * 2 + (c >> 5), rr = r & 15, cc = c & 31, ob = rr * 64 + cc * 2; return st * 1024 + (ob ^ (((ob >> 9) & 1) << 5)); }
__host__ __device__ __forceinline__ void stage_rc(int b, int& R, int& C) { const int st = b / 1024, sb = b % 1024, swz = sb ^ (((sb >> 9) & 1) << 5); R = (st >> 1) * 16 + swz / 64; C = (st & 1) * 32 + (swz % 64) / 2; }
__host__ __device__ __forceinline__ int perm32(int rho) { const int n = rho >> 4, i = rho & 15; return 8 * (i >> 2) + 4 * n + (i & 3); }

struct Unit { int pm, pn; };
struct Gemm { const bf16_t* A; const bf16_t* Bt; int M, N, K; };

struct StaticOrder {
    int nM, nN, nwg, G, c;
    __host__ __device__ void init(int M, int N, int G_, int c_) { nM = M / BM; nN = N / BM; nwg = nM * nN; G = G_; c = c_; }
    __host__ __device__ bool next(int i, Unit& u) const {
        const long L = (long)i * G + c; if (L >= nwg) return false;
        int wgid = (int)L; { const int q = nwg / NXCD, r = nwg % NXCD, xcd = wgid % NXCD, off = wgid / NXCD; wgid = (xcd < r ? xcd * (q + 1) : r * (q + 1) + (xcd - r) * q) + off; }
        const int nig = WGM * nN, gid = wgid / nig, fm = gid * WGM, gsz = (nM - fm) < WGM ? (nM - fm) : WGM;
        u.pm = fm + ((wgid % nig) % gsz); u.pn = (wgid % nig) / gsz; return true;
    }
    __device__ __forceinline__ void a_ready(const Unit&) const {}
    __device__ __forceinline__ void done(const Unit&) const {}
};
__device__ __forceinline__ unsigned cvt_pk_bf16(float lo, float hi) { unsigned r; asm volatile("v_cvt_pk_bf16_f32 %0, %1, %2" : "=v"(r) : "v"(lo), "v"(hi)); return r; }
template <class Epi, class Sched, bool STAMP = false>
__device__ __forceinline__ void gemm_phase(PG8_LAS unsigned char* lds, const Gemm g, const Sched& S, const Epi& E, unsigned long long* stamps) {
    const int tid = threadIdx.x, wid = __builtin_amdgcn_readfirstlane(tid >> 6), lane = tid & 63, wr = wid >> 2, wc = wid & 3, fr = lane & 15, fq = lane >> 4;
    const int K = g.K, nt = K / BK;
    int ts_lo = 0, ts_hi = 0, nts = 0; const unsigned long long rt_entry = STAMP ? (unsigned long long)wall_clock64() : 0ull;
#define PG8_STAMP() do { if (STAMP && wid == 0 && nts < 64) { const unsigned long long _c = (unsigned long long)clock64(); \
        ts_lo = (lane == nts) ? (int)(unsigned)_c : ts_lo; ts_hi = (lane == nts) ? (int)(unsigned)(_c >> 32) : ts_hi; ++nts; } } while (0)
    PG8_STAMP();
    unsigned voffA[2], voffB[2];
#pragma unroll
    for (int i = 0; i < 2; ++i) { int R, C; stage_rc(tid * 16 + i * 8192, R, C); const int Rb = Epi::PERM ? ((R & ~31) + perm32(R & 31)) : R;
        voffA[i] = (unsigned)(R * K + C) * 2u; voffB[i] = (unsigned)(Rb * K + C) * 2u; }
    const size_t kstep = (size_t)(BK * 2);
    const size_t hstep = (size_t)HALF * K * 2;
    const size_t tstep = 2 * hstep;
    const unsigned ldsw = (unsigned)wid * 1024u;
    const int aoff = lds_byte(wr * 64 + fr, fq * 8), boff = lds_byte(wc * 32 + fr, fq * 8);
#define PG8_SA(b, h) (((b) * 2 + (h)) * HTB)
#define PG8_SB(b, h) ((4 + (b) * 2 + (h)) * HTB)
#define PG8_STAGE(bufoff, gbase, voff) do { _Pragma("unroll") for (int _i = 0; _i < 2; ++_i) \
        __builtin_amdgcn_global_load_lds((const unsigned*)((const char*)(gbase) + (voff)[_i]), (PG8_LAS unsigned*)(lds + (bufoff) + ldsw + _i * 8192), 16, 0, 0); } while (0)
#define PG8_LDA(dst, b, h) do { _Pragma("unroll") for (int m = 0; m < 4; ++m) _Pragma("unroll") for (int k = 0; k < 2; ++k) dst[m][k] = *(const PG8_LAS bf16x8*)(lds + PG8_SA(b, h) + aoff + m * 2048 + k * 1024); } while (0)
#define PG8_LDB(dst, b, h) do { _Pragma("unroll") for (int n = 0; n < 2; ++n) _Pragma("unroll") for (int k = 0; k < 2; ++k) dst[n][k] = *(const PG8_LAS bf16x8*)(lds + PG8_SB(b, h) + boff + n * 2048 + k * 1024); } while (0)
#define PG8_MMA(ai, bj, At, Bt) do { __builtin_amdgcn_s_setprio(1); _Pragma("unroll") for (int m = 0; m < 4; ++m) _Pragma("unroll") for (int n = 0; n < 2; ++n) _Pragma("unroll") for (int k = 0; k < 2; ++k) \
        acc[ai][bj][m][n] = __builtin_amdgcn_mfma_f32_16x16x32_bf16(Bt[n][k], At[m][k], acc[ai][bj][m][n], 0, 0, 0); __builtin_amdgcn_s_setprio(0); } while (0)
#define PG8_WAIT_V(n) asm volatile("s_waitcnt vmcnt(" #n ")" ::: "memory")
#define PG8_WAIT_L(n) asm volatile("s_waitcnt lgkmcnt(" #n ")" ::: "memory")
#define PG8_BAR __builtin_amdgcn_s_barrier()
#define PG8_SCHED __builtin_amdgcn_sched_barrier(0)
    Unit cur, nxt; int ui = 0;
    if (!S.next(0, cur)) return;
    f32x4 acc[2][2][4][2];
#pragma unroll
    for (int a = 0; a < 2; ++a)
#pragma unroll
        for (int b = 0; b < 2; ++b)
#pragma unroll
            for (int m = 0; m < 4; ++m)
#pragma unroll
                for (int n = 0; n < 2; ++n) acc[a][b][m][n] = (f32x4){0.f, 0.f, 0.f, 0.f};
    bf16x8 At[4][2], B0[2][2], B1[2][2];
    const char* cA = (const char*)g.A + (size_t)cur.pm * tstep; const char* cB = (const char*)g.Bt + (size_t)cur.pn * tstep;
    S.a_ready(cur);
    PG8_STAGE(PG8_SB(0, 0), cB, voffB); PG8_STAGE(PG8_SA(0, 0), cA, voffA); PG8_STAGE(PG8_SB(0, 1), cB + hstep, voffB); PG8_STAGE(PG8_SA(0, 1), cA + hstep, voffA);
    if (wr == 1) PG8_BAR;
    PG8_WAIT_V(4); PG8_BAR;
    PG8_STAGE(PG8_SB(1, 0), cB + kstep, voffB); PG8_STAGE(PG8_SA(1, 0), cA + kstep, voffA); PG8_STAGE(PG8_SB(1, 1), cB + hstep + kstep, voffB);
    PG8_WAIT_V(6); PG8_BAR;
    PG8_STAMP();
    for (;;) {
        const bool has_next = S.next(ui + 1, nxt);
        const char* nA = has_next ? (const char*)g.A + (size_t)nxt.pm * tstep : cA; const char* nB = has_next ? (const char*)g.Bt + (size_t)nxt.pn * tstep : cB;
        for (int t = 0; t < nt; t += 2) {
            const bool last = (t == nt - 2);
            const char* a1 = cA + (size_t)(t + 1) * kstep;
            const char* a2 = last ? nA : cA + (size_t)(t + 2) * kstep; const char* b2 = last ? nB : cB + (size_t)(t + 2) * kstep;
            const char* a3 = a2 + kstep; const char* b3 = b2 + kstep;
            if (last && has_next) S.a_ready(nxt);
            PG8_LDB(B0, 0, 0); PG8_SCHED; PG8_LDA(At, 0, 0); PG8_STAGE(PG8_SA(1, 1), a1 + hstep, voffA);
            PG8_WAIT_L(8); PG8_BAR; PG8_WAIT_L(0); PG8_MMA(0, 0, At, B0); PG8_BAR; PG8_SCHED;
            PG8_LDB(B1, 0, 1); PG8_STAGE(PG8_SB(0, 0), b2, voffB);
            PG8_BAR; PG8_WAIT_L(0); PG8_MMA(0, 1, At, B1); PG8_BAR;
            PG8_LDA(At, 0, 1); PG8_STAGE(PG8_SA(0, 0), a2, voffA);
            PG8_BAR; PG8_WAIT_L(0); PG8_MMA(1, 0, At, B0); PG8_BAR; PG8_SCHED;
            PG8_STAGE(PG8_SB(0, 1), b2 + hstep, voffB);
            PG8_WAIT_V(6); PG8_BAR; PG8_MMA(1, 1, At, B1); PG8_BAR;
            PG8_LDB(B0, 1, 0); PG8_SCHED; PG8_LDA(At, 1, 0); PG8_STAGE(PG8_SA(0, 1), a2 + hstep, voffA);
            PG8_WAIT_L(8); PG8_BAR; PG8_WAIT_L(0); PG8_MMA(0, 0, At, B0); PG8_BAR; PG8_SCHED;
            PG8_LDB(B1, 1, 1); PG8_STAGE(PG8_SB(1, 0), b3, voffB);
            PG8_BAR; PG8_WAIT_L(0); PG8_MMA(0, 1, At, B1); PG8_BAR;
            PG8_LDA(At, 1, 1); PG8_STAGE(PG8_SA(1, 0), a3, voffA);
            PG8_BAR; PG8_WAIT_L(0); PG8_MMA(1, 0, At, B0); PG8_BAR; PG8_SCHED;
            PG8_STAGE(PG8_SB(1, 1), b3 + hstep, voffB);
            PG8_WAIT_V(6); PG8_BAR; PG8_MMA(1, 1, At, B1); PG8_BAR;
        }
        PG8_STAMP();
        if constexpr (!Epi::AFTER_DRAIN) { E(acc, cur, wr, wc, fr, fq); S.done(cur); }
        PG8_STAMP();
        if (!has_next) break;
#pragma unroll
        for (int a = 0; a < 2; ++a)
#pragma unroll
            for (int b = 0; b < 2; ++b)
#pragma unroll
                for (int m = 0; m < 4; ++m)
#pragma unroll
                    for (int n = 0; n < 2; ++n) acc[a][b][m][n] = (f32x4){0.f, 0.f, 0.f, 0.f};
        cur = nxt; cA = nA; cB = nB; ++ui;
    }
    PG8_WAIT_V(0);
    if (wr == 0) PG8_BAR;
    PG8_BAR;
    if constexpr (Epi::AFTER_DRAIN) { E.fused(acc, cur, wr, wc, fr, fq, lds, wid, lane); S.done(cur); }
    PG8_STAMP();
    if (STAMP && wid == 0) { stamps[lane] = lane < nts ? (((unsigned long long)(unsigned)ts_hi << 32) | (unsigned)ts_lo) : 0ull;
        if (lane == 62) stamps[62] = rt_entry; if (lane == 63) stamps[63] = (unsigned long long)wall_clock64(); }
#undef PG8_STAMP
#undef PG8_SA
#undef PG8_SB
#undef PG8_STAGE
#undef PG8_LDA
#undef PG8_LDB
#undef PG8_MMA
#undef PG8_WAIT_V
#undef PG8_WAIT_L
#undef PG8_BAR
#undef PG8_SCHED
}
}
#define XB_TMO      128
#define XB_XCNT(j)  (256  + 64 * (j))
#define XB_XSUB(j)  (1280 + 64 * (j))
#define XB_XGEN(j)  (2304 + 64 * (j))
#define XB_TOP      3328
#define XB_TOPGEN   3392
#define XCD_BAR_WORDS 3456
#define XB_SPIN_CAP (1u << 18)
#define LAS __attribute__((address_space(3)))

__device__ __forceinline__ unsigned xb_ld(unsigned* p)              { return __hip_atomic_load(p, __ATOMIC_RELAXED, __HIP_MEMORY_SCOPE_AGENT); }
__device__ __forceinline__ unsigned xb_add(unsigned* p, unsigned v) { return __hip_atomic_fetch_add(p, v, __ATOMIC_RELAXED, __HIP_MEMORY_SCOPE_AGENT); }
__device__ __forceinline__ unsigned xb_xcc_id() { return (unsigned)__builtin_amdgcn_s_getreg((3 << 11) | 20) & 0xFu; }
#define XB_SPIN(cond, bar) do { unsigned _sp = 0; while (cond) { __builtin_amdgcn_s_sleep(1); \
    if ((++_sp & 255u) == 0u) { if (xb_ld(&(bar)[XB_TMO])) break; if (_sp > XB_SPIN_CAP) { atomicAdd(&(bar)[XB_TMO], 1u); break; } } } } while (0)

struct XcdBarrier {
    unsigned* bar; unsigned x;
    volatile LAS unsigned* st;
};

__device__ __forceinline__ XcdBarrier xcd_barrier_post(unsigned* bar, volatile LAS unsigned* st) {
    XcdBarrier b; b.bar = bar; b.x = xb_xcc_id(); b.st = st;
    if (threadIdx.x == 0) (void)xb_add(&bar[XB_XCNT(b.x)], 1u);
    return b;
}
__device__ __forceinline__ void xcd_barrier_complete(unsigned* bar, unsigned x, unsigned& nloc, unsigned& nx) {
    const unsigned G = gridDim.x * gridDim.y * gridDim.z;
    unsigned sum, cnt, mine, sp = 0u;
    for (;;) {
        sum = 0u; cnt = 0u; mine = 0u;
#pragma unroll
        for (unsigned j = 0; j < 16; ++j) { const unsigned c = xb_ld(&bar[XB_XCNT(j)]); sum += c; cnt += (c > 0u) ? 1u : 0u; mine = (j == x) ? c : mine; }
        if (sum == G) break;
        __builtin_amdgcn_s_sleep(1);
        if ((++sp & 255u) == 0u) { if (xb_ld(&bar[XB_TMO])) break; if (sp > XB_SPIN_CAP) { atomicAdd(&bar[XB_TMO], 1u); break; } }
    }
    nloc = mine > 0u ? mine : 1u; nx = cnt > 0u ? cnt : 1u;
}

__device__ __forceinline__ void xcd_barrier(const XcdBarrier& b) {
    asm volatile("s_waitcnt vmcnt(0)" ::: "memory");
    __syncthreads();
    if (threadIdx.x == 0) {
        unsigned* bar = b.bar;
        __builtin_amdgcn_s_waitcnt(0);
        unsigned nloc = b.st[0], nx = b.st[1];
        if (nloc == 0u) { xcd_barrier_complete(bar, b.x, nloc, nx); b.st[0] = nloc; b.st[1] = nx; }
        const unsigned old = xb_add(&bar[XB_XSUB(b.x)], 1u);
        const unsigned gen = old / nloc;
        if (old + 1u == (gen + 1u) * nloc) {
            __builtin_amdgcn_fence(__ATOMIC_RELEASE, "agent");
            asm volatile("s_waitcnt vmcnt(0)" ::: "memory");
            const unsigned og = xb_add(&bar[XB_TOP], 1u);
            const unsigned tg = og / nx;
            if (og + 1u == (tg + 1u) * nx) xb_add(&bar[XB_TOPGEN], 1u);
            else XB_SPIN(xb_ld(&bar[XB_TOPGEN]) == tg, bar);
            __builtin_amdgcn_fence(__ATOMIC_ACQUIRE, "agent");
            xb_add(&bar[XB_XGEN(b.x)], 1u);
            asm volatile("s_waitcnt vmcnt(0)" ::: "memory");
        } else {
            XB_SPIN(xb_ld(&bar[XB_XGEN(b.x)]) == gen, bar);
            __builtin_amdgcn_fence(__ATOMIC_ACQUIRE, "agent");
            asm volatile("s_waitcnt vmcnt(0)" ::: "memory");
        }
    }
    __syncthreads();
}
namespace mk {
using pg8::f32x4;
using pg8::Unit;
using pg8::cvt_pk_bf16;
using pg8::u32x4;
typedef unsigned u32x2 __attribute__((ext_vector_type(2)));
typedef unsigned u32x6 __attribute__((ext_vector_type(6)));
typedef float f32x16 __attribute__((ext_vector_type(16)));
typedef _Float16 h16x4 __attribute__((ext_vector_type(4)));

__device__ __forceinline__ int opaque(int x) { asm volatile("" : "+v"(x)); return x; }
struct Params {
    const float *x_prompt, *x_sample, *cache_k, *cache_v, *cache_kidx, *state_ret;
    const int* page_table;
    const float *p_prompt, *p_sample, *w_in, *idx_k_g, *idx_k_b, *gn_g, *gn_b, *w_ret_o, *w_att_o, *w_out, *ln1_g, *ln1_b, *peer_wq,
        *peer_subkeys, *peer_u, *peer_v, *w_ple_gate, *w_ple, *ln2_g, *ln2_b;
    float *y_prompt, *y_sample, *k_prompt, *v_prompt, *kidx_prompt, *ret_prompt, *k_sample, *v_sample, *kidx_sample, *ret_sample;
    unsigned* bar;
    bf16_t *XB, *PB, *WinT, *WretT, *WattT, *WoutT, *WqgT, *WpleT;
    float *c256, *s256, *c128, *s128, *c64, *s64;
    bf16_t *RQ, *RK, *RV, *SG, *AQ, *AK, *AV, *GA, *GB;
    f16_t *IQ, *IK;
    float* IW;
    float* RO;
    bf16_t* SC;
    bf16_t *RETO, *ATTO;
    bf16_t* BRP;
    bf16_t* BR;
    bf16_t* VPRE;
    float* X1;
    bf16_t *X1B, *QP;
    float* PE;
    bf16_t* PLE;
    bf16_t* SUBK;
    unsigned char *U8, *V8;
    int* EIDX;
    float* GW;
    float *SCO, *SS;
};

__device__ __forceinline__ void store4_bf16(bf16_t* dst, const f32x4 v) {
    u32x2 w; w.x = cvt_pk_bf16(v[0], v[1]); w.y = cvt_pk_bf16(v[2], v[3]);
    *(u32x2*)dst = w;
}
__device__ __forceinline__ void store4_f16(f16_t* dst, const f32x4 v) {
    h16x4 h; h[0] = (_Float16)v[0]; h[1] = (_Float16)v[1]; h[2] = (_Float16)v[2]; h[3] = (_Float16)v[3];
    *(h16x4*)dst = h;
}
__device__ __forceinline__ f32x4 load4_bf16(const bf16_t* src) {
    const u32x2 g = *(const u32x2*)src;
    f32x4 r; r[0] = __uint_as_float(g.x << 16); r[1] = __uint_as_float(g.x & 0xffff0000u); r[2] = __uint_as_float(g.y << 16); r[3] = __uint_as_float(g.y & 0xffff0000u);
    return r;
}
__device__ __forceinline__ f32x4 sigmoid4(const f32x4 v) {
    f32x4 r; r[0] = sigmoidf_(v[0]); r[1] = sigmoidf_(v[1]); r[2] = sigmoidf_(v[2]); r[3] = sigmoidf_(v[3]); return r;
}

__device__ __forceinline__ int win_orig(int j) {
    const int pn = j >> 8, jj = j & 255, bj = jj >> 7, w = jj & 127;
    if (pn < 24) return j;
    if (pn < 28) { const int t = pn - 24, hh = w >> 6, i = w & 63; return C_AQ + (2 * t + hh) * 128 + bj * 64 + i; }
    if (pn == 28) { const int hh = w >> 6, i = w & 63; return C_AK + hh * 128 + bj * 64 + i; }
    if (pn == 29) return C_AV + jj;
    if (pn < 32) { const int t = pn - 30, hh = w >> 5, i = w & 31; return C_IQ + (4 * t + hh) * 64 + bj * 32 + i; }
    if (pn < 36) return C_GA + (pn - 32) * 256 + jj;
    if (pn < 40) return C_GB + (pn - 36) * 256 + jj;
    if (w < 32) return C_IK + bj * 32 + w;
    if (bj == 0 && w < 40) return C_IW + (w - 32);
    return -1;
}

__device__ __forceinline__ f32x4 rope_irev(int i0, float l2theta_over_half) {
    f32x4 r;
#pragma unroll
    for (int e = 0; e < 4; ++e) r[e] = __builtin_amdgcn_exp2f(-(float)(i0 + e) * l2theta_over_half) * 0.15915494309189535f;
    return r;
}
__device__ __forceinline__ void rope_cs(float posf, const f32x4 irev, f32x4& c, f32x4& s) {
#pragma unroll
    for (int e = 0; e < 4; ++e) {
        const float hi = posf * irev[e], lo = __builtin_fmaf(posf, irev[e], -hi);
        const float fr = __builtin_amdgcn_fractf(hi) + lo;
        c[e] = __builtin_amdgcn_cosf(fr); s[e] = __builtin_amdgcn_sinf(fr);
    }
}
__device__ __forceinline__ float posf_of_row(int r) { return (float)((r < TP) ? (r & 4095) : ((r < T) ? (16384 + ((r - TP) & 3)) : 0)); }
struct EpiIn {
    static constexpr bool PERM = false, AFTER_DRAIN = false;
    const Params& p;
    __device__ __forceinline__ void operator()(const f32x4 (&acc)[2][2][4][2], const Unit& u, int wr, int wc, int fr_in, int fq_in) const {
        int fr = fr_in, fq = fq_in; asm volatile("" : "+v"(fr), "+v"(fq));
        const int pn = u.pn;
        const int rbase = u.pm * 256 + wr * 64 + fr;
        const int wbase = wc * 32 + fq * 4;
        if (pn < 8) {
            const bool isk = pn >= 4; const int h = pn & 3; bf16_t* dst = isk ? p.RK : p.RQ; const float sc = isk ? 0.0625f : 1.0f;
#pragma unroll
            for (int ai = 0; ai < 2; ++ai)
#pragma unroll
                for (int m = 0; m < 4; ++m) {
                    const int r = rbase + ai * 128 + m * 16; const float posf = posf_of_row(r);
#pragma unroll
                    for (int n = 0; n < 2; ++n) {
                        const int w0 = wbase + 16 * n;
                        f32x4 c, s; rope_cs(posf, rope_irev(w0, 0.10381025296523008f), c, s);
                        const f32x4 x1 = acc[ai][0][m][n], x2 = acc[ai][1][m][n];
                        store4_bf16(dst + (size_t)r * 1024 + h * 256 + w0, (x1 * c - x2 * s) * sc);
                        store4_bf16(dst + (size_t)r * 1024 + h * 256 + 128 + w0, (x2 * c + x1 * s) * sc);
                    }
                }
        } else if (pn < 24) {
            const bool isg = pn >= 16; bf16_t* dst = isg ? p.SG : p.RV; const int cb = (isg ? pn - 16 : pn - 8) * 256;
#pragma unroll
            for (int ai = 0; ai < 2; ++ai)
#pragma unroll
                for (int m = 0; m < 4; ++m) {
                    const int r = rbase + ai * 128 + m * 16;
#pragma unroll
                    for (int bj = 0; bj < 2; ++bj)
#pragma unroll
                        for (int n = 0; n < 2; ++n) {
                            f32x4 v = acc[ai][bj][m][n];
                            if (isg) v = v * sigmoid4(v);
                            store4_bf16(dst + (size_t)r * 2048 + cb + bj * 128 + wbase + 16 * n, v);
                        }
                }
        } else if (pn < 29) {
            const bool isk = pn == 28; const int t = isk ? 0 : pn - 24; const float sc = isk ? 1.0f : 0.08838834764831845f;
#pragma unroll
            for (int ai = 0; ai < 2; ++ai)
#pragma unroll
                for (int m = 0; m < 4; ++m) {
                    const int r = rbase + ai * 128 + m * 16; const float posf = posf_of_row(r);
#pragma unroll
                    for (int n = 0; n < 2; ++n) {
                        const int w0 = wbase + 16 * n, hh = w0 >> 6, i0 = w0 & 63;
                        f32x4 c, s; rope_cs(posf, rope_irev(i0, 0.20762050593046015f), c, s);
                        const f32x4 x1 = acc[ai][0][m][n], x2 = acc[ai][1][m][n];
                        const f32x4 o1 = (x1 * c - x2 * s) * sc, o2 = (x2 * c + x1 * s) * sc;
                        if (!isk) {
                            bf16_t* d = p.AQ + (size_t)r * 1024 + (2 * t + hh) * 128 + i0;
                            store4_bf16(d, o1); store4_bf16(d + 64, o2);
                        } else {
                            bf16_t* d = p.AK + (size_t)r * 256 + hh * 128 + i0;
                            store4_bf16(d, o1); store4_bf16(d + 64, o2);
                            if (r < T) {
                                float* o = (r < TP) ? (p.k_prompt + (size_t)r * 256) : (p.k_sample + (size_t)(r - TP) * 256);
                                *(f32x4*)(o + hh * 128 + i0) = o1; *(f32x4*)(o + hh * 128 + 64 + i0) = o2;
                            }
                        }
                    }
                }
        } else if (pn == 29) {
#pragma unroll
            for (int ai = 0; ai < 2; ++ai)
#pragma unroll
                for (int m = 0; m < 4; ++m) {
                    const int r = rbase + ai * 128 + m * 16;
                    float* o = (r < TP) ? (p.v_prompt + (size_t)r * 256) : (p.v_sample + (size_t)(r - TP) * 256);
#pragma unroll
                    for (int bj = 0; bj < 2; ++bj)
#pragma unroll
                        for (int n = 0; n < 2; ++n) {
                            const int c = bj * 128 + wbase + 16 * n;
                            store4_bf16(p.AV + (size_t)r * 256 + c, acc[ai][bj][m][n]);
                            if (r < T) *(f32x4*)(o + c) = acc[ai][bj][m][n];
                        }
                }
        } else if (pn < 32) {
            const int t = pn - 30;
#pragma unroll
            for (int ai = 0; ai < 2; ++ai)
#pragma unroll
                for (int m = 0; m < 4; ++m) {
                    const int r = rbase + ai * 128 + m * 16; const float posf = posf_of_row(r);
#pragma unroll
                    for (int n = 0; n < 2; ++n) {
                        const int w0 = wbase + 16 * n, hh = w0 >> 5, i0 = w0 & 31;
                        f32x4 c, s; rope_cs(posf, rope_irev(i0, 0.4152410118609203f), c, s);
                        const f32x4 x1 = acc[ai][0][m][n], x2 = acc[ai][1][m][n];
                        f16_t* d = p.IQ + (size_t)r * 512 + (4 * t + hh) * 64 + i0;
                        store4_f16(d, x1 * c - x2 * s); store4_f16(d + 32, x2 * c + x1 * s);
                    }
                }
        } else if (pn < 40) {
            const bool isb = pn >= 36; bf16_t* dst = isb ? p.GB : p.GA; const int cb = (isb ? pn - 36 : pn - 32) * 256;
#pragma unroll
            for (int ai = 0; ai < 2; ++ai)
#pragma unroll
                for (int m = 0; m < 4; ++m) {
                    const int r = rbase + ai * 128 + m * 16;
#pragma unroll
                    for (int bj = 0; bj < 2; ++bj)
#pragma unroll
                        for (int n = 0; n < 2; ++n)
                            store4_bf16(dst + (size_t)r * 1024 + cb + bj * 128 + wbase + 16 * n, sigmoid4(acc[ai][bj][m][n]));
                }
        } else {
            if (wc == 0) {
#pragma unroll
                for (int ai = 0; ai < 2; ++ai)
#pragma unroll
                    for (int m = 0; m < 4; ++m) {
                        const int r = rbase + ai * 128 + m * 16; const int pi = posidx_of_row(r);
                        float s = 0.f;
#pragma unroll
                        for (int bj = 0; bj < 2; ++bj)
#pragma unroll
                            for (int n = 0; n < 2; ++n) { const f32x4 x = acc[ai][bj][m][n]; s += (x[0] + x[1]) + (x[2] + x[3]); }
                        s += __shfl_xor(s, 16); s += __shfl_xor(s, 32);
                        const float mean = s * (1.0f / 64.0f);
                        float q = 0.f;
#pragma unroll
                        for (int bj = 0; bj < 2; ++bj)
#pragma unroll
                            for (int n = 0; n < 2; ++n) { const f32x4 d = acc[ai][bj][m][n] - mean; q += (d[0] * d[0] + d[1] * d[1]) + (d[2] * d[2] + d[3] * d[3]); }
                        q += __shfl_xor(q, 16); q += __shfl_xor(q, 32);
                        const float rstd = rsqrtf(q * (1.0f / 64.0f) + LN_EPS);
                        float* ko = (r < TP) ? (p.kidx_prompt + (size_t)r * 64) : (p.kidx_sample + (size_t)(r - TP) * 64);
#pragma unroll
                        for (int n = 0; n < 2; ++n) {
                            const int w0 = wbase + 16 * n;
                            const f32x4 g1 = *(const f32x4*)(p.idx_k_g + w0), g2 = *(const f32x4*)(p.idx_k_g + 32 + w0);
                            const f32x4 b1 = *(const f32x4*)(p.idx_k_b + w0), b2 = *(const f32x4*)(p.idx_k_b + 32 + w0);
                            const f32x4 x1 = (acc[ai][0][m][n] - mean) * rstd * g1 + b1, x2 = (acc[ai][1][m][n] - mean) * rstd * g2 + b2;
                            f32x4 c, sn; rope_cs(posf_of_row(r), rope_irev(w0, 0.4152410118609203f), c, sn);
                            const f32x4 o1 = x1 * c - x2 * sn, o2 = x2 * c + x1 * sn;
                            store4_f16(p.IK + (size_t)r * 64 + w0, o1); store4_f16(p.IK + (size_t)r * 64 + 32 + w0, o2);
                            if (r < T) { *(f32x4*)(ko + w0) = o1; *(f32x4*)(ko + 32 + w0) = o2; }
                        }
                    }
            } else if (wc == 1 && fq < 2) {
#pragma unroll
                for (int ai = 0; ai < 2; ++ai)
#pragma unroll
                    for (int m = 0; m < 4; ++m) {
                        const int r = rbase + ai * 128 + m * 16;
                        *(f32x4*)(p.IW + (size_t)r * 8 + 4 * fq) = acc[ai][0][m][0] * (0.35355339059327373f * 0.125f);
                    }
            }
        }
    }
};

struct EpiBr1 {
    static constexpr bool PERM = false, AFTER_DRAIN = false;
    const bf16_t* G; bf16_t* O;
    __device__ __forceinline__ void operator()(const f32x4 (&acc)[2][2][4][2], const Unit& u, int wr, int wc, int fr_in, int fq_in) const {
        int fr = fr_in, fq = fq_in; asm volatile("" : "+v"(fr), "+v"(fq));
        const int rbase = u.pm * 256 + wr * 64 + fr, cbase = u.pn * 256 + wc * 32 + fq * 4;
#pragma unroll
        for (int ai = 0; ai < 2; ++ai) {
            u32x2 gv[4][2][2];
#pragma unroll
            for (int m = 0; m < 4; ++m)
#pragma unroll
                for (int bj = 0; bj < 2; ++bj)
#pragma unroll
                    for (int n = 0; n < 2; ++n) gv[m][bj][n] = *(const u32x2*)(G + (size_t)(rbase + ai * 128 + m * 16) * 1024 + cbase + bj * 128 + 16 * n);
            asm volatile("" ::: "memory");
#pragma unroll
            for (int m = 0; m < 4; ++m)
#pragma unroll
                for (int bj = 0; bj < 2; ++bj)
#pragma unroll
                    for (int n = 0; n < 2; ++n) {
                        const u32x2 g = gv[m][bj][n];
                        f32x4 gf; gf[0] = __uint_as_float(g.x << 16); gf[1] = __uint_as_float(g.x & 0xffff0000u); gf[2] = __uint_as_float(g.y << 16); gf[3] = __uint_as_float(g.y & 0xffff0000u);
                        store4_bf16(O + (size_t)(rbase + ai * 128 + m * 16) * 1024 + cbase + bj * 128 + 16 * n, gf * acc[ai][bj][m][n]);
                    }
            asm volatile("" ::: "memory");
        }
    }
};
struct EpiBr2 {
    static constexpr bool PERM = false, AFTER_DRAIN = false;
    const bf16_t* G; const bf16_t* I; bf16_t* O;
    __device__ __forceinline__ void operator()(const f32x4 (&acc)[2][2][4][2], const Unit& u, int wr, int wc, int fr_in, int fq_in) const {
        int fr = fr_in, fq = fq_in; asm volatile("" : "+v"(fr), "+v"(fq));
        const int rbase = u.pm * 256 + wr * 64 + fr, cbase = u.pn * 256 + wc * 32 + fq * 4;
#pragma unroll
        for (int ai = 0; ai < 2; ++ai)
#pragma unroll
            for (int mh = 0; mh < 2; ++mh) {
                u32x2 gv[2][2][2]; f32x4 iv[2][2][2];
#pragma unroll
                for (int m2 = 0; m2 < 2; ++m2)
#pragma unroll
                    for (int bj = 0; bj < 2; ++bj)
#pragma unroll
                        for (int n = 0; n < 2; ++n) {
                            const size_t o = (size_t)(rbase + ai * 128 + (2 * mh + m2) * 16) * 1024 + cbase + bj * 128 + 16 * n;
                            gv[m2][bj][n] = *(const u32x2*)(G + o); iv[m2][bj][n] = load4_bf16(I + o);
                        }
                asm volatile("" ::: "memory");
#pragma unroll
                for (int m2 = 0; m2 < 2; ++m2)
#pragma unroll
                    for (int bj = 0; bj < 2; ++bj)
#pragma unroll
                        for (int n = 0; n < 2; ++n) {
                            const size_t o = (size_t)(rbase + ai * 128 + (2 * mh + m2) * 16) * 1024 + cbase + bj * 128 + 16 * n;
                            const u32x2 g = gv[m2][bj][n];
                            f32x4 gf; gf[0] = __uint_as_float(g.x << 16); gf[1] = __uint_as_float(g.x & 0xffff0000u); gf[2] = __uint_as_float(g.y << 16); gf[3] = __uint_as_float(g.y & 0xffff0000u);
                            store4_bf16(O + o, iv[m2][bj][n] + gf * acc[ai][2 * 0 + bj][2 * mh + m2][n]);
                        }
                asm volatile("" ::: "memory");
            }
    }
};
struct EpiF32 {
    static constexpr bool PERM = false, AFTER_DRAIN = false;
    float* O; int ldc;
    __device__ __forceinline__ void operator()(const f32x4 (&acc)[2][2][4][2], const Unit& u, int wr, int wc, int fr_in, int fq_in) const {
        int fr = fr_in, fq = fq_in; asm volatile("" : "+v"(fr), "+v"(fq));
        const int rbase = u.pm * 256 + wr * 64 + fr, cbase = u.pn * 256 + wc * 32 + fq * 4;
#pragma unroll
        for (int ai = 0; ai < 2; ++ai)
#pragma unroll
            for (int m = 0; m < 4; ++m) {
                const size_t ro = (size_t)(rbase + ai * 128 + m * 16) * ldc;
#pragma unroll
                for (int bj = 0; bj < 2; ++bj)
#pragma unroll
                    for (int n = 0; n < 2; ++n) *(f32x4*)(O + ro + cbase + bj * 128 + 16 * n) = acc[ai][bj][m][n];
            }
    }
};
struct EpiOutV {
    static constexpr bool PERM = false, AFTER_DRAIN = false;
    const float *xp, *xs; bf16_t* O;
    __device__ __forceinline__ void operator()(const f32x4 (&acc)[2][2][4][2], const Unit& u, int wr, int wc, int fr_in, int fq_in) const {
        int fr = fr_in, fq = fq_in; asm volatile("" : "+v"(fr), "+v"(fq));
        const int rbase = u.pm * 256 + wr * 64 + fr, cbase = u.pn * 256 + wc * 32 + fq * 4;
#pragma unroll
        for (int ai = 0; ai < 2; ++ai)
#pragma unroll
            for (int mh = 0; mh < 2; ++mh) {
                f32x4 xv[2][2][2];
#pragma unroll
                for (int m2 = 0; m2 < 2; ++m2)
#pragma unroll
                    for (int bj = 0; bj < 2; ++bj)
#pragma unroll
                        for (int n = 0; n < 2; ++n) {
                            const int r = rbase + ai * 128 + (2 * mh + m2) * 16;
                            xv[m2][bj][n] = (r < TP) ? *(const f32x4*)(xp + (size_t)r * 1024 + cbase + bj * 128 + 16 * n) : (f32x4){0.f, 0.f, 0.f, 0.f};
                        }
                asm volatile("" ::: "memory");
#pragma unroll
                for (int m2 = 0; m2 < 2; ++m2)
#pragma unroll
                    for (int bj = 0; bj < 2; ++bj)
#pragma unroll
                        for (int n = 0; n < 2; ++n) {
                            const int r = rbase + ai * 128 + (2 * mh + m2) * 16;
                            store4_bf16(O + (size_t)r * 1024 + cbase + bj * 128 + 16 * n, xv[m2][bj][n] * ALPHA + acc[ai][bj][2 * mh + m2][n]);
                        }
                asm volatile("" ::: "memory");
            }
    }
};
struct EpiQG {
    static constexpr bool PERM = false, AFTER_DRAIN = false;
    bf16_t* QP; const float* PE; bf16_t* PLE;
    __device__ __forceinline__ void operator()(const f32x4 (&acc)[2][2][4][2], const Unit& u, int wr, int wc, int fr_in, int fq_in) const {
        int fr = fr_in, fq = fq_in; asm volatile("" : "+v"(fr), "+v"(fq));
        const int rbase = u.pm * 256 + wr * 64 + fr, cbase = u.pn * 256 + wc * 32 + fq * 4;
        if (u.pn < 8) {
#pragma unroll
            for (int ai = 0; ai < 2; ++ai)
#pragma unroll
                for (int m = 0; m < 4; ++m) {
                    const int r = rbase + ai * 128 + m * 16;
#pragma unroll
                    for (int bj = 0; bj < 2; ++bj)
#pragma unroll
                        for (int n = 0; n < 2; ++n) store4_bf16(QP + (size_t)r * 2048 + cbase + bj * 128 + 16 * n, acc[ai][bj][m][n]);
                }
        } else {
#pragma unroll
            for (int ai = 0; ai < 2; ++ai)
#pragma unroll
                for (int mh = 0; mh < 2; ++mh) {
                    f32x4 pv[2][2][2];
#pragma unroll
                    for (int m2 = 0; m2 < 2; ++m2)
#pragma unroll
                        for (int bj = 0; bj < 2; ++bj)
#pragma unroll
                            for (int n = 0; n < 2; ++n) pv[m2][bj][n] = *(const f32x4*)(PE + (size_t)(rbase + ai * 128 + (2 * mh + m2) * 16) * 1024 + (cbase - 2048) + bj * 128 + 16 * n);
                    asm volatile("" ::: "memory");
#pragma unroll
                    for (int m2 = 0; m2 < 2; ++m2)
#pragma unroll
                        for (int bj = 0; bj < 2; ++bj)
#pragma unroll
                            for (int n = 0; n < 2; ++n)
                                store4_bf16(PLE + (size_t)(rbase + ai * 128 + (2 * mh + m2) * 16) * 1024 + (cbase - 2048) + bj * 128 + 16 * n, sigmoid4(acc[ai][bj][2 * mh + m2][n]) * pv[m2][bj][n]);
                    asm volatile("" ::: "memory");
                }
        }
    }
};

__device__ __forceinline__ void phase_peer_tables(const Params& p, size_t gtid, size_t gstride) {
    for (size_t i = gtid; i < (size_t)2 * 16384 * 32; i += gstride) {
        const bool isv = i >= (size_t)16384 * 32;
        const size_t j = isv ? i - (size_t)16384 * 32 : i;
        const float* src = (isv ? p.peer_v : p.peer_u) + j * 32;
        const float sc = isv ? 7.0f : 48.0f;
        f32x16 fa, fb;
#pragma unroll
        for (int q = 0; q < 4; ++q) {
            const float4 a = *(const float4*)(src + 4 * q), b = *(const float4*)(src + 16 + 4 * q);
            fa[4 * q] = a.x * sc; fa[4 * q + 1] = a.y * sc; fa[4 * q + 2] = a.z * sc; fa[4 * q + 3] = a.w * sc;
            fb[4 * q] = b.x * sc; fb[4 * q + 1] = b.y * sc; fb[4 * q + 2] = b.z * sc; fb[4 * q + 3] = b.w * sc;
        }
        const u32x6 w6 = __builtin_amdgcn_cvt_scalef32_2xpk16_fp6_f32(fa, fb, 1.0f);
        unsigned* dst = (unsigned*)((isv ? p.V8 : p.U8) + j * 24);
        *(u32x2*)dst = (u32x2){w6[0], w6[1]}; *(u32x2*)(dst + 2) = (u32x2){w6[2], w6[3]}; *(u32x2*)(dst + 4) = (u32x2){w6[4], w6[5]};
    }
    for (size_t i = gtid; i < (size_t)32768; i += gstride) {
        const float4 a = *(const float4*)(p.peer_subkeys + i * 8), b = *(const float4*)(p.peer_subkeys + i * 8 + 4);
        uint4 o; o.x = pack_bf2(a.x, a.y); o.y = pack_bf2(a.z, a.w); o.z = pack_bf2(b.x, b.y); o.w = pack_bf2(b.z, b.w);
        *(uint4*)(p.SUBK + i * 8) = o;
    }
}

__device__ __forceinline__ void phase_prologue(const Params& p, unsigned char* smem) {
    const int tid = opaque((int)threadIdx.x);
    const size_t gtid = (size_t)blockIdx.x * NT + tid, gstride = (size_t)gridDim.x * NT;
    for (size_t i = gtid; i < (size_t)MP * 128; i += gstride) {
        const int r = (int)(i >> 7), c8 = (int)(i & 127);
        uint4 o = make_uint4(0u, 0u, 0u, 0u);
        if (r < T) {
            const float* src = (r < TP) ? (p.x_prompt + (size_t)r * 1024) : (p.x_sample + (size_t)(r - TP) * 1024);
            const float4 a = *(const float4*)(src + c8 * 8), b = *(const float4*)(src + c8 * 8 + 4);
            o.x = pack_bf2(a.x, a.y); o.y = pack_bf2(a.z, a.w); o.z = pack_bf2(b.x, b.y); o.w = pack_bf2(b.z, b.w);
        }
        *(uint4*)(p.XB + (size_t)r * 1024 + c8 * 8) = o;
    }
    for (size_t i = gtid; i < (size_t)MP * 32; i += gstride) {
        const int r = (int)(i >> 5), c8 = (int)(i & 31);
        uint4 o = make_uint4(0u, 0u, 0u, 0u);
        if (r < T) {
            const float* src = (r < TP) ? (p.p_prompt + (size_t)r * 256) : (p.p_sample + (size_t)(r - TP) * 256);
            const float4 a = *(const float4*)(src + c8 * 8), b = *(const float4*)(src + c8 * 8 + 4);
            o.x = pack_bf2(a.x, a.y); o.y = pack_bf2(a.z, a.w); o.z = pack_bf2(b.x, b.y); o.w = pack_bf2(b.z, b.w);
        }
        *(uint4*)(p.PB + (size_t)r * 256 + c8 * 8) = o;
    }
    float* tile = (float*)smem;
    for (int task = blockIdx.x; task < 4480; task += gridDim.x) {
        const float* src; bf16_t* dst; int K, N, ntk, t, mapped = 0;
        if (task < 2624) { t = task; src = p.w_in; dst = p.WinT; K = 1024; N = NIN; ntk = 16; mapped = 1; }
        else if (task < 3136) { t = task - 2624; src = p.w_ret_o; dst = p.WretT; K = 2048; N = 1024; ntk = 32; }
        else if (task < 3392) { t = task - 3136; src = p.w_att_o; dst = p.WattT; K = 1024; N = 1024; ntk = 16; }
        else if (task < 3648) { t = task - 3392; src = p.w_out; dst = p.WoutT; K = 1024; N = 1024; ntk = 16; }
        else if (task < 4160) { t = task - 3648; src = p.peer_wq; dst = p.WqgT; K = 1024; N = 2048; ntk = 16; }
        else if (task < 4416) { t = task - 4160; src = p.w_ple_gate; dst = p.WqgT + (size_t)2048 * 1024; K = 1024; N = 1024; ntk = 16; }
        else { t = task - 4416; src = p.w_ple; dst = p.WpleT; K = 256; N = 1024; ntk = 4; }
        const int j0 = (t / ntk) * 64, k0 = (t % ntk) * 64;
        {
            const int jj = tid & 63, kk0 = tid >> 6;
            const int oc = mapped ? win_orig(j0 + jj) : (j0 + jj);
#pragma unroll
            for (int i = 0; i < 8; ++i) {
                const int kk = kk0 + 8 * i;
                tile[kk * 65 + jj] = (oc >= 0) ? src[(size_t)(k0 + kk) * N + oc] : 0.f;
            }
        }
        __syncthreads();
        {
            const int kk2 = (tid & 31) * 2, jj2 = tid >> 5;
#pragma unroll
            for (int i = 0; i < 4; ++i) {
                const int jj = jj2 + 16 * i;
                *(unsigned*)(dst + (size_t)(j0 + jj) * K + k0 + kk2) = pack_bf2(tile[kk2 * 65 + jj], tile[(kk2 + 1) * 65 + jj]);
            }
        }
        __syncthreads();
    }
}

typedef short s16x4 __attribute__((ext_vector_type(4)));
typedef short bf16x8 __attribute__((ext_vector_type(8)));
typedef float f32x16 __attribute__((ext_vector_type(16)));
typedef float f32x2v __attribute__((ext_vector_type(2)));
typedef __bf16 bf16v2 __attribute__((ext_vector_type(2)));
typedef LAS3 unsigned char* ldsp;
__device__ __forceinline__ unsigned pk2(float a, float b) { const f32x2v v = {a, b}; const bf16v2 r = __builtin_convertvector(v, bf16v2); return __builtin_bit_cast(unsigned, r); }
__device__ __forceinline__ bf16x8 ld_tr8(ldsp lo, int hi_delta) {
    const s16x4 a = __builtin_amdgcn_ds_read_tr16_b64_v4i16((LAS3 s16x4*)lo);
    const s16x4 b = __builtin_amdgcn_ds_read_tr16_b64_v4i16((LAS3 s16x4*)(lo + hi_delta));
    return __builtin_shufflevector(a, b, 0, 1, 2, 3, 4, 5, 6, 7);
}
__device__ __forceinline__ bf16x8 ld_b128(ldsp a) { return *(LAS3 bf16x8*)a; }
#define MFMA32(a, b, c) __builtin_amdgcn_mfma_f32_32x32x16_bf16((a), (b), (c), 0, 0, 0)
__device__ __forceinline__ int crow(int reg, int lh) { return (reg & 3) + 8 * (reg >> 2) + 4 * lh; }
__device__ __forceinline__ u32x4 scale8_bf16(u32x4 v, float d) {
    u32x4 o;
    o.x = pk2(__uint_as_float(v.x << 16) * d, __uint_as_float(v.x & 0xffff0000u) * d);
    o.y = pk2(__uint_as_float(v.y << 16) * d, __uint_as_float(v.y & 0xffff0000u) * d);
    o.z = pk2(__uint_as_float(v.z << 16) * d, __uint_as_float(v.z & 0xffff0000u) * d);
    o.w = pk2(__uint_as_float(v.w << 16) * d, __uint_as_float(v.w & 0xffff0000u) * d);
    return o;
}

__device__ __forceinline__ void ret_state_item(const Params& p, int item, ldsp lds) {
    const int tid = opaque((int)threadIdx.x), lane = tid & 63, w = __builtin_amdgcn_readfirstlane(tid >> 6);
    const int bh = item >> 4, dkh = (item >> 3) & 1, dvs = item & 7, b = bh >> 2, hd = bh & 3;
    const float l2g = log2f(1.0f - exp2f(-5.0f - (float)hd));
    constexpr int PK = 320, PV = 192;
    ldsp KT = lds, VS = lds + 128 * PK;
    const int r31 = lane & 31, lh = lane >> 5, q = (lane & 15) >> 2, p4 = lane & 3, blk = (lane >> 4) & 1;
    const int dkt = w >> 1, dvt = w & 1;
    const int offA = (8 * lh + q) * PK + 2 * (32 * dkt + 16 * blk + 4 * p4);
    const int offB = (8 * lh + q) * PV + 2 * (32 * dvt + 16 * blk + 4 * p4);
    f32x16 acc;
#pragma unroll
    for (int i = 0; i < 16; ++i) acc[i] = 0.f;
    const float gC = exp2f(128.0f * l2g);
    const bf16_t* kbase = p.RK + (size_t)(b * 4096) * 1024 + hd * 256 + dkh * 128;
    const bf16_t* vbase = p.RV + (size_t)(b * 4096) * 2048 + hd * 512 + dvs * 64;
    u32x4 kreg[4], vreg[2];
#pragma unroll
    for (int i = 0; i < 4; ++i) { const int id = tid + 512 * i, tok = id >> 4, pc = id & 15; kreg[i] = *(const u32x4*)(kbase + (size_t)tok * 1024 + pc * 8); }
#pragma unroll
    for (int i = 0; i < 2; ++i) { const int id = tid + 512 * i, tok = id >> 3, pc = id & 7; vreg[i] = *(const u32x4*)(vbase + (size_t)tok * 2048 + pc * 8); }
    for (int c = 0; c < 32; ++c) {
#pragma unroll
        for (int i = 0; i < 4; ++i) { const int id = tid + 512 * i, tok = id >> 4, pc = id & 15; *(LAS3 u32x4*)(KT + tok * PK + pc * 16) = kreg[i]; }
#pragma unroll
        for (int i = 0; i < 2; ++i) { const int id = tid + 512 * i, tok = id >> 3, pc = id & 7;
            *(LAS3 u32x4*)(VS + tok * PV + pc * 16) = scale8_bf16(vreg[i], exp2f((float)(127 - tok) * l2g)); }
        __syncthreads();
        if (c + 1 < 32) {
#pragma unroll
            for (int i = 0; i < 4; ++i) { const int id = tid + 512 * i, tok = id >> 4, pc = id & 15; kreg[i] = *(const u32x4*)(kbase + (size_t)((c + 1) * 128 + tok) * 1024 + pc * 8); }
#pragma unroll
            for (int i = 0; i < 2; ++i) { const int id = tid + 512 * i, tok = id >> 3, pc = id & 7; vreg[i] = *(const u32x4*)(vbase + (size_t)((c + 1) * 128 + tok) * 2048 + pc * 8); }
        }
        bf16_t* sc = p.SC + ((size_t)(bh * 32 + c) * 256 + dkh * 128 + dkt * 32) * 512 + dvs * 64 + dvt * 32 + r31;
#pragma unroll
        for (int reg = 0; reg < 16; ++reg) sc[(size_t)crow(reg, lh) * 512] = (bf16_t)(pk2(acc[reg], 0.f) & 0xffffu);
        acc = acc * gC;
#pragma unroll
        for (int s = 0; s < 8; ++s) {
            const bf16x8 A = ld_tr8(KT + offA + 16 * s * PK, 4 * PK);
            const bf16x8 B = ld_tr8(VS + offB + 16 * s * PV, 4 * PV);
            acc = MFMA32(A, B, acc);
        }
        __syncthreads();
    }
    float* so = p.ret_prompt + ((size_t)bh * 256 + dkh * 128 + dkt * 32) * 512 + dvs * 64 + dvt * 32 + r31;
#pragma unroll
    for (int reg = 0; reg < 16; ++reg) so[(size_t)crow(reg, lh) * 512] = acc[reg];
}

__device__ __forceinline__ void ret_out_item(const Params& p, int item, ldsp lds) {
    const int tid = opaque((int)threadIdx.x), lane = tid & 63, w = __builtin_amdgcn_readfirstlane(tid >> 6);
    const int bh = item >> 5, c = item & 31, b = bh >> 2, hd = bh & 3;
    const float l2g = log2f(1.0f - exp2f(-5.0f - (float)hd));
    constexpr int PQ = 528, PS = 1088, SLB = 32 * PS;
    ldsp QI = lds, KI = lds + 128 * PQ, RED = KI + 2 * SLB;
    const int r31 = lane & 31, lh = lane >> 5;
    const int it = w & 3, dvh = w >> 2;
    const unsigned row0 = (unsigned)(b * 4096 + c * 128);
    const char* qg = (const char*)(p.RQ + (size_t)row0 * 1024 + hd * 256);
    const char* kg = (const char*)(p.RK + (size_t)row0 * 1024 + hd * 256);
    const char* sg_ = (const char*)(p.SC + (size_t)(bh * 32 + c) * 256 * 512);
    const char* vg = (const char*)(p.RV + (size_t)row0 * 2048 + hd * 512);
#pragma unroll
    for (int i = 0; i < 8; ++i) {
        const int id = tid + 512 * i, tok = id >> 5, pc = id & 31;
        const unsigned go = (unsigned)(tok * 2048 + pc * 16);
        *(LAS3 u32x4*)(QI + tok * PQ + pc * 16) = *(const u32x4*)(qg + go);
        *(LAS3 u32x4*)(KI + tok * PQ + pc * 16) = *(const u32x4*)(kg + go);
    }
    u32x4 sreg[4];
    {
        const int tt = opaque(tid);
#pragma unroll
        for (int i = 0; i < 4; ++i) { const int id = tt + 512 * i, rr = id >> 6, pc = id & 63; sreg[i] = *(const u32x4*)(sg_ + (unsigned)(rr * 1024 + pc * 16)); }
    }
    __syncthreads();
    bf16x8 pf[4][2];
    const int ig = 32 * it + r31;
#pragma unroll
    for (int jt = 0; jt < 4; ++jt) {
        if (jt <= it) {
            f32x16 a;
#pragma unroll
            for (int i = 0; i < 16; ++i) a[i] = 0.f;
            ldsp ka = KI + (32 * jt + r31) * PQ + 16 * lh, qa = QI + (32 * it + r31) * PQ + 16 * lh;
#pragma unroll 4
            for (int s = 0; s < 16; ++s) a = MFMA32(ld_b128(ka + 32 * s), ld_b128(qa + 32 * s), a);
#pragma unroll
            for (int reg = 0; reg < 16; ++reg) {
                const int j = 32 * jt + crow(reg, lh);
                a[reg] = (ig >= j) ? a[reg] * exp2f((float)(ig - j) * l2g) : 0.f;
            }
#pragma unroll
            for (int s2 = 0; s2 < 2; ++s2) {
                u32x4 pkd;
                pkd.x = pk2(a[8 * s2 + 0], a[8 * s2 + 1]); pkd.y = pk2(a[8 * s2 + 2], a[8 * s2 + 3]);
                pkd.z = pk2(a[8 * s2 + 4], a[8 * s2 + 5]); pkd.w = pk2(a[8 * s2 + 6], a[8 * s2 + 7]);
                pf[jt][s2] = __builtin_bit_cast(bf16x8, pkd);
            }
        } else {
            const u32x4 z = {0u, 0u, 0u, 0u};
            pf[jt][0] = __builtin_bit_cast(bf16x8, z); pf[jt][1] = __builtin_bit_cast(bf16x8, z);
        }
    }
    __syncthreads();
    f32x16 acc[8];
#pragma unroll
    for (int t = 0; t < 8; ++t)
#pragma unroll
        for (int i = 0; i < 16; ++i) acc[t][i] = 0.f;
    for (int d = 0; d < 8; ++d) {
        ldsp buf = KI + (d & 1) * SLB;
        const int tt = opaque(tid);
#pragma unroll
        for (int i = 0; i < 4; ++i) { const int id = tt + 512 * i, rr = id >> 6, pc = id & 63; *(LAS3 u32x4*)(buf + rr * PS + pc * 16) = sreg[i]; }
        __syncthreads();
        {
            const char* src = (d + 1 < 8) ? (sg_ + (size_t)(32 * (d + 1)) * 1024) : vg;
            const int pitch = (d + 1 < 8) ? 1024 : 4096;
#pragma unroll
            for (int i = 0; i < 4; ++i) { const int id = tt + 512 * i, rr = id >> 6, pc = id & 63; sreg[i] = *(const u32x4*)(src + (unsigned)(rr * pitch + pc * 16)); }
        }
        const int ln = opaque(lane);
        ldsp qa = QI + (32 * it + (ln & 31)) * PQ + 64 * d + 16 * (ln >> 5);
        ldsp sa = buf + (8 * (ln >> 5) + ((ln & 15) >> 2)) * PS + 2 * (256 * dvh + 16 * ((ln >> 4) & 1) + 4 * (ln & 3));
#pragma unroll
        for (int s = 0; s < 2; ++s) {
            const bf16x8 B = ld_b128(qa + 32 * s);
#pragma unroll
            for (int t = 0; t < 8; ++t) acc[t] = MFMA32(ld_tr8(sa + 16 * s * PS + 64 * t, 4 * PS), B, acc[t]);
        }
    }
    {
        const float rowdec = exp2f((float)(ig + 1) * l2g);
#pragma unroll
        for (int t = 0; t < 8; ++t) acc[t] = acc[t] * rowdec;
    }
#pragma unroll
    for (int u = 0; u < 4; ++u) {
        ldsp buf = KI + (u & 1) * SLB;
        const int tt = opaque(tid);
#pragma unroll
        for (int i = 0; i < 4; ++i) { const int id = tt + 512 * i, rr = id >> 6, pc = id & 63; *(LAS3 u32x4*)(buf + rr * PS + pc * 16) = sreg[i]; }
        __syncthreads();
        if (u + 1 < 4) {
#pragma unroll
            for (int i = 0; i < 4; ++i) { const int id = tt + 512 * i, rr = id >> 6, pc = id & 63; sreg[i] = *(const u32x4*)(vg + (unsigned)((32 * (u + 1) + rr) * 4096 + pc * 16)); }
        }
        if (u <= it) {
            const int ln = opaque(lane);
            ldsp sa = buf + (4 * (ln >> 5) + ((ln & 15) >> 2)) * PS + 2 * (256 * dvh + 16 * ((ln >> 4) & 1) + 4 * (ln & 3));
#pragma unroll
            for (int s2 = 0; s2 < 2; ++s2)
#pragma unroll
                for (int t = 0; t < 8; ++t) acc[t] = MFMA32(ld_tr8(sa + 16 * s2 * PS + 64 * t, 8 * PS), pf[u][s2], acc[t]);
        }
    }
    float sm = 0.f, sq = 0.f;
#pragma unroll
    for (int t = 0; t < 8; ++t)
#pragma unroll
        for (int i = 0; i < 16; ++i) { sm += acc[t][i]; sq += acc[t][i] * acc[t][i]; }
    sm += __shfl_xor(sm, 32); sq += __shfl_xor(sq, 32);
    LAS3 float* red = (LAS3 float*)RED;
    if (lh == 0) { red[(w * 32 + r31) * 2] = sm; red[(w * 32 + r31) * 2 + 1] = sq; }
    __syncthreads();
    {
        const int ln = opaque(lane), r31b = ln & 31, lhb = ln >> 5;
        const float osm = red[((w ^ 4) * 32 + r31b) * 2], osq = red[((w ^ 4) * 32 + r31b) * 2 + 1];
        const float mean = (sm + osm) * (1.0f / 512.0f);
        const float var = (sq + osq) * (1.0f / 512.0f) - mean * mean;
        const float rstd = rsqrtf(fmaxf(var, 0.f) + LN_EPS);
        ldsp ot = lds + (32 * it + r31b) * 1040 + 2 * (256 * dvh + 4 * lhb);
#pragma unroll
        for (int t = 0; t < 8; ++t)
#pragma unroll
            for (int g = 0; g < 4; ++g) {
                u32x2 o; o.x = pk2((acc[t][4 * g] - mean) * rstd, (acc[t][4 * g + 1] - mean) * rstd); o.y = pk2((acc[t][4 * g + 2] - mean) * rstd, (acc[t][4 * g + 3] - mean) * rstd);
                *(LAS3 u32x2*)(ot + 2 * (32 * t + 8 * g)) = o;
            }
    }
    __syncthreads();
    {
        const int tt = opaque(tid);
        const bf16_t* sgp = p.SG + (size_t)row0 * 2048 + hd * 512;
        bf16_t* outp = p.RETO + (size_t)row0 * 2048 + hd * 512;
#pragma unroll 4
        for (int i = 0; i < 16; ++i) {
            const int id = tt + 512 * i, rr = id >> 6, pc = id & 63;
            const u32x4 xn = *(LAS3 u32x4*)(lds + rr * 1040 + pc * 16);
            const u32x4 sg = *(const u32x4*)(sgp + (size_t)rr * 2048 + pc * 8);
            const f32x4 g0 = *(const f32x4*)(p.gn_g + hd * 512 + pc * 8), g1 = *(const f32x4*)(p.gn_g + hd * 512 + pc * 8 + 4);
            const f32x4 b0 = *(const f32x4*)(p.gn_b + hd * 512 + pc * 8), b1 = *(const f32x4*)(p.gn_b + hd * 512 + pc * 8 + 4);
            u32x4 o;
            o.x = pk2((__uint_as_float(xn.x << 16) * g0[0] + b0[0]) * __uint_as_float(sg.x << 16), (__uint_as_float(xn.x & 0xffff0000u) * g0[1] + b0[1]) * __uint_as_float(sg.x & 0xffff0000u));
            o.y = pk2((__uint_as_float(xn.y << 16) * g0[2] + b0[2]) * __uint_as_float(sg.y << 16), (__uint_as_float(xn.y & 0xffff0000u) * g0[3] + b0[3]) * __uint_as_float(sg.y & 0xffff0000u));
            o.z = pk2((__uint_as_float(xn.z << 16) * g1[0] + b1[0]) * __uint_as_float(sg.z << 16), (__uint_as_float(xn.z & 0xffff0000u) * g1[1] + b1[1]) * __uint_as_float(sg.z & 0xffff0000u));
            o.w = pk2((__uint_as_float(xn.w << 16) * g1[2] + b1[2]) * __uint_as_float(sg.w << 16), (__uint_as_float(xn.w & 0xffff0000u) * g1[3] + b1[3]) * __uint_as_float(sg.w & 0xffff0000u));
            *(u32x4*)(outp + (size_t)rr * 2048 + pc * 8) = o;
        }
    }
    __syncthreads();
}

__device__ __forceinline__ void ret_scan_load(const Params& p, int item, int row0, const float* state_in, float (&S)[32], float (&qk)[4], float (&vt)[4]) {
    const int tid = opaque((int)threadIdx.x), col = tid & 63, dkq = tid >> 6;
    const int bh = item >> 3, vg = item & 7, b = bh >> 2, h = bh & 3;
    const size_t sbase = (size_t)bh * 256 * 512 + (size_t)(dkq * 32) * 512 + vg * 64 + col;
#pragma unroll
    for (int i = 0; i < 32; ++i) S[i] = state_in ? state_in[sbase + (size_t)i * 512] : 0.f;
#pragma unroll
    for (int t = 0; t < 4; ++t) {
        const size_t r = (size_t)(row0 + b * 4 + t);
        qk[t] = (tid < 256) ? bf2f(p.RQ[r * 1024 + h * 256 + tid]) : bf2f(p.RK[r * 1024 + h * 256 + (tid - 256)]);
        vt[t] = bf2f(p.RV[r * 2048 + h * 512 + vg * 64 + col]);
    }
}
__device__ __forceinline__ void ret_scan_item(const Params& p, int item, int next_item, int row0, const float* state_in, float* state_out, float* qs, float* ks,
                                              float (&S)[32], float (&qk)[4], float (&vt)[4]) {
    const int tid = opaque((int)threadIdx.x), col = tid & 63, dkq = tid >> 6;
    float* redp = ks + 1024;
    const int bh = item >> 3, vg = item & 7, b = bh >> 2, h = bh & 3;
    const float gamma = 1.0f - exp2f(-5.0f - (float)h);
    const size_t sbase = (size_t)bh * 256 * 512 + (size_t)(dkq * 32) * 512 + vg * 64 + col;
    float vtok[4];
#pragma unroll
    for (int t = 0; t < 4; ++t) {
        if (tid < 256) qs[t * 256 + tid] = qk[t]; else ks[t * 256 + tid - 256] = qk[t];
        vtok[t] = vt[t];
    }
    __syncthreads();
    float Sn[32], qkn[4], vtn[4];
    if (next_item >= 0) ret_scan_load(p, next_item, row0, state_in, Sn, qkn, vtn);
#pragma unroll
    for (int t = 0; t < 4; ++t) {
        const size_t r = (size_t)(row0 + b * 4 + t);
        float part = 0.f;
#pragma unroll
        for (int i = 0; i < 32; ++i) {
            S[i] = gamma * S[i] + ks[t * 256 + dkq * 32 + i] * vtok[t];
            part += qs[t * 256 + dkq * 32 + i] * S[i];
        }
        redp[dkq * 64 + col] = part;
        __syncthreads();
        if (tid < 64) {
            float tot = 0.f;
#pragma unroll
            for (int w = 0; w < 8; ++w) tot += redp[w * 64 + tid];
            p.RO[r * 2048 + h * 512 + vg * 64 + tid] = tot;
        }
        __syncthreads();
    }
#pragma unroll
    for (int i = 0; i < 32; ++i) state_out[sbase + (size_t)i * 512] = S[i];
    if (next_item >= 0) {
#pragma unroll
        for (int i = 0; i < 32; ++i) S[i] = Sn[i];
#pragma unroll
        for (int t = 0; t < 4; ++t) { qk[t] = qkn[t]; vt[t] = vtn[t]; }
    }
    __syncthreads();
}
__device__ __forceinline__ void phase_ret_scan(const Params& p, unsigned char* smem) {
    for (int it = blockIdx.x; it < 256; it += gridDim.x) ret_state_item(p, it, (ldsp)smem);
    float* qs = (float*)smem; float* ks = qs + 1024;
    {
        float S[32], qk[4], vt[4];
        int it = blockIdx.x;
        if (it < 1024) ret_scan_load(p, it, TP, p.state_ret, S, qk, vt);
        for (; it < 1024; it += gridDim.x) { const int nx = it + (int)gridDim.x; ret_scan_item(p, it, nx < 1024 ? nx : -1, TP, p.state_ret, p.ret_sample, qs, ks, S, qk, vt); }
    }
}
__device__ __forceinline__ void phase_ret_out(const Params& p, unsigned char* smem) {
    for (int it = blockIdx.x; it < 512; it += gridDim.x) ret_out_item(p, it, (ldsp)smem);
}
__device__ __forceinline__ void phase_ret_gn(const Params& p) {
    const int tid_ = opaque((int)threadIdx.x), wid = tid_ >> 6, lane = tid_ & 63;
    for (int item = TP * 4 + blockIdx.x * 8 + wid; item < T * 4; item += gridDim.x * 8) {
        const int r = item >> 2, h = item & 3;
        const float* o = p.RO + (size_t)r * 2048 + h * 512;
        float v[8]; float s = 0.f;
#pragma unroll
        for (int i = 0; i < 8; ++i) { v[i] = o[lane + 64 * i]; s += v[i]; }
        const float mean = wave_sum(s) * (1.0f / 512.0f);
        float q = 0.f;
#pragma unroll
        for (int i = 0; i < 8; ++i) { const float d = v[i] - mean; q += d * d; }
        const float rstd = rsqrtf(wave_sum(q) * (1.0f / 512.0f) + LN_EPS);
#pragma unroll
        for (int i = 0; i < 8; ++i) {
            const int c = h * 512 + lane + 64 * i;
            const float on = (v[i] - mean) * rstd * p.gn_g[c] + p.gn_b[c];
            p.RETO[(size_t)r * 2048 + c] = f2bf(bf2f(p.SG[(size_t)r * 2048 + c]) * on);
        }
    }
}


__device__ __forceinline__ unsigned fkey(float f) { const unsigned u = __float_as_uint(f); return (u & 0x80000000u) ? ~u : (u | 0x80000000u); }

__device__ __forceinline__ float block_sum512(float v, float* red) {
    v = wave_sum(v);
    __syncthreads();
    if ((threadIdx.x & 63) == 0) red[threadIdx.x >> 6] = v;
    __syncthreads();
    float t = 0.f;
#pragma unroll
    for (int w = 0; w < 8; ++w) t += red[w];
    return t;
}
__device__ __forceinline__ void phase_ln1(const Params& p) {
    const int tid_ = opaque((int)threadIdx.x), wid = tid_ >> 6, lane = tid_ & 63;
    const int stride = gridDim.x * 8;
    int r = blockIdx.x * 8 + wid;
    u32x4 v8[2], n8[2];
    if (r < T) {
#pragma unroll
        for (int i = 0; i < 2; ++i) v8[i] = *(const u32x4*)(p.VPRE + (size_t)r * 1024 + lane * 8 + 512 * i);
    }
    for (; r < T; r += stride) {
        const int rn = r + stride;
        if (rn < T) {
#pragma unroll
            for (int i = 0; i < 2; ++i) n8[i] = *(const u32x4*)(p.VPRE + (size_t)rn * 1024 + lane * 8 + 512 * i);
        }
        float v[16];
#pragma unroll
        for (int i = 0; i < 2; ++i)
#pragma unroll
            for (int e = 0; e < 4; ++e) { v[8 * i + 2 * e] = __uint_as_float(v8[i][e] << 16); v[8 * i + 2 * e + 1] = __uint_as_float(v8[i][e] & 0xffff0000u); }
        float s = 0.f;
#pragma unroll
        for (int i = 0; i < 16; ++i) s += v[i];
        const float mean = wave_sum(s) * (1.0f / 1024.0f);
        float q = 0.f;
#pragma unroll
        for (int i = 0; i < 16; ++i) { const float d = v[i] - mean; q += d * d; }
        const float rstd = rsqrtf(wave_sum(q) * (1.0f / 1024.0f) + LN_EPS);
#pragma unroll
        for (int i = 0; i < 2; ++i) {
            const int c = lane * 8 + 512 * i;
            const float4 g0 = *(const float4*)(p.ln1_g + c), g1 = *(const float4*)(p.ln1_g + c + 4), b0 = *(const float4*)(p.ln1_b + c), b1 = *(const float4*)(p.ln1_b + c + 4);
            uint4 ob;
            ob.x = pack_bf2((v[8 * i] - mean) * rstd * g0.x + b0.x, (v[8 * i + 1] - mean) * rstd * g0.y + b0.y);
            ob.y = pack_bf2((v[8 * i + 2] - mean) * rstd * g0.z + b0.z, (v[8 * i + 3] - mean) * rstd * g0.w + b0.w);
            ob.z = pack_bf2((v[8 * i + 4] - mean) * rstd * g1.x + b1.x, (v[8 * i + 5] - mean) * rstd * g1.y + b1.y);
            ob.w = pack_bf2((v[8 * i + 6] - mean) * rstd * g1.z + b1.z, (v[8 * i + 7] - mean) * rstd * g1.w + b1.w);
            *(uint4*)(p.X1B + (size_t)r * 1024 + c) = ob;
        }
#pragma unroll
        for (int i = 0; i < 2; ++i) v8[i] = n8[i];
    }
}

__device__ __forceinline__ void wave_argmax(float& v, int& i) {
#pragma unroll
    for (int o = 32; o >= 1; o >>= 1) {
        const float ov = __shfl_xor(v, o);
        const int oi = __shfl_xor(i, o);
        if (ov > v || (ov == v && oi < i)) { v = ov; i = oi; }
    }
}
__device__ __forceinline__ void peer_item(const Params& p, int r, unsigned char* smem) {
    float* xs = (float*)smem;
    float* qs = xs + 1024;
    float* sc = qs + 2048;
    float* topv = sc + 2048;
    int* topi = (int*)(topv + 256);
    float* gw = (float*)(topi + 256);
    int* eid = (int*)(gw + 128);
    float* red = (float*)(eid + 128);
    const int tid = opaque((int)threadIdx.x), wid = tid >> 6, lane = tid & 63;
    xs[tid] = p.X1[(size_t)r * 1024 + tid]; xs[tid + 512] = p.X1[(size_t)r * 1024 + 512 + tid];
#pragma unroll
    for (int i = 0; i < 4; ++i) qs[tid + 512 * i] = bf2f(p.QP[(size_t)r * 2048 + tid + 512 * i]);
    __syncthreads();
    for (int it = 0; it < 4; ++it) {
        const int id = tid + NT * it, list = id >> 7, n = id & 127;
        const float* sk = p.peer_subkeys + ((size_t)list * 128 + n) * 128;
        const float* qq = qs + list * 128;
        float d = 0.f;
#pragma unroll 8
        for (int e = 0; e < 128; ++e) d += qq[e] * sk[e];
        sc[list * 128 + n] = d;
    }
    __syncthreads();
    for (int li = 0; li < 2; ++li) {
        const int list = wid * 2 + li;
        float v0 = sc[list * 128 + lane], v1 = sc[list * 128 + lane + 64];
        for (int k = 0; k < 16; ++k) {
            float bv; int bi;
            if (v1 > v0) { bv = v1; bi = lane + 64; } else { bv = v0; bi = lane; }
            wave_argmax(bv, bi);
            if (lane == 0) { topv[list * 16 + k] = bv; topi[list * 16 + k] = bi; }
            if (bi == lane) v0 = -3.0e38f;
            if (bi == lane + 64) v1 = -3.0e38f;
        }
    }
    __syncthreads();
    {
        const int h = wid;
        float cv[4];
#pragma unroll
        for (int i = 0; i < 4; ++i) { const int c = lane + 64 * i; cv[i] = topv[(2 * h) * 16 + (c >> 4)] + topv[(2 * h + 1) * 16 + (c & 15)]; }
        float myv = 0.f; int myc = 0;
        for (int k = 0; k < 16; ++k) {
            float bv = cv[0]; int bi = lane;
#pragma unroll
            for (int i = 1; i < 4; ++i) if (cv[i] > bv) { bv = cv[i]; bi = lane + 64 * i; }
            wave_argmax(bv, bi);
            if (lane == k) { myv = bv; myc = bi; }
#pragma unroll
            for (int i = 0; i < 4; ++i) if (bi == lane + 64 * i) cv[i] = -3.0e38f;
        }
        float m = (lane < 16) ? myv : -3.0e38f;
        m = wave_max(m);
        const float e = (lane < 16) ? __expf(myv - m) : 0.f;
        const float ssum = wave_sum(e);
        if (lane < 16) {
            gw[h * 16 + lane] = e / ssum;
            eid[h * 16 + lane] = topi[(2 * h) * 16 + (myc >> 4)] * 128 + topi[(2 * h + 1) * 16 + (myc & 15)];
        }
    }
    __syncthreads();
    for (int pi = 0; pi < 16; ++pi) {
        const int pr = wid * 16 + pi;
        const float* uu = p.peer_u + (size_t)eid[pr] * 1024;
        float d = 0.f;
#pragma unroll
        for (int i = 0; i < 4; ++i) {
            const float4 uv = *(const float4*)(uu + lane * 4 + 256 * i);
            const float* xx = xs + lane * 4 + 256 * i;
            d += xx[0] * uv.x + xx[1] * uv.y + xx[2] * uv.z + xx[3] * uv.w;
        }
        d = wave_sum(d);
        if (lane == 0) gw[pr] = gw[pr] * 0.5f * d * (1.0f + erff(d * 0.7071067811865476f));
    }
    __syncthreads();
    float o0 = 0.f, o1 = 0.f;
#pragma unroll 4
    for (int pr = 0; pr < 128; ++pr) {
        const float2 vv = *(const float2*)(p.peer_v + (size_t)eid[pr] * 1024 + tid * 2);
        const float w = gw[pr];
        o0 += w * vv.x; o1 += w * vv.y;
    }
    float2 ple; ple.x = bf2f(p.PLE[(size_t)r * 1024 + tid * 2]); ple.y = bf2f(p.PLE[(size_t)r * 1024 + tid * 2 + 1]);
    const float v0 = ALPHA * xs[tid * 2] + o0 + ple.x, v1 = ALPHA * xs[tid * 2 + 1] + o1 + ple.y;
    const float mean = block_sum512(v0 + v1, red) * (1.0f / 1024.0f);
    const float d0 = v0 - mean, d1 = v1 - mean;
    const float rstd = rsqrtf(block_sum512(d0 * d0 + d1 * d1, red) * (1.0f / 1024.0f) + LN_EPS);
    float* y = (r < TP) ? (p.y_prompt + (size_t)r * 1024) : (p.y_sample + (size_t)(r - TP) * 1024);
    float2 o; o.x = d0 * rstd * p.ln2_g[tid * 2] + p.ln2_b[tid * 2]; o.y = d1 * rstd * p.ln2_g[tid * 2 + 1] + p.ln2_b[tid * 2 + 1];
    *(float2*)(y + tid * 2) = o;
    __syncthreads();
}
__device__ __forceinline__ void phase_peer(const Params& p, unsigned char* smem) {
    for (int r = blockIdx.x; r < T; r += gridDim.x) peer_item(p, r, smem);
}


typedef _Float16 f16x8 __attribute__((ext_vector_type(8)));
#define MFMA32H(a, b, c) __builtin_amdgcn_mfma_f32_32x32x16_f16((a), (b), (c), 0, 0, 0)
struct IdxChunk { int b, nt, m0, m1; };
__device__ __forceinline__ IdxChunk idx_chunk_decode(int chunk) {
    IdxChunk c; c.b = chunk / 187; int idx = chunk - c.b * 187;
    int nt = 0;
    for (;;) { const int nc = (nt + 3) / 3; if (idx < nc) break; idx -= nc; ++nt; }
    c.nt = nt; c.m0 = 3 * idx; c.m1 = (c.m0 + 2 < nt) ? (c.m0 + 2) : nt;
    return c;
}
__device__ __forceinline__ void idx_chunk_load_q(const Params& p, const IdxChunk& c, u32x4 (&qpre)[16], float2& wv) {
    const int tid = opaque((int)threadIdx.x);
    const char* qg = (const char*)(p.IQ + (size_t)(c.b * 4096 + 128 * c.nt) * 512);
#pragma unroll
    for (int i = 0; i < 16; ++i) { const int id = tid + 512 * i, row = id >> 6, pc = id & 63; qpre[i] = *(const u32x4*)(qg + (size_t)row * 1024 + pc * 16); }
    const int q = tid >> 2, h2 = (tid & 3) * 2;
    wv = *(const float2*)(p.IW + (size_t)(c.b * 4096 + 128 * c.nt + q) * 8 + h2);
}
__device__ __forceinline__ void idx_chunk_load_k(const Params& p, int b, int mt, f16x8 (&kf)[2][4]) {
    const int tid = opaque((int)threadIdx.x), lane = tid & 63, w = __builtin_amdgcn_readfirstlane(tid >> 6);
    const int r31 = lane & 31, lh = lane >> 5, kmp = w >> 2;
#pragma unroll
    for (int kk = 0; kk < 2; ++kk) {
        const int krow = b * 4096 + 128 * mt + 32 * (2 * kmp + kk) + r31;
#pragma unroll
        for (int s = 0; s < 4; ++s) kf[kk][s] = *(const f16x8*)(p.IK + (size_t)krow * 64 + 16 * s + 8 * lh);
    }
}
__device__ __forceinline__ void idx_score_chunk(const Params& p, const IdxChunk& ck, const bool has_next, const IdxChunk& cn, u32x4 (&qpre)[16], float2& wvp, f16x8 (&kf)[2][4], ldsp lds) {
    const int tid = opaque((int)threadIdx.x), lane = tid & 63, w = __builtin_amdgcn_readfirstlane(tid >> 6);
    const int b = ck.b, nt = ck.nt, m0 = ck.m0, m1 = ck.m1;
    const int r31 = lane & 31, lh = lane >> 5, qn = w & 3, kmp = w >> 2;
    constexpr int PQI = 1040;
    LAS3 float* wT = (LAS3 float*)(lds + 128 * PQI);
    {
#pragma unroll
        for (int i = 0; i < 16; ++i) { const int id = tid + 512 * i, row = id >> 6, pc = id & 63; *(LAS3 u32x4*)(lds + row * PQI + pc * 16) = qpre[i]; }
        const int q = tid >> 2, h2 = (tid & 3) * 2;
        wT[h2 * 128 + q] = wvp.x; wT[(h2 + 1) * 128 + q] = wvp.y;
    }
    __syncthreads();
    ldsp qa = lds + (32 * qn + r31) * PQI + 16 * lh;
#pragma unroll 1
    for (int mt = m0; mt <= m1; ++mt) {
        f16x8 nk[2][4];
        const bool more = mt < m1;
        if (more) idx_chunk_load_k(p, b, mt + 1, nk);
        else if (has_next) idx_chunk_load_q(p, cn, qpre, wvp);
#pragma unroll
        for (int kk = 0; kk < 2; ++kk) {
            f32x16 score;
#pragma unroll
            for (int i = 0; i < 16; ++i) score[i] = 0.f;
#pragma unroll 2
            for (int h = 0; h < 8; ++h) {
                f32x16 acc;
#pragma unroll
                for (int i = 0; i < 16; ++i) acc[i] = 0.f;
#pragma unroll
                for (int s = 0; s < 4; ++s) acc = MFMA32H(*(LAS3 f16x8*)(qa + 2 * (h * 64 + 16 * s)), kf[kk][s], acc);
#pragma unroll
                for (int g = 0; g < 4; ++g) {
                    const f32x4 wv = *(LAS3 f32x4*)(wT + h * 128 + 32 * qn + 8 * g + 4 * lh);
#pragma unroll
                    for (int e = 0; e < 4; ++e) score[4 * g + e] += wv[e] * fmaxf(acc[4 * g + e], 0.f);
                }
            }
            float* so = p.SCO + (size_t)(b * 4096 + 128 * nt + 32 * qn) * 4096 + 128 * mt + 32 * (2 * kmp + kk) + r31;
#pragma unroll
            for (int reg = 0; reg < 16; ++reg) __builtin_nontemporal_store(score[reg], so + (size_t)crow(reg, lh) * 4096);
        }
        if (more) {
#pragma unroll
            for (int kk = 0; kk < 2; ++kk)
#pragma unroll
                for (int s = 0; s < 4; ++s) kf[kk][s] = nk[kk][s];
        }
    }
    if (has_next) idx_chunk_load_k(p, cn.b, cn.m0, kf);
    __syncthreads();
}
__device__ __forceinline__ void idx_score_sample_item(const Params& p, int item) {
    const int tid = opaque((int)threadIdx.x), lane = tid & 63, w = __builtin_amdgcn_readfirstlane(tid >> 6);
    const int bd = item >> 3, kb = item & 7;
    const int r31 = lane & 31, lh = lane >> 5, tq = r31 >> 3, hq = r31 & 7;
    const size_t qrow = (size_t)(TP + bd * 4 + tq);
    f16x8 bq[4];
#pragma unroll
    for (int s = 0; s < 4; ++s) bq[s] = *(const f16x8*)(p.IQ + qrow * 512 + hq * 64 + 16 * s + 8 * lh);
    const float wv = p.IW[qrow * 8 + hq];
    const int ntile = (kb == 7 && w == 7) ? 9 : 8;
    const float* krp[8];
#pragma unroll
    for (int tile = 0; tile < 8; ++tile) {
        const int key = kb * 2048 + (w * 8 + tile) * 32 + r31;
        krp[tile] = p.cache_kidx + ((size_t)p.page_table[bd * 128 + (key >> 7)] * 128 + (key & 127)) * 64 + 8 * lh;
    }
    float4 cur[8], nxt[8];
#pragma unroll
    for (int s = 0; s < 4; ++s) { cur[2 * s] = *(const float4*)(krp[0] + 16 * s); cur[2 * s + 1] = *(const float4*)(krp[0] + 16 * s + 4); }
#pragma unroll
    for (int tile = 0; tile < 9; ++tile) {
        if (tile < ntile) {
            f16x8 af[4];
            int key0;
            if (tile < 8) {
                key0 = kb * 2048 + (w * 8 + tile) * 32;
                if (tile + 1 < 8) {
#pragma unroll
                    for (int s = 0; s < 4; ++s) { nxt[2 * s] = *(const float4*)(krp[(tile + 1) & 7] + 16 * s); nxt[2 * s + 1] = *(const float4*)(krp[(tile + 1) & 7] + 16 * s + 4); }
                }
#pragma unroll
                for (int s = 0; s < 4; ++s) {
                    const float4 x0 = cur[2 * s], x1 = cur[2 * s + 1];
                    f16x8 v; v[0] = (_Float16)x0.x; v[1] = (_Float16)x0.y; v[2] = (_Float16)x0.z; v[3] = (_Float16)x0.w; v[4] = (_Float16)x1.x; v[5] = (_Float16)x1.y; v[6] = (_Float16)x1.z; v[7] = (_Float16)x1.w;
                    af[s] = v;
                }
            } else {
                key0 = 16384;
                const f16_t* kr = p.IK + (size_t)(TP + bd * 4 + (r31 & 3)) * 64 + 8 * lh;
#pragma unroll
                for (int s = 0; s < 4; ++s) af[s] = *(const f16x8*)(kr + 16 * s);
            }
            f32x16 acc;
#pragma unroll
            for (int i = 0; i < 16; ++i) acc[i] = 0.f;
#pragma unroll
            for (int s = 0; s < 4; ++s) acc = MFMA32H(af[s], bq[s], acc);
            const int nkeys = (tile < 8) ? 32 : 4;
#pragma unroll
            for (int reg = 0; reg < 16; ++reg) {
                float v = wv * fmaxf(acc[reg], 0.f);
                v += __shfl_xor(v, 1); v += __shfl_xor(v, 2); v += __shfl_xor(v, 4);
                const int kin = crow(reg, lh);
                if (hq == 0 && kin < nkeys) p.SS[(size_t)(bd * 4 + tq) * 16392 + key0 + kin] = v;
            }
            if (tile + 1 < 8) {
#pragma unroll
                for (int i = 0; i < 8; ++i) cur[i] = nxt[i];
            }
        }
    }
}
__device__ __forceinline__ float dot2bf_(unsigned a, unsigned b, float c) {
    typedef __bf16 bf2 __attribute__((ext_vector_type(2)));
    return __builtin_amdgcn_fdot2_f32_bf16(__builtin_bit_cast(bf2, a), __builtin_bit_cast(bf2, b), c, false);
}

template <bool SAMPLE>
__device__ __forceinline__ const void* kv_row_ptr(const Params& p, int bidx, int row, int g, bool isv, bool& f32src) {
    f32src = SAMPLE;
    if (SAMPLE) {
        const bool past = row < 16384;
        const int prow = past ? row : 0;
        const size_t ph = (size_t)p.page_table[bidx * 128 + (prow >> 7)] * 128 + (prow & 127);
        const size_t off = past ? (ph * 2 + g) * 128 : (size_t)((bidx * 4 + (row - 16384)) * 2 + g) * 128;
        const float* cb = isv ? p.cache_v : p.cache_k; const float* nb = isv ? p.v_sample : p.k_sample;
        return (past ? cb : nb) + off;
    }
    return (isv ? p.AV : p.AK) + (size_t)(bidx * 4096 + row) * 256 + g * 128;
}
template <bool SAMPLE>
__device__ __forceinline__ u32x4 ld8_kv(const void* rowp, bool f32src, int e0) {
    if (SAMPLE) {
        const float4 a = *(const float4*)((const float*)rowp + e0), b = *(const float4*)((const float*)rowp + e0 + 4);
        u32x4 o; o.x = pk2(a.x, a.y); o.y = pk2(a.z, a.w); o.z = pk2(b.x, b.y); o.w = pk2(b.z, b.w);
        return o;
    }
    return *(const u32x4*)((const bf16_t*)rowp + e0);
}
#define MFMA16(a, b, c) __builtin_amdgcn_mfma_f32_16x16x32_bf16((a), (b), (c), 0, 0, 0)
template <bool SAMPLE>
__device__ __forceinline__ void attend_unit(const Params& p, int r, int bidx, int g, LAS3 int* list, int nsel, ldsp wp) {
    const int lane = opaque((int)threadIdx.x) & 63, n16 = lane & 15, kg = lane >> 4;
    LAS3 float* pw = (LAS3 float*)(wp + 1024);
    ldsp Pt = wp + 5120, Vs = wp + 7168;
    const u32x4 zero4 = {0u, 0u, 0u, 0u};
    bf16x8 qf[4];
    {
        const bf16_t* qp = p.AQ + (size_t)r * 1024 + (4 * g + (n16 & 3)) * 128 + 8 * kg;
#pragma unroll
        for (int s = 0; s < 4; ++s) { u32x4 t = *(const u32x4*)(qp + 32 * s); if (n16 >= 4) t = zero4; qf[s] = __builtin_bit_cast(bf16x8, t); }
    }
    asm volatile("" ::: "memory");
    {
        constexpr int KD = SAMPLE ? 1 : 3;
        u32x4 kk[KD][8];
#pragma unroll
        for (int d = 0; d < KD; ++d) {
#pragma unroll
            for (int u = 0; u < 8; ++u) { bool f32src; const void* rp = kv_row_ptr<SAMPLE>(p, bidx, list[32 * d + 4 * u + kg], g, false, f32src); kk[d][u] = ld8_kv<SAMPLE>(rp, f32src, 8 * n16); }
        }
#pragma unroll
        for (int kt = 0; kt < 8; ++kt) {
#pragma unroll
            for (int u = 0; u < 8; ++u) *(LAS3 u32x4*)(Vs + (4 * u + kg) * 320 + 16 * n16) = kk[kt % KD][u];
            asm volatile("" ::: "memory");
            if (kt + KD < 8) {
#pragma unroll
                for (int u = 0; u < 8; ++u) { bool f32src; const void* rp = kv_row_ptr<SAMPLE>(p, bidx, list[32 * (kt + KD) + 4 * u + kg], g, false, f32src); kk[kt % KD][u] = ld8_kv<SAMPLE>(rp, f32src, 8 * n16); }
            }
#pragma unroll
            for (int tl = 0; tl < 2; ++tl) {
                f32x4 acc = {0.f, 0.f, 0.f, 0.f};
#pragma unroll
                for (int s = 0; s < 4; ++s) acc = MFMA16(qf[s], ld_b128(Vs + (16 * tl + n16) * 320 + 64 * s + 16 * kg), acc);
                if (kg == 0) *(LAS3 f32x4*)(pw + (32 * kt + 16 * tl + n16) * 4) = acc;
            }
            asm volatile("" ::: "memory");
        }
    }
    asm volatile("" ::: "memory");
    const int nb = (nsel + 31) >> 5;
    constexpr int PD = SAMPLE ? 1 : 3;
    u32x4 vv[PD][8];
#pragma unroll
    for (int d = 0; d < PD; ++d) {
        if (d < nb) {
#pragma unroll
            for (int u = 0; u < 8; ++u) { bool f32src; const void* rp = kv_row_ptr<SAMPLE>(p, bidx, list[32 * d + 4 * u + kg], g, true, f32src); vv[d][u] = ld8_kv<SAMPLE>(rp, f32src, 8 * n16); }
        }
    }
#pragma unroll
    for (int hh = 0; hh < 4; ++hh) {
        float sc[4];
#pragma unroll
        for (int ks = 0; ks < 4; ++ks) sc[ks] = (64 * ks + lane < nsel) ? pw[(64 * ks + lane) * 4 + hh] : -3.0e38f;
        float m = fmaxf(fmaxf(sc[0], sc[1]), fmaxf(sc[2], sc[3]));
        m = wave_max(m);
        float e[4], sum = 0.f;
#pragma unroll
        for (int ks = 0; ks < 4; ++ks) { e[ks] = (64 * ks + lane < nsel) ? __expf(sc[ks] - m) : 0.f; sum += e[ks]; }
        sum = wave_sum(sum);
        const float inv = 1.0f / sum;
#pragma unroll
        for (int ks = 0; ks < 4; ++ks) *(LAS3 unsigned short*)(Pt + hh * 512 + 2 * (64 * ks + lane)) = (unsigned short)(pk2(e[ks] * inv, 0.f) & 0xffffu);
    }
    asm volatile("" ::: "memory");
    f32x4 o[8];
#pragma unroll
    for (int nt = 0; nt < 8; ++nt) o[nt] = (f32x4){0.f, 0.f, 0.f, 0.f};
    const int q4 = n16 >> 2, p4 = n16 & 3;
#pragma unroll
    for (int bt = 0; bt < 8; ++bt) {
        if (bt < nb) {
#pragma unroll
            for (int u = 0; u < 8; ++u) *(LAS3 u32x4*)(Vs + (4 * u + kg) * 320 + 16 * n16) = vv[bt % PD][u];
            asm volatile("" ::: "memory");
            if (bt + PD < nb) {
#pragma unroll
                for (int u = 0; u < 8; ++u) { bool f32src; const void* rp = kv_row_ptr<SAMPLE>(p, bidx, list[32 * (bt + PD) + 4 * u + kg], g, true, f32src); vv[bt % PD][u] = ld8_kv<SAMPLE>(rp, f32src, 8 * n16); }
            }
            u32x4 pa = *(LAS3 u32x4*)(Pt + (n16 & 3) * 512 + 2 * (32 * bt + 8 * kg));
            if (n16 >= 4) pa = zero4;
            const bf16x8 A = __builtin_bit_cast(bf16x8, pa);
            ldsp vb = Vs + (8 * kg + q4) * 320 + 8 * p4;
#pragma unroll
            for (int nt = 0; nt < 8; ++nt) o[nt] = MFMA16(A, ld_tr8(vb + 32 * nt, 4 * 320), o[nt]);
            asm volatile("" ::: "memory");
        }
    }
    if (kg == 0) {
#pragma unroll
        for (int nt = 0; nt < 8; ++nt)
#pragma unroll
            for (int j = 0; j < 4; ++j) p.ATTO[(size_t)r * 1024 + (4 * g + j) * 128 + 16 * nt + n16] = (bf16_t)(pk2(o[nt][j], 0.f) & 0xffffu);
    }
}
__device__ __forceinline__ int wave_sum_i(int v) {
    v += __builtin_amdgcn_update_dpp(0, v, 0xB1, 0xf, 0xf, true);
    v += __builtin_amdgcn_update_dpp(0, v, 0x4E, 0xf, 0xf, true);
    v += __builtin_amdgcn_update_dpp(0, v, 0x141, 0xf, 0xf, true);
    v += __builtin_amdgcn_update_dpp(0, v, 0x140, 0xf, 0xf, true);
    v += __builtin_amdgcn_update_dpp(0, v, 0x142, 0xa, 0xf, false);
    v += __builtin_amdgcn_update_dpp(0, v, 0x143, 0xc, 0xf, false);
    return __builtin_amdgcn_readlane(v, 63);
}
__device__ __forceinline__ void attn_query_wave(const Params& p, int b, int t, ldsp wl) {
    const int lane = opaque((int)threadIdx.x) & 63;
    LAS3 int* list = (LAS3 int*)wl;
    const int r = b * 4096 + t, nvalid = t + 1;
    int nsel;
    if (nvalid <= 256) {
#pragma unroll
        for (int i = 0; i < 4; ++i) { const int j = lane + 64 * i; list[j] = (j < nvalid) ? j : 0; }
        nsel = nvalid;
    } else {
        const int ngrp = (nvalid + 511) >> 9;
        const float* srow = p.SCO + (size_t)r * 4096;
        unsigned key[64];
#pragma unroll
        for (int gq = 0; gq < 8; ++gq) {
            if (gq < ngrp) {
#pragma unroll
                for (int s = 8 * gq; s < 8 * gq + 8; ++s) { const int j = 64 * s + lane; key[s] = (j < nvalid) ? fkey(__builtin_nontemporal_load(srow + j)) : 0u; }
            } else {
#pragma unroll
                for (int s = 8 * gq; s < 8 * gq + 8; ++s) key[s] = 0u;
            }
        }
        unsigned lo, hi; int clo = nvalid, chi = 0;
        {
            unsigned kmx = 0u, kmn = 0xffffffffu;
#pragma unroll
            for (int gq = 0; gq < 8; ++gq) {
                if (gq < ngrp) {
#pragma unroll
                    for (int s = 8 * gq; s < 8 * gq + 8; ++s) { kmx = kmx > key[s] ? kmx : key[s]; const unsigned kv = (64 * s + lane < nvalid) ? key[s] : 0xffffffffu; kmn = kmn < kv ? kmn : kv; }
                }
            }
#pragma unroll
            for (int o = 32; o >= 1; o >>= 1) { const unsigned a = (unsigned)__shfl_xor((int)kmx, o), b2 = (unsigned)__shfl_xor((int)kmn, o); kmx = kmx > a ? kmx : a; kmn = kmn < b2 ? kmn : b2; }
            lo = (unsigned)__builtin_amdgcn_readfirstlane((int)kmn); hi = (unsigned)__builtin_amdgcn_readfirstlane((int)kmx);
            if (hi != 0xffffffffu) hi += 1u; else chi = -1;
        }
        for (int it = 0; hi - lo > 1u; ++it) {
            const unsigned wdt = hi - lo;
            unsigned cand;
            if ((it & 1) || chi < 0 || wdt < 8u) cand = lo + (wdt >> 1);
            else {
                const float fr = (float)(clo - 256) / (float)(clo - chi);
                unsigned off = (unsigned)((float)wdt * fr);
                off = off < 1u ? 1u : off; off = off > wdt - 1u ? wdt - 1u : off;
                cand = lo + off;
            }
            int cl = 0;
#pragma unroll
            for (int gq = 0; gq < 8; ++gq) {
                if (gq < ngrp) {
#pragma unroll
                    for (int s = 8 * gq; s < 8 * gq + 8; ++s) cl += (key[s] >= cand) ? 1 : 0;
                }
            }
            const int c = wave_sum_i(cl);
            if (c >= 256) { lo = cand; clo = c; } else { hi = cand; chi = c; }
            if (c == 256) break;
        }
        int ngl = 0, nql = 0;
#pragma unroll
        for (int s = 0; s < 64; ++s) { ngl += (key[s] > lo) ? 1 : 0; nql += (key[s] == lo) ? 1 : 0; }
        const int need = 256 - wave_sum_i(ngl), neqt = wave_sum_i(nql);
        if (neqt == need) {
            int incl = ngl + nql;
#pragma unroll
            for (int d = 1; d < 64; d <<= 1) { const int t2 = __shfl_up(incl, d); if (lane >= d) incl += t2; }
            int pos = incl - (ngl + nql);
#pragma unroll
            for (int gq = 0; gq < 8; ++gq) {
                if (gq < ngrp) {
#pragma unroll
                    for (int s = 8 * gq; s < 8 * gq + 8; ++s) { if (key[s] >= lo) { list[pos] = 64 * s + lane; ++pos; } }
                }
            }
        } else {
            int nout = 0, neq = 0;
            const unsigned long long below = (lane == 0) ? 0ull : (~0ull >> (64 - lane));
#pragma unroll
            for (int gq = 0; gq < 8; ++gq) {
                if (gq < ngrp) {
#pragma unroll
                    for (int s = 8 * gq; s < 8 * gq + 8; ++s) {
                        const bool gt = key[s] > lo, eq = key[s] == lo;
                        const unsigned long long meq = __ballot(eq);
                        const bool take = gt || (eq && (neq + __popcll(meq & below)) < need);
                        const unsigned long long mt = __ballot(take);
                        if (take) list[nout + __popcll(mt & below)] = 64 * s + lane;
                        nout += __popcll(mt); neq += __popcll(meq);
                    }
                }
            }
        }
        nsel = 256;
    }
#pragma unroll 1
    for (int g = 0; g < 2; ++g) attend_unit<false>(p, r, b, g, list, nsel, wl);
}
__device__ __forceinline__ void attn_item(const Params& p, int qn, bool sample, unsigned char* smem) {
    unsigned* keys = (unsigned*)smem;
    int* sel = (int*)(keys + 16400);
    unsigned* red = (unsigned*)(sel + 256);
    const int tid = opaque((int)threadIdx.x), wid = tid >> 6, lane = tid & 63;
    const int b = qn >> 2, qpos = 16384 + (qn & 3), r = TP + qn;
    const int nvalid = qpos + 1;
    for (int s = tid; s < nvalid; s += NT) keys[s] = fkey(p.SS[(size_t)qn * 16392 + s]);
    __syncthreads();
    unsigned prefix = 0u;
    for (int bit = 31; bit >= 0; --bit) {
        const unsigned cand = prefix | (1u << bit);
        int c = 0;
        for (int s = tid; s < nvalid; s += NT) c += (keys[s] >= cand) ? 1 : 0;
        c = (int)wave_sum((float)c);
        if (lane == 0) red[wid] = (unsigned)c;
        __syncthreads();
        unsigned tot = 0;
#pragma unroll
        for (int w = 0; w < 8; ++w) tot += red[w];
        __syncthreads();
        if (tot >= 256u) prefix = cand;
        if (tot == 256u) break;
    }
    const unsigned thr = prefix;
    int c = 0;
    for (int s = tid; s < nvalid; s += NT) c += (keys[s] > thr) ? 1 : 0;
    c = (int)wave_sum((float)c);
    if (lane == 0) red[wid] = (unsigned)c;
    __syncthreads();
    int ngt = 0;
#pragma unroll
    for (int w = 0; w < 8; ++w) ngt += (int)red[w];
    const int need = 256 - ngt;
    if (wid == 0) {
        int nout = 0, neq = 0;
        for (int base = 0; base < nvalid; base += 64) {
            const int s = base + lane;
            const unsigned k = (s < nvalid) ? keys[s] : 0u;
            const bool gt = (s < nvalid) && (k > thr);
            const bool eq = (s < nvalid) && (k == thr);
            const unsigned long long meq = __ballot(eq);
            const unsigned long long below = (lane == 0) ? 0ull : (~0ull >> (64 - lane));
            const int eqrank = neq + __popcll(meq & below);
            const bool take = gt || (eq && eqrank < need);
            const unsigned long long mt = __ballot(take);
            if (take) sel[nout + __popcll(mt & below)] = s;
            nout += __popcll(mt);
            neq += __popcll(meq);
        }
    }
    __syncthreads();
}
__device__ __forceinline__ void attn_sample_units(const Params& p, int qn, unsigned char* smem) {
    const int tid_ = opaque((int)threadIdx.x), wid = tid_ >> 6, lane = tid_ & 63;
    ldsp priv = (ldsp)smem + wid * 17408;
    int mine[4];
    if (wid < 2) {
#pragma unroll
        for (int i = 0; i < 4; ++i) mine[i] = *(LAS3 int*)((ldsp)smem + 65600 + 4 * (lane + 64 * i));
    }
    __syncthreads();
    if (wid < 2) {
#pragma unroll
        for (int i = 0; i < 4; ++i) ((LAS3 int*)priv)[lane + 64 * i] = mine[i];
        attend_unit<true>(p, TP + qn, qn >> 2, wid, (LAS3 int*)priv, 256, priv);
    }
}
__device__ __forceinline__ void phase_attn(const Params& p, unsigned char* smem) {
    for (int it = blockIdx.x; it < TS; it += gridDim.x) { attn_item(p, it, true, smem); attn_sample_units(p, it, smem); __syncthreads(); }
}
__device__ __forceinline__ void phase_idx_scores(const Params& p, unsigned char* smem) {
    for (int it = blockIdx.x; it < 256; it += gridDim.x) idx_score_sample_item(p, it);
    {
        u32x4 qpre[16]; float2 wvp; f16x8 kf[2][4];
        int it = blockIdx.x;
        IdxChunk ck = idx_chunk_decode(it < 748 ? it : 0);
        if (it < 748) { idx_chunk_load_q(p, ck, qpre, wvp); idx_chunk_load_k(p, ck.b, ck.m0, kf); }
        for (; it < 748; it += gridDim.x) {
            const int nx = it + (int)gridDim.x; const bool has_next = nx < 748;
            const IdxChunk cn = idx_chunk_decode(has_next ? nx : 0);
            idx_score_chunk(p, ck, has_next, cn, qpre, wvp, kf, (ldsp)smem);
            ck = cn;
        }
    }
}
__device__ __forceinline__ void phase_attn_prompt(const Params& p, unsigned char* smem, bool has_sample) {
    const int tid_ = opaque((int)threadIdx.x), wl = tid_ >> 6, lane = tid_ & 63;
    if (has_sample) attn_sample_units(p, (int)blockIdx.x, smem);
    ldsp priv = (ldsp)smem + wl * 17408;
    unsigned* ctr = p.bar + 3600;
    for (;;) {
        unsigned pi = 0;
        if (lane == 0) pi = atomicAdd(ctr, 1u);
        pi = (unsigned)__builtin_amdgcn_readfirstlane((int)pi);
        if (pi >= 8192u) break;
        const int b = pi >> 11, tt = pi & 2047;
        attn_query_wave(p, b, tt, priv);
        attn_query_wave(p, b, 4095 - tt, priv);
    }
}

__device__ __forceinline__ unsigned med3u(unsigned a, unsigned b, unsigned c) { unsigned r; asm("v_med3_u32 %0, %1, %2, %3" : "=v"(r) : "v"(a), "v"(b), "v"(c)); return r; }
__device__ __forceinline__ void ins16(unsigned (&top)[16], unsigned x) {
#pragma unroll
    for (int j = 15; j >= 1; --j) top[j] = med3u(top[j - 1], top[j], x);
    top[0] = top[0] > x ? top[0] : x;
}
template <int NT0, int NT1>
__device__ __forceinline__ void peer_score_load(const Params& p, int item, u32x4 (&af)[8], u32x4 (&bf)[4][8]) {
    const int tid = opaque((int)threadIdx.x), lane = tid & 63, w = __builtin_amdgcn_readfirstlane(tid >> 6);
    const int tile = item >> 3, hd = item & 7, row0 = tile * 128;
    const int r31 = lane & 31, lh = lane >> 5, l = w >> 2, mt = w & 3;
    const char* ag = (const char*)(p.QP + (size_t)(row0 + 32 * mt + r31) * 2048 + hd * 256 + l * 128 + 8 * lh);
    if (NT0 == 0) {
#pragma unroll
        for (int s2 = 0; s2 < 8; ++s2) af[s2] = *(const u32x4*)(ag + 32 * s2);
    }
#pragma unroll
    for (int nt = NT0; nt < NT1; ++nt) {
        const char* bg = (const char*)(p.SUBK + (size_t)((hd * 2 + l) * 128 + 32 * nt + r31) * 128 + 8 * lh);
#pragma unroll
        for (int s2 = 0; s2 < 8; ++s2) bf[nt][s2] = *(const u32x4*)(bg + 32 * s2);
    }
}
__device__ __forceinline__ void peer_score_item(const Params& p, int item, int next_item, u32x4 (&af)[8], u32x4 (&bf)[4][8], ldsp lds) {
    const int tid = opaque((int)threadIdx.x), lane = tid & 63, w = __builtin_amdgcn_readfirstlane(tid >> 6);
    const int tile = item >> 3, hd = item & 7, row0 = tile * 128;
    constexpr int PT = 257;
    LAS3 float* sc = (LAS3 float*)lds;
    const int r31 = lane & 31, lh = lane >> 5;
    peer_score_load<2, 4>(p, item, af, bf);
    {
        const int l = w >> 2, mt = w & 3;
#pragma unroll
        for (int nt = 0; nt < 4; ++nt) {
            f32x16 a;
#pragma unroll
            for (int i = 0; i < 16; ++i) a[i] = 0.f;
#pragma unroll
            for (int s2 = 0; s2 < 8; ++s2) a = MFMA32(__builtin_bit_cast(bf16x8, af[s2]), __builtin_bit_cast(bf16x8, bf[nt][s2]), a);
#pragma unroll
            for (int reg = 0; reg < 16; ++reg) sc[(32 * mt + crow(reg, lh)) * PT + l * 128 + 32 * nt + r31] = a[reg];
        }
    }
    __syncthreads();
    if (next_item >= 0) peer_score_load<0, 2>(p, next_item, af, bf);
    const int part = tid & 1, tok = (tid >> 1) & 127, l = tid >> 8;
    unsigned top[16];
#pragma unroll
    for (int j = 0; j < 16; ++j) top[j] = 0u;
    {
        LAS3 float* base = sc + tok * PT + l * 128 + part;
#pragma unroll 4
        for (int e = 0; e < 64; ++e) {
            const int n = 2 * e + part;
            ins16(top, (fkey(base[2 * e]) & ~127u) | (unsigned)(127 - n));
        }
    }
    {
        unsigned oth[16];
#pragma unroll
        for (int j = 0; j < 16; ++j) oth[j] = (unsigned)__shfl_xor((int)top[j], 1);
#pragma unroll
        for (int j = 0; j < 16; ++j) ins16(top, oth[j]);
    }
    float tv[16]; int tix[16];
#pragma unroll
    for (int j = 0; j < 16; ++j) { tix[j] = 127 - (int)(top[j] & 127u); tv[j] = sc[tok * PT + l * 128 + tix[j]]; }
    __syncthreads();
    LAS3 float* TV = (LAS3 float*)lds;
    LAS3 int* TI = (LAS3 int*)(lds + 32768);
    if (part == 0) {
#pragma unroll
        for (int j = 0; j < 16; ++j) { TV[(tok * 2 + l) * 17 + j] = tv[j]; TI[(tok * 2 + l) * 17 + j] = tix[j]; }
    }
    __syncthreads();
    if (tid < 128) {
        const int tk = tid;
        float v1[16], v2[16];
#pragma unroll
        for (int j = 0; j < 16; ++j) { v1[j] = TV[(tk * 2) * 17 + j]; v2[j] = TV[(tk * 2 + 1) * 17 + j]; }
        unsigned ct[16];
#pragma unroll
        for (int j = 0; j < 16; ++j) ct[j] = 0u;
#pragma unroll
        for (int a = 0; a < 16; ++a)
#pragma unroll
            for (int b = 0; b < 16; ++b)
                if ((a + 1) * (b + 1) <= 16) ins16(ct, (fkey(v1[a] + v2[b]) & ~255u) | (unsigned)(255 - (a * 16 + b)));
        float sv[16]; int ei[16];
        float m = -3.0e38f;
#pragma unroll
        for (int j = 0; j < 16; ++j) {
            const int cidx = 255 - (int)(ct[j] & 255u), a = cidx >> 4, b = cidx & 15;
            sv[j] = TV[(tk * 2) * 17 + a] + TV[(tk * 2 + 1) * 17 + b];
            ei[j] = TI[(tk * 2) * 17 + a] * 128 + TI[(tk * 2 + 1) * 17 + b];
            m = fmaxf(m, sv[j]);
        }
        float sum = 0.f;
#pragma unroll
        for (int j = 0; j < 16; ++j) { sv[j] = __expf(sv[j] - m); sum += sv[j]; }
        const float inv = 1.0f / sum;
        int* eo = p.EIDX + (size_t)(row0 + tk) * 128 + hd * 16;
        float* go = p.GW + (size_t)(row0 + tk) * 128 + hd * 16;
#pragma unroll
        for (int j = 0; j < 16; j += 4) {
            *(int4*)(eo + j) = make_int4(ei[j], ei[j + 1], ei[j + 2], ei[j + 3]);
            *(float4*)(go + j) = make_float4(sv[j] * inv, sv[j + 1] * inv, sv[j + 2] * inv, sv[j + 3] * inv);
        }
    }
    __syncthreads();
}
__device__ __forceinline__ void phase_peer_score(const Params& p, unsigned char* smem) {
    u32x4 af[8], bf[4][8];
    int it = blockIdx.x;
    if (it < 129 * 8) peer_score_load<0, 2>(p, it, af, bf);
    for (; it < 129 * 8; it += gridDim.x) { const int nx = it + (int)gridDim.x; peer_score_item(p, it, nx < 129 * 8 ? nx : -1, af, bf, (ldsp)smem); }
}

__device__ __forceinline__ float dot2bf(unsigned a, unsigned b, float c) {
    typedef __bf16 bf2 __attribute__((ext_vector_type(2)));
    return __builtin_amdgcn_fdot2_f32_bf16(__builtin_bit_cast(bf2, a), __builtin_bit_cast(bf2, b), c, false);
}
typedef unsigned u32x3 __attribute__((ext_vector_type(3)));
typedef float f32x32 __attribute__((ext_vector_type(32)));
template <bool SPLIT>
__device__ __forceinline__ void gather_token(const Params& p, const int r, const int kb0, const int kb1, LAS3 float* xrow, const int (&pidx)[16], const int lane, const int wl) {
#pragma unroll
        for (int q = 0; q < 2; ++q) {
            const u32x4 xb = *(const u32x4*)(p.X1B + (size_t)r * 1024 + lane * 16 + 8 * q);
            *(LAS3 f32x4*)(xrow + lane * 16 + 8 * q) = (f32x4){__uint_as_float(xb[0] << 16), __uint_as_float(xb[0] & 0xffff0000u), __uint_as_float(xb[1] << 16), __uint_as_float(xb[1] & 0xffff0000u)};
            *(LAS3 f32x4*)(xrow + lane * 16 + 8 * q + 4) = (f32x4){__uint_as_float(xb[2] << 16), __uint_as_float(xb[2] & 0xffff0000u), __uint_as_float(xb[3] << 16), __uint_as_float(xb[3] & 0xffff0000u)};
        }
        asm volatile("" ::: "memory");
        float x[16];
#pragma unroll
        for (int m = 0; m < 16; ++m) x[m] = xrow[pidx[m]];
        const int e0 = p.EIDX[(size_t)r * 128 + lane], e1 = p.EIDX[(size_t)r * 128 + 64 + lane];
        const float g0 = p.GW[(size_t)r * 128 + lane], g1 = p.GW[(size_t)r * 128 + 64 + lane];
        float o[16];
#pragma unroll
        for (int i = 0; i < 16; ++i) o[i] = 0.f;
#pragma unroll 1
        for (int kb = kb0; kb < kb1; ++kb) {
            u32x3 uu[8], vv[8];
            const int esel = (kb < 8) ? e0 : e1;
#pragma unroll
            for (int j = 0; j < 8; ++j) {
                const int e = __builtin_amdgcn_readlane(esel, (kb * 8 + j) & 63);
                uu[j] = *(const u32x3*)(p.U8 + (size_t)e * 768 + lane * 12);
                vv[j] = *(const u32x3*)(p.V8 + (size_t)e * 768 + lane * 12);
            }
            float d[8];
#pragma unroll
            for (int j = 0; j < 8; j += 2) {
                const u32x6 w6 = {uu[j][0], uu[j][1], uu[j][2], uu[j + 1][0], uu[j + 1][1], uu[j + 1][2]};
                const f32x32 f = __builtin_amdgcn_cvt_scalef32_pk32_f32_fp6(w6, 1.0f);
                float t0 = 0.f, t1 = 0.f;
#pragma unroll
                for (int m = 0; m < 16; ++m) { t0 += x[m] * f[m]; t1 += x[m] * f[16 + m]; }
                d[j] = t0; d[j + 1] = t1;
            }
            float r4[4], r2[2], r1;
#pragma unroll
            for (int j = 0; j < 4; ++j) { const float keep = (lane & 1) ? d[2 * j + 1] : d[2 * j], send = (lane & 1) ? d[2 * j] : d[2 * j + 1]; r4[j] = keep + __shfl_xor(send, 1); }
#pragma unroll
            for (int j = 0; j < 2; ++j) { const float keep = (lane & 2) ? r4[2 * j + 1] : r4[2 * j], send = (lane & 2) ? r4[2 * j] : r4[2 * j + 1]; r2[j] = keep + __shfl_xor(send, 2); }
            { const float keep = (lane & 4) ? r2[1] : r2[0], send = (lane & 4) ? r2[0] : r2[1]; r1 = keep + __shfl_xor(send, 4); }
            r1 += __shfl_xor(r1, 8); r1 += __shfl_xor(r1, 16); r1 += __shfl_xor(r1, 32);
            const float gk = __shfl((kb < 8) ? g0 : g1, (kb * 8 + (lane & 7)) & 63);
            const float dt = r1 * (1.0f / 48.0f);
            const float wk = gk * 0.5f * dt * (1.0f + erff(dt * 0.7071067811865476f)) * (1.0f / 7.0f);
#pragma unroll
            for (int j = 0; j < 8; j += 2) {
                const float wa = __uint_as_float((unsigned)__builtin_amdgcn_readlane((int)__float_as_uint(wk), j));
                const float wb = __uint_as_float((unsigned)__builtin_amdgcn_readlane((int)__float_as_uint(wk), j + 1));
                const u32x6 w6 = {vv[j][0], vv[j][1], vv[j][2], vv[j + 1][0], vv[j + 1][1], vv[j + 1][2]};
                const f32x32 f = __builtin_amdgcn_cvt_scalef32_pk32_f32_fp6(w6, 1.0f);
#pragma unroll
                for (int m = 0; m < 16; ++m) o[m] += wa * f[m] + wb * f[16 + m];
            }
        }
        asm volatile("" ::: "memory");
#pragma unroll
        for (int m = 0; m < 16; ++m) xrow[pidx[m]] = o[m];
        asm volatile("" ::: "memory");
        if (SPLIT) { __syncthreads(); if (wl != 0) { __syncthreads(); return; } }
        float v[16];
        float sm = 0.f;
#pragma unroll
        for (int q = 0; q < 4; ++q) {
            f32x4 on = *(LAS3 f32x4*)(xrow + lane * 16 + 4 * q);
            if (SPLIT) {
#pragma unroll
                for (int w8 = 1; w8 < 8; ++w8) on += *(LAS3 f32x4*)(xrow + w8 * 2048 + lane * 16 + 4 * q);
            }
            const u32x2 pw_ = *(const u32x2*)(p.PLE + (size_t)r * 1024 + lane * 16 + 4 * q);
            float4 pl; pl.x = __uint_as_float(pw_[0] << 16); pl.y = __uint_as_float(pw_[0] & 0xffff0000u); pl.z = __uint_as_float(pw_[1] << 16); pl.w = __uint_as_float(pw_[1] & 0xffff0000u);
            const u32x2 xw = *(const u32x2*)(p.X1B + (size_t)r * 1024 + lane * 16 + 4 * q);
            float4 xn; xn.x = __uint_as_float(xw[0] << 16); xn.y = __uint_as_float(xw[0] & 0xffff0000u); xn.z = __uint_as_float(xw[1] << 16); xn.w = __uint_as_float(xw[1] & 0xffff0000u);
            v[4 * q] = ALPHA * xn.x + on[0] + pl.x; v[4 * q + 1] = ALPHA * xn.y + on[1] + pl.y;
            v[4 * q + 2] = ALPHA * xn.z + on[2] + pl.z; v[4 * q + 3] = ALPHA * xn.w + on[3] + pl.w;
            sm += (v[4 * q] + v[4 * q + 1]) + (v[4 * q + 2] + v[4 * q + 3]);
        }
        asm volatile("" ::: "memory");
        const float mean = wave_sum(sm) * (1.0f / 1024.0f);
        float sq = 0.f;
#pragma unroll
        for (int i = 0; i < 16; ++i) { const float dd = v[i] - mean; sq += dd * dd; }
        const float rstd = rsqrtf(wave_sum(sq) * (1.0f / 1024.0f) + LN_EPS);
        float* y = (r < TP) ? (p.y_prompt + (size_t)r * 1024) : (p.y_sample + (size_t)(r - TP) * 1024);
#pragma unroll
        for (int q = 0; q < 4; ++q) {
            const int c = lane * 16 + 4 * q;
            const float4 g4 = *(const float4*)(p.ln2_g + c), b4 = *(const float4*)(p.ln2_b + c);
            float4 ov; ov.x = (v[4 * q] - mean) * rstd * g4.x + b4.x; ov.y = (v[4 * q + 1] - mean) * rstd * g4.y + b4.y;
            ov.z = (v[4 * q + 2] - mean) * rstd * g4.z + b4.z; ov.w = (v[4 * q + 3] - mean) * rstd * g4.w + b4.w;
            *(float4*)(y + c) = ov;
        }
        if (SPLIT) __syncthreads();
}
__device__ __forceinline__ void phase_peer_gather(const Params& p, unsigned char* smem) {
    const int tid_ = opaque((int)threadIdx.x), lane = tid_ & 63, wl = tid_ >> 6;
    LAS3 float* xrow = (LAS3 float*)((ldsp)smem + wl * 8192);
    int pidx[16];
    {
        f32x16 fa, fb;
#pragma unroll
        for (int k = 0; k < 16; ++k) { fa[k] = (k < 8) ? 0.125f * k : (1.0f + 0.125f * (k & 7)); const int k2 = 16 + k; fb[k] = (1.0f + 0.125f * (k2 & 7)) * ((k2 < 24) ? 2.0f : 4.0f); }
        const u32x6 w6 = __builtin_amdgcn_cvt_scalef32_2xpk16_fp6_f32(fa, fb, 1.0f);
        const f32x32 rr = __builtin_amdgcn_cvt_scalef32_pk32_f32_fp6(w6, 1.0f);
        const int hsel = lane & 1;
#pragma unroll
        for (int m = 0; m < 16; ++m) {
            const float v = hsel ? rr[16 + m] : rr[m];
            const unsigned bits = __float_as_uint(v);
            const int kk = (v < 1.0f) ? (int)(v * 8.0f) : (8 * ((int)(bits >> 23) - 126) + (int)((bits >> 20) & 7u));
            pidx[m] = 32 * (lane >> 1) + kk;
        }
    }
    for (int r = blockIdx.x * 8 + wl; r < TP; r += gridDim.x * 8) gather_token<false>(p, r, 0, 16, xrow, pidx, lane, wl);
    for (int sb = blockIdx.x; sb < TS; sb += gridDim.x) gather_token<true>(p, TP + sb, 2 * wl, 2 * wl + 2, xrow, pidx, lane, wl);
}

struct SEpiBr1 { const bf16_t* G; bf16_t* O; __device__ __forceinline__ void operator()(int r, int c, float v) const { O[(size_t)r * 1024 + c] = f2bf(bf2f(G[(size_t)r * 1024 + c]) * v); } };
struct SEpiBr2 { const bf16_t* G; const bf16_t* I; bf16_t* O; __device__ __forceinline__ void operator()(int r, int c, float v) const { O[(size_t)r * 1024 + c] = f2bf(bf2f(I[(size_t)r * 1024 + c]) + bf2f(G[(size_t)r * 1024 + c]) * v); } };
struct SEpiF32 { float* O; __device__ __forceinline__ void operator()(int r, int c, float v) const { O[(size_t)r * 1024 + c] = v; } };
struct SEpiOutV { const float* xs; bf16_t* O; __device__ __forceinline__ void operator()(int r, int c, float v) const { O[(size_t)r * 1024 + c] = f2bf(ALPHA * xs[(size_t)(r - TP) * 1024 + c] + v); } };
struct SEpiQG { bf16_t* QP; const float* PE; bf16_t* PLE;
    __device__ __forceinline__ void operator()(int r, int c, float v) const {
        if (c < 2048) QP[(size_t)r * 2048 + c] = f2bf(v);
        else { const size_t o = (size_t)r * 1024 + (c - 2048); PLE[o] = f2bf(sigmoidf_(v) * PE[o]); } } };
template <class SE>
__device__ __forceinline__ void small_gemm(const bf16_t* A, int K, const bf16_t* Bt, int N, const SE& E, ldsp lds, int first, int stride) {
    const int tid = opaque((int)threadIdx.x), lane = tid & 63, w = __builtin_amdgcn_readfirstlane(tid >> 6);
    const int r31 = lane & 31, lh = lane >> 5;
    const int nitems = 4 * (N >> 5), ks = K >> 3;
    LAS3 float* part = (LAS3 float*)lds;
    for (int it = first; it < nitems; it += stride) {
        const int mt = it & 3, nt = it >> 2;
        const bf16_t* ap = A + (size_t)(TP + 32 * mt + r31) * K + w * ks + 8 * lh;
        const bf16_t* bp = Bt + (size_t)(32 * nt + r31) * K + w * ks + 8 * lh;
        f32x16 acc;
#pragma unroll
        for (int i = 0; i < 16; ++i) acc[i] = 0.f;
#pragma unroll 8
        for (int s = 0; s < ks; s += 16) {
            const bf16x8 a = __builtin_bit_cast(bf16x8, *(const u32x4*)(ap + s));
            const bf16x8 b = __builtin_bit_cast(bf16x8, *(const u32x4*)(bp + s));
            acc = MFMA32(a, b, acc);
        }
#pragma unroll
        for (int reg = 0; reg < 16; ++reg) part[(w * 32 + crow(reg, lh)) * 33 + r31] = acc[reg];
        __syncthreads();
#pragma unroll
        for (int h = 0; h < 2; ++h) {
            const int e = tid + 512 * h, rr = e >> 5, cc = e & 31;
            float v = 0.f;
#pragma unroll
            for (int ww = 0; ww < 8; ++ww) v += part[(ww * 32 + rr) * 33 + cc];
            E(TP + 32 * mt + rr, 32 * nt + cc, v);
        }
        __syncthreads();
    }
}

__global__ void __launch_bounds__(512, 2) mega(Params p) {
    extern __shared__ __attribute__((aligned(16))) unsigned char smem[];
    if (threadIdx.x == 0) *(uint4*)(smem + LDS_BAR) = make_uint4(0u, 0u, 0u, 0u);
    __syncthreads();
    XcdBarrier bar = xcd_barrier_post(p.bar, (volatile LAS unsigned*)(smem + LDS_BAR));
    PG8_LAS unsigned char* lds = (PG8_LAS unsigned char*)smem;
    const int G = (int)gridDim.x, c = (int)blockIdx.x;

    phase_prologue(p, smem);
    xcd_barrier(bar);
    {
        pg8::Gemm g{p.XB, p.WinT, MP, NINP, 1024};
        pg8::StaticOrder S; S.init(MP, NINP, G, c);
        EpiIn E{p};
        pg8::gemm_phase<EpiIn, pg8::StaticOrder, false>(lds, g, S, E, nullptr);
        const int nunits = (MP / 256) * (NINP / 256), rem = nunits % G;
        const int first = (rem > 0) ? rem : 0, nidle = G - first;
        if (c >= first) phase_peer_tables(p, (size_t)(c - first) * NT + threadIdx.x, (size_t)nidle * NT);
    }
    xcd_barrier(bar);
    phase_ret_scan(p, smem);
    phase_idx_scores(p, smem);
    xcd_barrier(bar);
    phase_ret_out(p, smem);
    phase_ret_gn(p);
    __syncthreads();
    {
        const bool one_each = (int)gridDim.x >= TS;
        const bool has_sample = one_each && (int)blockIdx.x < TS;
        if (!one_each) phase_attn(p, smem);
        else if (has_sample) attn_item(p, (int)blockIdx.x, true, smem);
        phase_attn_prompt(p, smem, has_sample);
    }
    xcd_barrier(bar);
    {
        const int sfirst = G - 1 - c;
        { SEpiBr1 E{p.GA, p.BRP}; small_gemm(p.RETO, 2048, p.WretT, 1024, E, (ldsp)smem, sfirst, G); }
        asm volatile("s_waitcnt vmcnt(0)" ::: "memory"); __syncthreads();
        { SEpiBr2 E{p.GB, p.BRP, p.BR}; small_gemm(p.ATTO, 1024, p.WattT, 1024, E, (ldsp)smem, sfirst, G); }
        { SEpiF32 E{p.PE}; small_gemm(p.PB, 256, p.WpleT, 1024, E, (ldsp)smem, sfirst, G); }
        pg8::StaticOrder S; S.init(TP, 1024, G, c);
        { pg8::Gemm g{p.RETO, p.WretT, TP, 1024, 2048}; EpiBr1 E{p.GA, p.BRP}; pg8::gemm_phase<EpiBr1, pg8::StaticOrder, false>(lds, g, S, E, nullptr); }
        asm volatile("s_waitcnt vmcnt(0)" ::: "memory"); __syncthreads();
        { pg8::Gemm g{p.ATTO, p.WattT, TP, 1024, 1024}; EpiBr2 E{p.GB, p.BRP, p.BR}; pg8::gemm_phase<EpiBr2, pg8::StaticOrder, false>(lds, g, S, E, nullptr); }
        asm volatile("s_waitcnt vmcnt(0)" ::: "memory"); __syncthreads();
        { pg8::Gemm g{p.PB, p.WpleT, TP, 1024, 256}; EpiF32 E{p.PE, 1024}; pg8::gemm_phase<EpiF32, pg8::StaticOrder, false>(lds, g, S, E, nullptr); }
    }
    xcd_barrier(bar);
    {
        { SEpiOutV E{p.x_sample, p.VPRE}; small_gemm(p.BR, 1024, p.WoutT, 1024, E, (ldsp)smem, G - 1 - c, G); }
        pg8::StaticOrder S; S.init(TP, 1024, G, c);
        pg8::Gemm g{p.BR, p.WoutT, TP, 1024, 1024}; EpiOutV E{p.x_prompt, p.x_sample, p.VPRE};
        pg8::gemm_phase<EpiOutV, pg8::StaticOrder, false>(lds, g, S, E, nullptr);
    }
    xcd_barrier(bar);
    phase_ln1(p);
    xcd_barrier(bar);
    {
        { SEpiQG E{p.QP, p.PE, p.PLE}; small_gemm(p.X1B, 1024, p.WqgT, 3072, E, (ldsp)smem, G - 1 - c, G); }
        pg8::StaticOrder S; S.init(TP, 3072, G, c);
        pg8::Gemm g{p.X1B, p.WqgT, TP, 3072, 1024}; EpiQG E{p.QP, p.PE, p.PLE};
        pg8::gemm_phase<EpiQG, pg8::StaticOrder, false>(lds, g, S, E, nullptr);
    }
    xcd_barrier(bar);
    phase_peer_score(p, smem);
    xcd_barrier(bar);
    phase_peer_gather(p, smem);
}
}

extern "C" void kernel_launch(void* const* d_in, const int* in_sizes, int n_in, void* d_out, int out_size, void* d_ws, size_t ws_size,
                              hipStream_t stream) {
    using namespace mk;
    Params p{};
    p.x_prompt = (const float*)d_in[0]; p.x_sample = (const float*)d_in[1]; p.cache_k = (const float*)d_in[2]; p.cache_v = (const float*)d_in[3];
    p.cache_kidx = (const float*)d_in[4]; p.state_ret = (const float*)d_in[5]; p.page_table = (const int*)d_in[6];
    p.p_prompt = (const float*)d_in[7]; p.p_sample = (const float*)d_in[8]; p.w_in = (const float*)d_in[9];
    p.idx_k_g = (const float*)d_in[10]; p.idx_k_b = (const float*)d_in[11]; p.gn_g = (const float*)d_in[12]; p.gn_b = (const float*)d_in[13];
    p.w_ret_o = (const float*)d_in[14]; p.w_att_o = (const float*)d_in[15]; p.w_out = (const float*)d_in[16];
    p.ln1_g = (const float*)d_in[17]; p.ln1_b = (const float*)d_in[18]; p.peer_wq = (const float*)d_in[19]; p.peer_subkeys = (const float*)d_in[20];
    p.peer_u = (const float*)d_in[21]; p.peer_v = (const float*)d_in[22]; p.w_ple_gate = (const float*)d_in[23]; p.w_ple = (const float*)d_in[24];
    p.ln2_g = (const float*)d_in[25]; p.ln2_b = (const float*)d_in[26];
    float* out = (float*)d_out;
    p.y_prompt = out; p.y_sample = p.y_prompt + 16777216; p.k_prompt = p.y_sample + 131072; p.v_prompt = p.k_prompt + 4194304;
    p.kidx_prompt = p.v_prompt + 4194304; p.ret_prompt = p.kidx_prompt + 1048576; p.k_sample = p.ret_prompt + 2097152;
    p.v_sample = p.k_sample + 32768; p.kidx_sample = p.v_sample + 32768; p.ret_sample = p.kidx_sample + 8192;

    unsigned char* w = (unsigned char*)d_ws;
    size_t off = 0;
    auto take = [&](size_t bytes) { unsigned char* r = w + off; off += (bytes + 255) & ~(size_t)255; return r; };
    p.bar = (unsigned*)take(16384);
    p.XB = (bf16_t*)take((size_t)MP * 1024 * 2); p.PB = (bf16_t*)take((size_t)MP * 256 * 2);
    p.WinT = (bf16_t*)take((size_t)NINP * 1024 * 2); p.WretT = (bf16_t*)take((size_t)1024 * 2048 * 2); p.WattT = (bf16_t*)take((size_t)1024 * 1024 * 2);
    p.WoutT = (bf16_t*)take((size_t)1024 * 1024 * 2); p.WqgT = (bf16_t*)take((size_t)3072 * 1024 * 2); p.WpleT = (bf16_t*)take((size_t)1024 * 256 * 2);
    p.c256 = (float*)take((size_t)NPOS * 128 * 4); p.s256 = (float*)take((size_t)NPOS * 128 * 4);
    p.c128 = (float*)take((size_t)NPOS * 64 * 4); p.s128 = (float*)take((size_t)NPOS * 64 * 4);
    p.c64 = (float*)take((size_t)NPOS * 32 * 4); p.s64 = (float*)take((size_t)NPOS * 32 * 4);
    p.RQ = (bf16_t*)take((size_t)MP * 1024 * 2); p.RK = (bf16_t*)take((size_t)MP * 1024 * 2);
    p.RV = (bf16_t*)take((size_t)MP * 2048 * 2); p.SG = (bf16_t*)take((size_t)MP * 2048 * 2);
    p.AQ = (bf16_t*)take((size_t)MP * 1024 * 2); p.AK = (bf16_t*)take((size_t)MP * 256 * 2); p.AV = (bf16_t*)take((size_t)MP * 256 * 2);
    p.GA = (bf16_t*)take((size_t)MP * 1024 * 2); p.GB = (bf16_t*)take((size_t)MP * 1024 * 2);
    p.IQ = (f16_t*)take((size_t)MP * 512 * 2); p.IK = (f16_t*)take((size_t)MP * 64 * 2); p.IW = (float*)take((size_t)MP * 8 * 4);
    p.RO = (float*)take((size_t)MP * 2048 * 4);
    p.SC = (bf16_t*)take((size_t)16 * 32 * 256 * 512 * 2);
    p.RETO = (bf16_t*)take((size_t)MP * 2048 * 2); p.ATTO = (bf16_t*)take((size_t)MP * 1024 * 2);
    p.BRP = (bf16_t*)take((size_t)MP * 1024 * 2); p.BR = (bf16_t*)take((size_t)MP * 1024 * 2);
    p.VPRE = (bf16_t*)take((size_t)MP * 1024 * 2); p.X1 = (float*)take((size_t)256);
    p.X1B = (bf16_t*)take((size_t)MP * 1024 * 2); p.QP = (bf16_t*)take((size_t)MP * 2048 * 2);
    p.PE = (float*)take((size_t)MP * 1024 * 4); p.PLE = (bf16_t*)take((size_t)MP * 1024 * 2);
    p.U8 = (unsigned char*)take((size_t)16384 * 1024); p.V8 = (unsigned char*)take((size_t)16384 * 1024); p.SUBK = (bf16_t*)take((size_t)16 * 128 * 128 * 2);
    p.EIDX = (int*)take((size_t)MP * 128 * 4); p.GW = (float*)take((size_t)MP * 128 * 4);
    p.SCO = (float*)take((size_t)TP * 4096 * 4); p.SS = (float*)take((size_t)TS * 16392 * 4);

    static int grid = 0;
    if (!grid) {
        int dev = 0, cus = 0;
        hipGetDevice(&dev);
        hipDeviceGetAttribute(&cus, hipDeviceAttributeMultiprocessorCount, dev);
        (void)hipFuncSetAttribute((const void*)mega, hipFuncAttributeMaxDynamicSharedMemorySize, LDS_TOTAL);
        grid = cus > 0 ? cus : 256;
        if (grid > 256) grid = 256;
    }
    (void)hipMemsetAsync(p.bar, 0, 16384, stream);
    hipLaunchKernelGGL(mega, dim3(grid), dim3(NT), LDS_TOTAL, stream, p);
}
```

```cpp
#include <hip/hip_runtime.h>
#include <stdint.h>
#include <math.h>

#define LAS3 __attribute__((address_space(3)))
typedef unsigned short bf16_t;
typedef _Float16 f16_t;

namespace mk {
constexpr int TP = 16384, TS = 128, T = 16512, MP = 16640;
constexpr int NIN = 10312, NINP = 10496;
constexpr int C_RQ = 0, C_RK = 1024, C_RV = 2048, C_RG = 4096, C_AQ = 6144, C_AK = 7168, C_AV = 7424,
              C_IQ = 7680, C_IK = 8192, C_IW = 8256, C_GA = 8264, C_GB = 9288;
constexpr float ALPHA = 1.189207115002721f;
constexpr float LN_EPS = 1e-5f;
constexpr int NPOS = 4100;
constexpr int LDS_TOTAL = 147456;
constexpr int LDS_BAR = LDS_TOTAL - 16;
constexpr int NT = 512;

__device__ __forceinline__ float wave_sum(float v) {
#pragma unroll
    for (int o = 32; o >= 1; o >>= 1) v += __shfl_xor(v, o);
    return v;
}
__device__ __forceinline__ float wave_max(float v) {
#pragma unroll
    for (int o = 32; o >= 1; o >>= 1) v = fmaxf(v, __shfl_xor(v, o));
    return v;
}
__device__ __forceinline__ bf16_t f2bf(float f) { unsigned u = __float_as_uint(f); u += 0x7FFFu + ((u >> 16) & 1u); return (bf16_t)(u >> 16); }
__device__ __forceinline__ float bf2f(bf16_t b) { return __uint_as_float(((unsigned)b) << 16); }
__device__ __forceinline__ unsigned pack_bf2(float lo, float hi) { return (unsigned)f2bf(lo) | ((unsigned)f2bf(hi) << 16); }
__device__ __forceinline__ float sigmoidf_(float x) { return __builtin_amdgcn_rcpf(1.0f + __builtin_amdgcn_exp2f(-1.4426950408889634f * x)); }
__device__ __forceinline__ int posidx_of_row(int r) { return (r < TP) ? (r & 4095) : ((r < T) ? (4096 + ((r - TP) & 3)) : 0); }
}
namespace pg8 {
#define PG8_LAS __attribute__((address_space(3)))
typedef unsigned short bf16_t;
typedef short bf16x8 __attribute__((ext_vector_type(8)));
typedef float f32x4 __attribute__((ext_vector_type(4)));
typedef unsigned u32x4 __attribute__((ext_vector_type(4)));
constexpr int BM = 256, BK = 64, HALF = 128, HTB = HALF * BK * 2  , STAGE_BYTES = 8 * HTB, NXCD = 8, WGM = 2;

__host__ __device__ __forceinline__ int lds_byte(int r, int c) { const int st = (r >> 4) * 2 + (c >> 5), rr = r & 15, cc = c & 31, ob = rr * 64 + cc * 2; return st * 1024 + (ob ^ (((ob >> 9) & 1) << 5)); }
__host__ __device__ __forceinline__ void stage_rc(int b, int& R, int& C) { const int st = b / 1024, sb = b % 1024, swz = sb ^ (((sb >> 9) & 1) << 5); R = (st >> 1) * 16 + swz / 64; C = (st & 1) * 32 + (swz % 64) / 2; }
__host__ __device__ __forceinline__ int perm32(int rho) { const int n = rho >> 4, i = rho & 15; return 8 * (i >> 2) + 4 * n + (i & 3); }

struct Unit { int pm, pn; };
struct Gemm { const bf16_t* A; const bf16_t* Bt; int M, N, K; };

struct StaticOrder {
    int nM, nN, nwg, G, c;
    __host__ __device__ void init(int M, int N, int G_, int c_) { nM = M / BM; nN = N / BM; nwg = nM * nN; G = G_; c = c_; }
    __host__ __device__ bool next(int i, Unit& u) const {
        const long L = (long)i * G + c; if (L >= nwg) return false;
        int wgid = (int)L; { const int q = nwg / NXCD, r = nwg % NXCD, xcd = wgid % NXCD, off = wgid / NXCD; wgid = (xcd < r ? xcd * (q + 1) : r * (q + 1) + (xcd - r) * q) + off; }
        const int nig = WGM * nN, gid = wgid / nig, fm = gid * WGM, gsz = (nM - fm) < WGM ? (nM - fm) : WGM;
        u.pm = fm + ((wgid % nig) % gsz); u.pn = (wgid % nig) / gsz; return true;
    }
    __device__ __forceinline__ void a_ready(const Unit&) const {}
    __device__ __forceinline__ void done(const Unit&) const {}
};
__device__ __forceinline__ unsigned cvt_pk_bf16(float lo, float hi) { unsigned r; asm volatile("v_cvt_pk_bf16_f32 %0, %1, %2" : "=v"(r) : "v"(lo), "v"(hi)); return r; }
template <class Epi, class Sched, bool STAMP = false>
__device__ __forceinline__ void gemm_phase(PG8_LAS unsigned char* lds, const Gemm g, const Sched& S, const Epi& E, unsigned long long* stamps) {
    const int tid = threadIdx.x, wid = __builtin_amdgcn_readfirstlane(tid >> 6), lane = tid & 63, wr = wid >> 2, wc = wid & 3, fr = lane & 15, fq = lane >> 4;
    const int K = g.K, nt = K / BK;
    int ts_lo = 0, ts_hi = 0, nts = 0; const unsigned long long rt_entry = STAMP ? (unsigned long long)wall_clock64() : 0ull;
#define PG8_STAMP() do { if (STAMP && wid == 0 && nts < 64) { const unsigned long long _c = (unsigned long long)clock64(); \
        ts_lo = (lane == nts) ? (int)(unsigned)_c : ts_lo; ts_hi = (lane == nts) ? (int)(unsigned)(_c >> 32) : ts_hi; ++nts; } } while (0)
    PG8_STAMP();
    unsigned voffA[2], voffB[2];
#pragma unroll
    for (int i = 0; i < 2; ++i) { int R, C; stage_rc(tid * 16 + i * 8192, R, C); const int Rb = Epi::PERM ? ((R & ~31) + perm32(R & 31)) : R;
        voffA[i] = (unsigned)(R * K + C) * 2u; voffB[i] = (unsigned)(Rb * K + C) * 2u; }
    const size_t kstep = (size_t)(BK * 2);
    const size_t hstep = (size_t)HALF * K * 2;
    const size_t tstep = 2 * hstep;
    const unsigned ldsw = (unsigned)wid * 1024u;
    const int aoff = lds_byte(wr * 64 + fr, fq * 8), boff = lds_byte(wc * 32 + fr, fq * 8);
#define PG8_SA(b, h) (((b) * 2 + (h)) * HTB)
#define PG8_SB(b, h) ((4 + (b) * 2 + (h)) * HTB)
#define PG8_STAGE(bufoff, gbase, voff) do { _Pragma("unroll") for (int _i = 0; _i < 2; ++_i) \
        __builtin_amdgcn_global_load_lds((const unsigned*)((const char*)(gbase) + (voff)[_i]), (PG8_LAS unsigned*)(lds + (bufoff) + ldsw + _i * 8192), 16, 0, 0); } while (0)
#define PG8_LDA(dst, b, h) do { _Pragma("unroll") for (int m = 0; m < 4; ++m) _Pragma("unroll") for (int k = 0; k < 2; ++k) dst[m][k] = *(const PG8_LAS bf16x8*)(lds + PG8_SA(b, h) + aoff + m * 2048 + k * 1024); } while (0)
#define PG8_LDB(dst, b, h) do { _Pragma("unroll") for (int n = 0; n < 2; ++n) _Pragma("unroll") for (int k = 0; k < 2; ++k) dst[n][k] = *(const PG8_LAS bf16x8*)(lds + PG8_SB(b, h) + boff + n * 2048 + k * 1024); } while (0)
#define PG8_MMA(ai, bj, At, Bt) do { __builtin_amdgcn_s_setprio(1); _Pragma("unroll") for (int m = 0; m < 4; ++m) _Pragma("unroll") for (int n = 0; n < 2; ++n) _Pragma("unroll") for (int k = 0; k < 2; ++k) \
        acc[ai][bj][m][n] = __builtin_amdgcn_mfma_f32_16x16x32_bf16(Bt[n][k], At[m][k], acc[ai][bj][m][n], 0, 0, 0); __builtin_amdgcn_s_setprio(0); } while (0)
#define PG8_WAIT_V(n) asm volatile("s_waitcnt vmcnt(" #n ")" ::: "memory")
#define PG8_WAIT_L(n) asm volatile("s_waitcnt lgkmcnt(" #n ")" ::: "memory")
#define PG8_BAR __builtin_amdgcn_s_barrier()
#define PG8_SCHED __builtin_amdgcn_sched_barrier(0)
    Unit cur, nxt; int ui = 0;
    if (!S.next(0, cur)) return;
    f32x4 acc[2][2][4][2];
#pragma unroll
    for (int a = 0; a < 2; ++a)
#pragma unroll
        for (int b = 0; b < 2; ++b)
#pragma unroll
            for (int m = 0; m < 4; ++m)
#pragma unroll
                for (int n = 0; n < 2; ++n) acc[a][b][m][n] = (f32x4){0.f, 0.f, 0.f, 0.f};
    bf16x8 At[4][2], B0[2][2], B1[2][2];
    const char* cA = (const char*)g.A + (size_t)cur.pm * tstep; const char* cB = (const char*)g.Bt + (size_t)cur.pn * tstep;
    S.a_ready(cur);
    PG8_STAGE(PG8_SB(0, 0), cB, voffB); PG8_STAGE(PG8_SA(0, 0), cA, voffA); PG8_STAGE(PG8_SB(0, 1), cB + hstep, voffB); PG8_STAGE(PG8_SA(0, 1), cA + hstep, voffA);
    if (wr == 1) PG8_BAR;
    PG8_WAIT_V(4); PG8_BAR;
    PG8_STAGE(PG8_SB(1, 0), cB + kstep, voffB); PG8_STAGE(PG8_SA(1, 0), cA + kstep, voffA); PG8_STAGE(PG8_SB(1, 1), cB + hstep + kstep, voffB);
    PG8_WAIT_V(6); PG8_BAR;
    PG8_STAMP();
    for (;;) {
        const bool has_next = S.next(ui + 1, nxt);
        const char* nA = has_next ? (const char*)g.A + (size_t)nxt.pm * tstep : cA; const char* nB = has_next ? (const char*)g.Bt + (size_t)nxt.pn * tstep : cB;
        for (int t = 0; t < nt; t += 2) {
            const bool last = (t == nt - 2);
            const char* a1 = cA + (size_t)(t + 1) * kstep;
            const char* a2 = last ? nA : cA + (size_t)(t + 2) * kstep; const char* b2 = last ? nB : cB + (size_t)(t + 2) * kstep;
            const char* a3 = a2 + kstep; const char* b3 = b2 + kstep;
            if (last && has_next) S.a_ready(nxt);
            PG8_LDB(B0, 0, 0); PG8_SCHED; PG8_LDA(At, 0, 0); PG8_STAGE(PG8_SA(1, 1), a1 + hstep, voffA);
            PG8_WAIT_L(8); PG8_BAR; PG8_WAIT_L(0); PG8_MMA(0, 0, At, B0); PG8_BAR; PG8_SCHED;
            PG8_LDB(B1, 0, 1); PG8_STAGE(PG8_SB(0, 0), b2, voffB);
            PG8_BAR; PG8_WAIT_L(0); PG8_MMA(0, 1, At, B1); PG8_BAR;
            PG8_LDA(At, 0, 1); PG8_STAGE(PG8_SA(0, 0), a2, voffA);
            PG8_BAR; PG8_WAIT_L(0); PG8_MMA(1, 0, At, B0); PG8_BAR; PG8_SCHED;
            PG8_STAGE(PG8_SB(0, 1), b2 + hstep, voffB);
            PG8_WAIT_V(6); PG8_BAR; PG8_MMA(1, 1, At, B1); PG8_BAR;
            PG8_LDB(B0, 1, 0); PG8_SCHED; PG8_LDA(At, 1, 0); PG8_STAGE(PG8_SA(0, 1), a2 + hstep, voffA);
            PG8_WAIT_L(8); PG8_BAR; PG8_WAIT_L(0); PG8_MMA(0, 0, At, B0); PG8_BAR; PG8_SCHED;
            PG8_LDB(B1, 1, 1); PG8_STAGE(PG8_SB(1, 0), b3, voffB);
            PG8_BAR; PG8_WAIT_L(0); PG8_MMA(0, 1, At, B1); PG8_BAR;
            PG8_LDA(At, 1, 1); PG8_STAGE(PG8_SA(1, 0), a3, voffA);
            PG8_BAR; PG8_WAIT_L(0); PG8_MMA(1, 0, At, B0); PG8_BAR; PG8_SCHED;
            PG8_STAGE(PG8_SB(1, 1), b3 + hstep, voffB);
            PG8_WAIT_V(6); PG8_BAR; PG8_MMA(1, 1, At, B1); PG8_BAR;
        }
        PG8_STAMP();
        if constexpr (!Epi::AFTER_DRAIN) { E(acc, cur, wr, wc, fr, fq); S.done(cur); }
        PG8_STAMP();
        if (!has_next) break;
#pragma unroll
        for (int a = 0; a < 2; ++a)
#pragma unroll
            for (int b = 0; b < 2; ++b)
#pragma unroll
                for (int m = 0; m < 4; ++m)
#pragma unroll
                    for (int n = 0; n < 2; ++n) acc[a][b][m][n] = (f32x4){0.f, 0.f, 0.f, 0.f};
        cur = nxt; cA = nA; cB = nB; ++ui;
    }
    PG8_WAIT_V(0);
    if (wr == 0) PG8_BAR;
    PG8_BAR;
    if constexpr (Epi::AFTER_DRAIN) { E.fused(acc, cur, wr, wc, fr, fq, lds, wid, lane); S.done(cur); }
    PG8_STAMP();
    if (STAMP && wid == 0) { stamps[lane] = lane < nts ? (((unsigned long long)(unsigned)ts_hi << 32) | (unsigned)ts_lo) : 0ull;
        if (lane == 62) stamps[62] = rt_entry; if (lane == 63) stamps[63] = (unsigned long long)wall_clock64(); }
#undef PG8_STAMP
#undef PG8_SA
#undef PG8_SB
#undef PG8_STAGE
#undef PG8_LDA
#undef PG8_LDB
#undef PG8_MMA
#undef PG8_WAIT_V
#undef PG8_WAIT_L
#undef PG8_BAR
#undef PG8_SCHED
}
}
#define XB_TMO      128
#define XB_XCNT(j)  (256  + 64 * (j))
#define XB_XSUB(j)  (1280 + 64 * (j))
#define XB_XGEN(j)  (2304 + 64 * (j))
#define XB_TOP      3328
#define XB_TOPGEN   3392
#define XCD_BAR_WORDS 3456
#define XB_SPIN_CAP (1u << 18)
#define LAS __attribute__((address_space(3)))

__device__ __forceinline__ unsigned xb_ld(unsigned* p)              { return __hip_atomic_load(p, __ATOMIC_RELAXED, __HIP_MEMORY_SCOPE_AGENT); }
__device__ __forceinline__ unsigned xb_add(unsigned* p, unsigned v) { return __hip_atomic_fetch_add(p, v, __ATOMIC_RELAXED, __HIP_MEMORY_SCOPE_AGENT); }
__device__ __forceinline__ unsigned xb_xcc_id() { return (unsigned)__builtin_amdgcn_s_getreg((3 << 11) | 20) & 0xFu; }
#define XB_SPIN(cond, bar) do { unsigned _sp = 0; while (cond) { __builtin_amdgcn_s_sleep(1); \
    if ((++_sp & 255u) == 0u) { if (xb_ld(&(bar)[XB_TMO])) break; if (_sp > XB_SPIN_CAP) { atomicAdd(&(bar)[XB_TMO], 1u); break; } } } } while (0)

struct XcdBarrier {
    unsigned* bar; unsigned x;
    volatile LAS unsigned* st;
};

__device__ __forceinline__ XcdBarrier xcd_barrier_post(unsigned* bar, volatile LAS unsigned* st) {
    XcdBarrier b; b.bar = bar; b.x = xb_xcc_id(); b.st = st;
    if (threadIdx.x == 0) (void)xb_add(&bar[XB_XCNT(b.x)], 1u);
    return b;
}
__device__ __forceinline__ void xcd_barrier_complete(unsigned* bar, unsigned x, unsigned& nloc, unsigned& nx) {
    const unsigned G = gridDim.x * gridDim.y * gridDim.z;
    unsigned sum, cnt, mine, sp = 0u;
    for (;;) {
        sum = 0u; cnt = 0u; mine = 0u;
#pragma unroll
        for (unsigned j = 0; j < 16; ++j) { const unsigned c = xb_ld(&bar[XB_XCNT(j)]); sum += c; cnt += (c > 0u) ? 1u : 0u; mine = (j == x) ? c : mine; }
        if (sum == G) break;
        __builtin_amdgcn_s_sleep(1);
        if ((++sp & 255u) == 0u) { if (xb_ld(&bar[XB_TMO])) break; if (sp > XB_SPIN_CAP) { atomicAdd(&bar[XB_TMO], 1u); break; } }
    }
    nloc = mine > 0u ? mine : 1u; nx = cnt > 0u ? cnt : 1u;
}

__device__ __forceinline__ void xcd_barrier(const XcdBarrier& b) {
    asm volatile("s_waitcnt vmcnt(0)" ::: "memory");
    __syncthreads();
    if (threadIdx.x == 0) {
        unsigned* bar = b.bar;
        __builtin_amdgcn_s_waitcnt(0);
        unsigned nloc = b.st[0], nx = b.st[1];
        if (nloc == 0u) { xcd_barrier_complete(bar, b.x, nloc, nx); b.st[0] = nloc; b.st[1] = nx; }
        const unsigned old = xb_add(&bar[XB_XSUB(b.x)], 1u);
        const unsigned gen = old / nloc;
        if (old + 1u == (gen + 1u) * nloc) {
            __builtin_amdgcn_fence(__ATOMIC_RELEASE, "agent");
            asm volatile("s_waitcnt vmcnt(0)" ::: "memory");
            const unsigned og = xb_add(&bar[XB_TOP], 1u);
            const unsigned tg = og / nx;
            if (og + 1u == (tg + 1u) * nx) xb_add(&bar[XB_TOPGEN], 1u);
            else XB_SPIN(xb_ld(&bar[XB_TOPGEN]) == tg, bar);
            __builtin_amdgcn_fence(__ATOMIC_ACQUIRE, "agent");
            xb_add(&bar[XB_XGEN(b.x)], 1u);
            asm volatile("s_waitcnt vmcnt(0)" ::: "memory");
        } else {
            XB_SPIN(xb_ld(&bar[XB_XGEN(b.x)]) == gen, bar);
            __builtin_amdgcn_fence(__ATOMIC_ACQUIRE, "agent");
            asm volatile("s_waitcnt vmcnt(0)" ::: "memory");
        }
    }
    __syncthreads();
}
namespace mk {
using pg8::f32x4;
using pg8::Unit;
using pg8::cvt_pk_bf16;
using pg8::u32x4;
typedef unsigned u32x2 __attribute__((ext_vector_type(2)));
typedef unsigned u32x6 __attribute__((ext_vector_type(6)));
typedef float f32x16 __attribute__((ext_vector_type(16)));
typedef _Float16 h16x4 __attribute__((ext_vector_type(4)));

__device__ __forceinline__ int opaque(int x) { asm volatile("" : "+v"(x)); return x; }
struct Params {
    const float *x_prompt, *x_sample, *cache_k, *cache_v, *cache_kidx, *state_ret;
    const int* page_table;
    const float *p_prompt, *p_sample, *w_in, *idx_k_g, *idx_k_b, *gn_g, *gn_b, *w_ret_o, *w_att_o, *w_out, *ln1_g, *ln1_b, *peer_wq,
        *peer_subkeys, *peer_u, *peer_v, *w_ple_gate, *w_ple, *ln2_g, *ln2_b;
    float *y_prompt, *y_sample, *k_prompt, *v_prompt, *kidx_prompt, *ret_prompt, *k_sample, *v_sample, *kidx_sample, *ret_sample;
    unsigned* bar;
    bf16_t *XB, *PB, *WinT, *WretT, *WattT, *WoutT, *WqgT, *WpleT;
    float *c256, *s256, *c128, *s128, *c64, *s64;
    bf16_t *RQ, *RK, *RV, *SG, *AQ, *AK, *AV, *GA, *GB;
    f16_t *IQ, *IK;
    float* IW;
    float* RO;
    bf16_t* SC;
    bf16_t *RETO, *ATTO;
    bf16_t* BRP;
    bf16_t* BR;
    bf16_t* VPRE;
    float* X1;
    bf16_t *X1B, *QP;
    float* PE;
    bf16_t* PLE;
    bf16_t* SUBK;
    unsigned char *U8, *V8;
    int* EIDX;
    float* GW;
    float *SCO, *SS;
};

__device__ __forceinline__ void store4_bf16(bf16_t* dst, const f32x4 v) {
    u32x2 w; w.x = cvt_pk_bf16(v[0], v[1]); w.y = cvt_pk_bf16(v[2], v[3]);
    *(u32x2*)dst = w;
}
__device__ __forceinline__ void store4_f16(f16_t* dst, const f32x4 v) {
    h16x4 h; h[0] = (_Float16)v[0]; h[1] = (_Float16)v[1]; h[2] = (_Float16)v[2]; h[3] = (_Float16)v[3];
    *(h16x4*)dst = h;
}
__device__ __forceinline__ f32x4 load4_bf16(const bf16_t* src) {
    const u32x2 g = *(const u32x2*)src;
    f32x4 r; r[0] = __uint_as_float(g.x << 16); r[1] = __uint_as_float(g.x & 0xffff0000u); r[2] = __uint_as_float(g.y << 16); r[3] = __uint_as_float(g.y & 0xffff0000u);
    return r;
}
__device__ __forceinline__ f32x4 sigmoid4(const f32x4 v) {
    f32x4 r; r[0] = sigmoidf_(v[0]); r[1] = sigmoidf_(v[1]); r[2] = sigmoidf_(v[2]); r[3] = sigmoidf_(v[3]); return r;
}

__device__ __forceinline__ int win_orig(int j) {
    const int pn = j >> 8, jj = j & 255, bj = jj >> 7, w = jj & 127;
    if (pn < 24) return j;
    if (pn < 28) { const int t = pn - 24, hh = w >> 6, i = w & 63; return C_AQ + (2 * t + hh) * 128 + bj * 64 + i; }
    if (pn == 28) { const int hh = w >> 6, i = w & 63; return C_AK + hh * 128 + bj * 64 + i; }
    if (pn == 29) return C_AV + jj;
    if (pn < 32) { const int t = pn - 30, hh = w >> 5, i = w & 31; return C_IQ + (4 * t + hh) * 64 + bj * 32 + i; }
    if (pn < 36) return C_GA + (pn - 32) * 256 + jj;
    if (pn < 40) return C_GB + (pn - 36) * 256 + jj;
    if (w < 32) return C_IK + bj * 32 + w;
    if (bj == 0 && w < 40) return C_IW + (w - 32);
    return -1;
}

__device__ __forceinline__ f32x4 rope_irev(int i0, float l2theta_over_half) {
    f32x4 r;
#pragma unroll
    for (int e = 0; e < 4; ++e) r[e] = __builtin_amdgcn_exp2f(-(float)(i0 + e) * l2theta_over_half) * 0.15915494309189535f;
    return r;
}
__device__ __forceinline__ void rope_cs(float posf, const f32x4 irev, f32x4& c, f32x4& s) {
#pragma unroll
    for (int e = 0; e < 4; ++e) {
        const float hi = posf * irev[e], lo = __builtin_fmaf(posf, irev[e], -hi);
        const float fr = __builtin_amdgcn_fractf(hi) + lo;
        c[e] = __builtin_amdgcn_cosf(fr); s[e] = __builtin_amdgcn_sinf(fr);
    }
}
__device__ __forceinline__ float posf_of_row(int r) { return (float)((r < TP) ? (r & 4095) : ((r < T) ? (16384 + ((r - TP) & 3)) : 0)); }
struct EpiIn {
    static constexpr bool PERM = false, AFTER_DRAIN = false;
    const Params& p;
    __device__ __forceinline__ void operator()(const f32x4 (&acc)[2][2][4][2], const Unit& u, int wr, int wc, int fr_in, int fq_in) const {
        int fr = fr_in, fq = fq_in; asm volatile("" : "+v"(fr), "+v"(fq));
        const int pn = u.pn;
        const int rbase = u.pm * 256 + wr * 64 + fr;
        const int wbase = wc * 32 + fq * 4;
        if (pn < 8) {
            const bool isk = pn >= 4; const int h = pn & 3; bf16_t* dst = isk ? p.RK : p.RQ; const float sc = isk ? 0.0625f : 1.0f;
#pragma unroll
            for (int ai = 0; ai < 2; ++ai)
#pragma unroll
                for (int m = 0; m < 4; ++m) {
                    const int r = rbase + ai * 128 + m * 16; const float posf = posf_of_row(r);
#pragma unroll
                    for (int n = 0; n < 2; ++n) {
                        const int w0 = wbase + 16 * n;
                        f32x4 c, s; rope_cs(posf, rope_irev(w0, 0.10381025296523008f), c, s);
                        const f32x4 x1 = acc[ai][0][m][n], x2 = acc[ai][1][m][n];
                        store4_bf16(dst + (size_t)r * 1024 + h * 256 + w0, (x1 * c - x2 * s) * sc);
                        store4_bf16(dst + (size_t)r * 1024 + h * 256 + 128 + w0, (x2 * c + x1 * s) * sc);
                    }
                }
        } else if (pn < 24) {
            const bool isg = pn >= 16; bf16_t* dst = isg ? p.SG : p.RV; const int cb = (isg ? pn - 16 : pn - 8) * 256;
#pragma unroll
            for (int ai = 0; ai < 2; ++ai)
#pragma unroll
                for (int m = 0; m < 4; ++m) {
                    const int r = rbase + ai * 128 + m * 16;
#pragma unroll
                    for (int bj = 0; bj < 2; ++bj)
#pragma unroll
                        for (int n = 0; n < 2; ++n) {
                            f32x4 v = acc[ai][bj][m][n];
                            if (isg) v = v * sigmoid4(v);
                            store4_bf16(dst + (size_t)r * 2048 + cb + bj * 128 + wbase + 16 * n, v);
                        }
                }
        } else if (pn < 29) {
            const bool isk = pn == 28; const int t = isk ? 0 : pn - 24; const float sc = isk ? 1.0f : 0.08838834764831845f;
#pragma unroll
            for (int ai = 0; ai < 2; ++ai)
#pragma unroll
                for (int m = 0; m < 4; ++m) {
                    const int r = rbase + ai * 128 + m * 16; const float posf = posf_of_row(r);
#pragma unroll
                    for (int n = 0; n < 2; ++n) {
                        const int w0 = wbase + 16 * n, hh = w0 >> 6, i0 = w0 & 63;
                        f32x4 c, s; rope_cs(posf, rope_irev(i0, 0.20762050593046015f), c, s);
                        const f32x4 x1 = acc[ai][0][m][n], x2 = acc[ai][1][m][n];
                        const f32x4 o1 = (x1 * c - x2 * s) * sc, o2 = (x2 * c + x1 * s) * sc;
                        if (!isk) {
                            bf16_t* d = p.AQ + (size_t)r * 1024 + (2 * t + hh) * 128 + i0;
                            store4_bf16(d, o1); store4_bf16(d + 64, o2);
                        } else {
                            bf16_t* d = p.AK + (size_t)r * 256 + hh * 128 + i0;
                            store4_bf16(d, o1); store4_bf16(d + 64, o2);
                            if (r < T) {
                                float* o = (r < TP) ? (p.k_prompt + (size_t)r * 256) : (p.k_sample + (size_t)(r - TP) * 256);
                                *(f32x4*)(o + hh * 128 + i0) = o1; *(f32x4*)(o + hh * 128 + 64 + i0) = o2;
                            }
                        }
                    }
                }
        } else if (pn == 29) {
#pragma unroll
            for (int ai = 0; ai < 2; ++ai)
#pragma unroll
                for (int m = 0; m < 4; ++m) {
                    const int r = rbase + ai * 128 + m * 16;
                    float* o = (r < TP) ? (p.v_prompt + (size_t)r * 256) : (p.v_sample + (size_t)(r - TP) * 256);
#pragma unroll
                    for (int bj = 0; bj < 2; ++bj)
#pragma unroll
                        for (int n = 0; n < 2; ++n) {
                            const int c = bj * 128 + wbase + 16 * n;
                            store4_bf16(p.AV + (size_t)r * 256 + c, acc[ai][bj][m][n]);
                            if (r < T) *(f32x4*)(o + c) = acc[ai][bj][m][n];
                        }
                }
        } else if (pn < 32) {
            const int t = pn - 30;
#pragma unroll
            for (int ai = 0; ai < 2; ++ai)
#pragma unroll
                for (int m = 0; m < 4; ++m) {
                    const int r = rbase + ai * 128 + m * 16; const float posf = posf_of_row(r);
#pragma unroll
                    for (int n = 0; n < 2; ++n) {
                        const int w0 = wbase + 16 * n, hh = w0 >> 5, i0 = w0 & 31;
                        f32x4 c, s; rope_cs(posf, rope_irev(i0, 0.4152410118609203f), c, s);
                        const f32x4 x1 = acc[ai][0][m][n], x2 = acc[ai][1][m][n];
                        f16_t* d = p.IQ + (size_t)r * 512 + (4 * t + hh) * 64 + i0;
                        store4_f16(d, x1 * c - x2 * s); store4_f16(d + 32, x2 * c + x1 * s);
                    }
                }
        } else if (pn < 40) {
            const bool isb = pn >= 36; bf16_t* dst = isb ? p.GB : p.GA; const int cb = (isb ? pn - 36 : pn - 32) * 256;
#pragma unroll
            for (int ai = 0; ai < 2; ++ai)
#pragma unroll
                for (int m = 0; m < 4; ++m) {
                    const int r = rbase + ai * 128 + m * 16;
#pragma unroll
                    for (int bj = 0; bj < 2; ++bj)
#pragma unroll
                        for (int n = 0; n < 2; ++n)
                            store4_bf16(dst + (size_t)r * 1024 + cb + bj * 128 + wbase + 16 * n, sigmoid4(acc[ai][bj][m][n]));
                }
        } else {
            if (wc == 0) {
#pragma unroll
                for (int ai = 0; ai < 2; ++ai)
#pragma unroll
                    for (int m = 0; m < 4; ++m) {
                        const int r = rbase + ai * 128 + m * 16; const int pi = posidx_of_row(r);
                        float s = 0.f;
#pragma unroll
                        for (int bj = 0; bj < 2; ++bj)
#pragma unroll
                            for (int n = 0; n < 2; ++n) { const f32x4 x = acc[ai][bj][m][n]; s += (x[0] + x[1]) + (x[2] + x[3]); }
                        s += __shfl_xor(s, 16); s += __shfl_xor(s, 32);
                        const float mean = s * (1.0f / 64.0f);
                        float q = 0.f;
#pragma unroll
                        for (int bj = 0; bj < 2; ++bj)
#pragma unroll
                            for (int n = 0; n < 2; ++n) { const f32x4 d = acc[ai][bj][m][n] - mean; q += (d[0] * d[0] + d[1] * d[1]) + (d[2] * d[2] + d[3] * d[3]); }
                        q += __shfl_xor(q, 16); q += __shfl_xor(q, 32);
                        const float rstd = rsqrtf(q * (1.0f / 64.0f) + LN_EPS);
                        float* ko = (r < TP) ? (p.kidx_prompt + (size_t)r * 64) : (p.kidx_sample + (size_t)(r - TP) * 64);
#pragma unroll
                        for (int n = 0; n < 2; ++n) {
                            const int w0 = wbase + 16 * n;
                            const f32x4 g1 = *(const f32x4*)(p.idx_k_g + w0), g2 = *(const f32x4*)(p.idx_k_g + 32 + w0);
                            const f32x4 b1 = *(const f32x4*)(p.idx_k_b + w0), b2 = *(const f32x4*)(p.idx_k_b + 32 + w0);
                            const f32x4 x1 = (acc[ai][0][m][n] - mean) * rstd * g1 + b1, x2 = (acc[ai][1][m][n] - mean) * rstd * g2 + b2;
                            f32x4 c, sn; rope_cs(posf_of_row(r), rope_irev(w0, 0.4152410118609203f), c, sn);
                            const f32x4 o1 = x1 * c - x2 * sn, o2 = x2 * c + x1 * sn;
                            store4_f16(p.IK + (size_t)r * 64 + w0, o1); store4_f16(p.IK + (size_t)r * 64 + 32 + w0, o2);
                            if (r < T) { *(f32x4*)(ko + w0) = o1; *(f32x4*)(ko + 32 + w0) = o2; }
                        }
                    }
            } else if (wc == 1 && fq < 2) {
#pragma unroll
                for (int ai = 0; ai < 2; ++ai)
#pragma unroll
                    for (int m = 0; m < 4; ++m) {
                        const int r = rbase + ai * 128 + m * 16;
                        *(f32x4*)(p.IW + (size_t)r * 8 + 4 * fq) = acc[ai][0][m][0] * (0.35355339059327373f * 0.125f);
                    }
            }
        }
    }
};

struct EpiBr1 {
    static constexpr bool PERM = false, AFTER_DRAIN = false;
    const bf16_t* G; bf16_t* O;
    __device__ __forceinline__ void operator()(const f32x4 (&acc)[2][2][4][2], const Unit& u, int wr, int wc, int fr_in, int fq_in) const {
        int fr = fr_in, fq = fq_in; asm volatile("" : "+v"(fr), "+v"(fq));
        const int rbase = u.pm * 256 + wr * 64 + fr, cbase = u.pn * 256 + wc * 32 + fq * 4;
#pragma unroll
        for (int ai = 0; ai < 2; ++ai) {
            u32x2 gv[4][2][2];
#pragma unroll
            for (int m = 0; m < 4; ++m)
#pragma unroll
                for (int bj = 0; bj < 2; ++bj)
#pragma unroll
                    for (int n = 0; n < 2; ++n) gv[m][bj][n] = *(const u32x2*)(G + (size_t)(rbase + ai * 128 + m * 16) * 1024 + cbase + bj * 128 + 16 * n);
            asm volatile("" ::: "memory");
#pragma unroll
            for (int m = 0; m < 4; ++m)
#pragma unroll
                for (int bj = 0; bj < 2; ++bj)
#pragma unroll
                    for (int n = 0; n < 2; ++n) {
                        const u32x2 g = gv[m][bj][n];
                        f32x4 gf; gf[0] = __uint_as_float(g.x << 16); gf[1] = __uint_as_float(g.x & 0xffff0000u); gf[2] = __uint_as_float(g.y << 16); gf[3] = __uint_as_float(g.y & 0xffff0000u);
                        store4_bf16(O + (size_t)(rbase + ai * 128 + m * 16) * 1024 + cbase + bj * 128 + 16 * n, gf * acc[ai][bj][m][n]);
                    }
            asm volatile("" ::: "memory");
        }
    }
};
struct EpiBr2 {
    static constexpr bool PERM = false, AFTER_DRAIN = false;
    const bf16_t* G; const bf16_t* I; bf16_t* O;
    __device__ __forceinline__ void operator()(const f32x4 (&acc)[2][2][4][2], const Unit& u, int wr, int wc, int fr_in, int fq_in) const {
        int fr = fr_in, fq = fq_in; asm volatile("" : "+v"(fr), "+v"(fq));
        const int rbase = u.pm * 256 + wr * 64 + fr, cbase = u.pn * 256 + wc * 32 + fq * 4;
#pragma unroll
        for (int ai = 0; ai < 2; ++ai)
#pragma unroll
            for (int mh = 0; mh < 2; ++mh) {
                u32x2 gv[2][2][2]; f32x4 iv[2][2][2];
#pragma unroll
                for (int m2 = 0; m2 < 2; ++m2)
#pragma unroll
                    for (int bj = 0; bj < 2; ++bj)
#pragma unroll
                        for (int n = 0; n < 2; ++n) {
                            const size_t o = (size_t)(rbase + ai * 128 + (2 * mh + m2) * 16) * 1024 + cbase + bj * 128 + 16 * n;
                            gv[m2][bj][n] = *(const u32x2*)(G + o); iv[m2][bj][n] = load4_bf16(I + o);
                        }
                asm volatile("" ::: "memory");
#pragma unroll
                for (int m2 = 0; m2 < 2; ++m2)
#pragma unroll
                    for (int bj = 0; bj < 2; ++bj)
#pragma unroll
                        for (int n = 0; n < 2; ++n) {
                            const size_t o = (size_t)(rbase + ai * 128 + (2 * mh + m2) * 16) * 1024 + cbase + bj * 128 + 16 * n;
                            const u32x2 g = gv[m2][bj][n];
                            f32x4 gf; gf[0] = __uint_as_float(g.x << 16); gf[1] = __uint_as_float(g.x & 0xffff0000u); gf[2] = __uint_as_float(g.y << 16); gf[3] = __uint_as_float(g.y & 0xffff0000u);
                            store4_bf16(O + o, iv[m2][bj][n] + gf * acc[ai][2 * 0 + bj][2 * mh + m2][n]);
                        }
                asm volatile("" ::: "memory");
            }
    }
};
struct EpiF32 {
    static constexpr bool PERM = false, AFTER_DRAIN = false;
    float* O; int ldc;
    __device__ __forceinline__ void operator()(const f32x4 (&acc)[2][2][4][2], const Unit& u, int wr, int wc, int fr_in, int fq_in) const {
        int fr = fr_in, fq = fq_in; asm volatile("" : "+v"(fr), "+v"(fq));
        const int rbase = u.pm * 256 + wr * 64 + fr, cbase = u.pn * 256 + wc * 32 + fq * 4;
#pragma unroll
        for (int ai = 0; ai < 2; ++ai)
#pragma unroll
            for (int m = 0; m < 4; ++m) {
                const size_t ro = (size_t)(rbase + ai * 128 + m * 16) * ldc;
#pragma unroll
                for (int bj = 0; bj < 2; ++bj)
#pragma unroll
                    for (int n = 0; n < 2; ++n) *(f32x4*)(O + ro + cbase + bj * 128 + 16 * n) = acc[ai][bj][m][n];
            }
    }
};
struct EpiOutV {
    static constexpr bool PERM = false, AFTER_DRAIN = false;
    const float *xp, *xs; bf16_t* O;
    __device__ __forceinline__ void operator()(const f32x4 (&acc)[2][2][4][2], const Unit& u, int wr, int wc, int fr_in, int fq_in) const {
        int fr = fr_in, fq = fq_in; asm volatile("" : "+v"(fr), "+v"(fq));
        const int rbase = u.pm * 256 + wr * 64 + fr, cbase = u.pn * 256 + wc * 32 + fq * 4;
#pragma unroll
        for (int ai = 0; ai < 2; ++ai)
#pragma unroll
            for (int mh = 0; mh < 2; ++mh) {
                f32x4 xv[2][2][2];
#pragma unroll
                for (int m2 = 0; m2 < 2; ++m2)
#pragma unroll
                    for (int bj = 0; bj < 2; ++bj)
#pragma unroll
                        for (int n = 0; n < 2; ++n) {
                            const int r = rbase + ai * 128 + (2 * mh + m2) * 16;
                            xv[m2][bj][n] = (r < TP) ? *(const f32x4*)(xp + (size_t)r * 1024 + cbase + bj * 128 + 16 * n) : (f32x4){0.f, 0.f, 0.f, 0.f};
                        }
                asm volatile("" ::: "memory");
#pragma unroll
                for (int m2 = 0; m2 < 2; ++m2)
#pragma unroll
                    for (int bj = 0; bj < 2; ++bj)
#pragma unroll
                        for (int n = 0; n < 2; ++n) {
                            const int r = rbase + ai * 128 + (2 * mh + m2) * 16;
                            store4_bf16(O + (size_t)r * 1024 + cbase + bj * 128 + 16 * n, xv[m2][bj][n] * ALPHA + acc[ai][bj][2 * mh + m2][n]);
                        }
                asm volatile("" ::: "memory");
            }
    }
};
struct EpiQG {
    static constexpr bool PERM = false, AFTER_DRAIN = false;
    bf16_t* QP; const float* PE; bf16_t* PLE;
    __device__ __forceinline__ void operator()(const f32x4 (&acc)[2][2][4][2], const Unit& u, int wr, int wc, int fr_in, int fq_in) const {
        int fr = fr_in, fq = fq_in; asm volatile("" : "+v"(fr), "+v"(fq));
        const int rbase = u.pm * 256 + wr * 64 + fr, cbase = u.pn * 256 + wc * 32 + fq * 4;
        if (u.pn < 8) {
#pragma unroll
            for (int ai = 0; ai < 2; ++ai)
#pragma unroll
                for (int m = 0; m < 4; ++m) {
                    const int r = rbase + ai * 128 + m * 16;
#pragma unroll
                    for (int bj = 0; bj < 2; ++bj)
#pragma unroll
                        for (int n = 0; n < 2; ++n) store4_bf16(QP + (size_t)r * 2048 + cbase + bj * 128 + 16 * n, acc[ai][bj][m][n]);
                }
        } else {
#pragma unroll
            for (int ai = 0; ai < 2; ++ai)
#pragma unroll
                for (int mh = 0; mh < 2; ++mh) {
                    f32x4 pv[2][2][2];
#pragma unroll
                    for (int m2 = 0; m2 < 2; ++m2)
#pragma unroll
                        for (int bj = 0; bj < 2; ++bj)
#pragma unroll
                            for (int n = 0; n < 2; ++n) pv[m2][bj][n] = *(const f32x4*)(PE + (size_t)(rbase + ai * 128 + (2 * mh + m2) * 16) * 1024 + (cbase - 2048) + bj * 128 + 16 * n);
                    asm volatile("" ::: "memory");
#pragma unroll
                    for (int m2 = 0; m2 < 2; ++m2)
#pragma unroll
                        for (int bj = 0; bj < 2; ++bj)
#pragma unroll
                            for (int n = 0; n < 2; ++n)
                                store4_bf16(PLE + (size_t)(rbase + ai * 128 + (2 * mh + m2) * 16) * 1024 + (cbase - 2048) + bj * 128 + 16 * n, sigmoid4(acc[ai][bj][2 * mh + m2][n]) * pv[m2][bj][n]);
                    asm volatile("" ::: "memory");
                }
        }
    }
};

__device__ __forceinline__ void phase_peer_tables(const Params& p, size_t gtid, size_t gstride) {
    for (size_t i = gtid; i < (size_t)2 * 16384 * 32; i += gstride) {
        const bool isv = i >= (size_t)16384 * 32;
        const size_t j = isv ? i - (size_t)16384 * 32 : i;
        const float* src = (isv ? p.peer_v : p.peer_u) + j * 32;
        const float sc = isv ? 7.0f : 48.0f;
        f32x16 fa, fb;
#pragma unroll
        for (int q = 0; q < 4; ++q) {
            const float4 a = *(const float4*)(src + 4 * q), b = *(const float4*)(src + 16 + 4 * q);
            fa[4 * q] = a.x * sc; fa[4 * q + 1] = a.y * sc; fa[4 * q + 2] = a.z * sc; fa[4 * q + 3] = a.w * sc;
            fb[4 * q] = b.x * sc; fb[4 * q + 1] = b.y * sc; fb[4 * q + 2] = b.z * sc; fb[4 * q + 3] = b.w * sc;
        }
        const u32x6 w6 = __builtin_amdgcn_cvt_scalef32_2xpk16_fp6_f32(fa, fb, 1.0f);
        unsigned* dst = (unsigned*)((isv ? p.V8 : p.U8) + j * 24);
        *(u32x2*)dst = (u32x2){w6[0], w6[1]}; *(u32x2*)(dst + 2) = (u32x2){w6[2], w6[3]}; *(u32x2*)(dst + 4) = (u32x2){w6[4], w6[5]};
    }
    for (size_t i = gtid; i < (size_t)32768; i += gstride) {
        const float4 a = *(const float4*)(p.peer_subkeys + i * 8), b = *(const float4*)(p.peer_subkeys + i * 8 + 4);
        uint4 o; o.x = pack_bf2(a.x, a.y); o.y = pack_bf2(a.z, a.w); o.z = pack_bf2(b.x, b.y); o.w = pack_bf2(b.z, b.w);
        *(uint4*)(p.SUBK + i * 8) = o;
    }
}

__device__ __forceinline__ void phase_prologue(const Params& p, unsigned char* smem) {
    const int tid = opaque((int)threadIdx.x);
    const size_t gtid = (size_t)blockIdx.x * NT + tid, gstride = (size_t)gridDim.x * NT;
    for (size_t i = gtid; i < (size_t)MP * 128; i += gstride) {
        const int r = (int)(i >> 7), c8 = (int)(i & 127);
        uint4 o = make_uint4(0u, 0u, 0u, 0u);
        if (r < T) {
            const float* src = (r < TP) ? (p.x_prompt + (size_t)r * 1024) : (p.x_sample + (size_t)(r - TP) * 1024);
            const float4 a = *(const float4*)(src + c8 * 8), b = *(const float4*)(src + c8 * 8 + 4);
            o.x = pack_bf2(a.x, a.y); o.y = pack_bf2(a.z, a.w); o.z = pack_bf2(b.x, b.y); o.w = pack_bf2(b.z, b.w);
        }
        *(uint4*)(p.XB + (size_t)r * 1024 + c8 * 8) = o;
    }
    for (size_t i = gtid; i < (size_t)MP * 32; i += gstride) {
        const int r = (int)(i >> 5), c8 = (int)(i & 31);
        uint4 o = make_uint4(0u, 0u, 0u, 0u);
        if (r < T) {
            const float* src = (r < TP) ? (p.p_prompt + (size_t)r * 256) : (p.p_sample + (size_t)(r - TP) * 256);
            const float4 a = *(const float4*)(src + c8 * 8), b = *(const float4*)(src + c8 * 8 + 4);
            o.x = pack_bf2(a.x, a.y); o.y = pack_bf2(a.z, a.w); o.z = pack_bf2(b.x, b.y); o.w = pack_bf2(b.z, b.w);
        }
        *(uint4*)(p.PB + (size_t)r * 256 + c8 * 8) = o;
    }
    float* tile = (float*)smem;
    for (int task = blockIdx.x; task < 4480; task += gridDim.x) {
        const float* src; bf16_t* dst; int K, N, ntk, t, mapped = 0;
        if (task < 2624) { t = task; src = p.w_in; dst = p.WinT; K = 1024; N = NIN; ntk = 16; mapped = 1; }
        else if (task < 3136) { t = task - 2624; src = p.w_ret_o; dst = p.WretT; K = 2048; N = 1024; ntk = 32; }
        else if (task < 3392) { t = task - 3136; src = p.w_att_o; dst = p.WattT; K = 1024; N = 1024; ntk = 16; }
        else if (task < 3648) { t = task - 3392; src = p.w_out; dst = p.WoutT; K = 1024; N = 1024; ntk = 16; }
        else if (task < 4160) { t = task - 3648; src = p.peer_wq; dst = p.WqgT; K = 1024; N = 2048; ntk = 16; }
        else if (task < 4416) { t = task - 4160; src = p.w_ple_gate; dst = p.WqgT + (size_t)2048 * 1024; K = 1024; N = 1024; ntk = 16; }
        else { t = task - 4416; src = p.w_ple; dst = p.WpleT; K = 256; N = 1024; ntk = 4; }
        const int j0 = (t / ntk) * 64, k0 = (t % ntk) * 64;
        {
            const int jj = tid & 63, kk0 = tid >> 6;
            const int oc = mapped ? win_orig(j0 + jj) : (j0 + jj);
#pragma unroll
            for (int i = 0; i < 8; ++i) {
                const int kk = kk0 + 8 * i;
                tile[kk * 65 + jj] = (oc >= 0) ? src[(size_t)(k0 + kk) * N + oc] : 0.f;
            }
        }
        __syncthreads();
        {
            const int kk2 = (tid & 31) * 2, jj2 = tid >> 5;
#pragma unroll
            for (int i = 0; i < 4; ++i) {
                const int jj = jj2 + 16 * i;
                *(unsigned*)(dst + (size_t)(j0 + jj) * K + k0 + kk2) = pack_bf2(tile[kk2 * 65 + jj], tile[(kk2 + 1) * 65 + jj]);
            }
        }
        __syncthreads();
    }
}

typedef short s16x4 __attribute__((ext_vector_type(4)));
typedef short bf16x8 __attribute__((ext_vector_type(8)));
typedef float f32x16 __attribute__((ext_vector_type(16)));
typedef float f32x2v __attribute__((ext_vector_type(2)));
typedef __bf16 bf16v2 __attribute__((ext_vector_type(2)));
typedef LAS3 unsigned char* ldsp;
__device__ __forceinline__ unsigned pk2(float a, float b) { const f32x2v v = {a, b}; const bf16v2 r = __builtin_convertvector(v, bf16v2); return __builtin_bit_cast(unsigned, r); }
__device__ __forceinline__ bf16x8 ld_tr8(ldsp lo, int hi_delta) {
    const s16x4 a = __builtin_amdgcn_ds_read_tr16_b64_v4i16((LAS3 s16x4*)lo);
    const s16x4 b = __builtin_amdgcn_ds_read_tr16_b64_v4i16((LAS3 s16x4*)(lo + hi_delta));
    return __builtin_shufflevector(a, b, 0, 1, 2, 3, 4, 5, 6, 7);
}
__device__ __forceinline__ bf16x8 ld_b128(ldsp a) { return *(LAS3 bf16x8*)a; }
#define MFMA32(a, b, c) __builtin_amdgcn_mfma_f32_32x32x16_bf16((a), (b), (c), 0, 0, 0)
__device__ __forceinline__ int crow(int reg, int lh) { return (reg & 3) + 8 * (reg >> 2) + 4 * lh; }
__device__ __forceinline__ u32x4 scale8_bf16(u32x4 v, float d) {
    u32x4 o;
    o.x = pk2(__uint_as_float(v.x << 16) * d, __uint_as_float(v.x & 0xffff0000u) * d);
    o.y = pk2(__uint_as_float(v.y << 16) * d, __uint_as_float(v.y & 0xffff0000u) * d);
    o.z = pk2(__uint_as_float(v.z << 16) * d, __uint_as_float(v.z & 0xffff0000u) * d);
    o.w = pk2(__uint_as_float(v.w << 16) * d, __uint_as_float(v.w & 0xffff0000u) * d);
    return o;
}

__device__ __forceinline__ void ret_state_item(const Params& p, int item, ldsp lds) {
    const int tid = opaque((int)threadIdx.x), lane = tid & 63, w = __builtin_amdgcn_readfirstlane(tid >> 6);
    const int bh = item >> 4, dkh = (item >> 3) & 1, dvs = item & 7, b = bh >> 2, hd = bh & 3;
    const float l2g = log2f(1.0f - exp2f(-5.0f - (float)hd));
    constexpr int PK = 320, PV = 192;
    ldsp KT = lds, VS = lds + 128 * PK;
    const int r31 = lane & 31, lh = lane >> 5, q = (lane & 15) >> 2, p4 = lane & 3, blk = (lane >> 4) & 1;
    const int dkt = w >> 1, dvt = w & 1;
    const int offA = (8 * lh + q) * PK + 2 * (32 * dkt + 16 * blk + 4 * p4);
    const int offB = (8 * lh + q) * PV + 2 * (32 * dvt + 16 * blk + 4 * p4);
    f32x16 acc;
#pragma unroll
    for (int i = 0; i < 16; ++i) acc[i] = 0.f;
    const float gC = exp2f(128.0f * l2g);
    const bf16_t* kbase = p.RK + (size_t)(b * 4096) * 1024 + hd * 256 + dkh * 128;
    const bf16_t* vbase = p.RV + (size_t)(b * 4096) * 2048 + hd * 512 + dvs * 64;
    u32x4 kreg[4], vreg[2];
#pragma unroll
    for (int i = 0; i < 4; ++i) { const int id = tid + 512 * i, tok = id >> 4, pc = id & 15; kreg[i] = *(const u32x4*)(kbase + (size_t)tok * 1024 + pc * 8); }
#pragma unroll
    for (int i = 0; i < 2; ++i) { const int id = tid + 512 * i, tok = id >> 3, pc = id & 7; vreg[i] = *(const u32x4*)(vbase + (size_t)tok * 2048 + pc * 8); }
    for (int c = 0; c < 32; ++c) {
#pragma unroll
        for (int i = 0; i < 4; ++i) { const int id = tid + 512 * i, tok = id >> 4, pc = id & 15; *(LAS3 u32x4*)(KT + tok * PK + pc * 16) = kreg[i]; }
#pragma unroll
        for (int i = 0; i < 2; ++i) { const int id = tid + 512 * i, tok = id >> 3, pc = id & 7;
            *(LAS3 u32x4*)(VS + tok * PV + pc * 16) = scale8_bf16(vreg[i], exp2f((float)(127 - tok) * l2g)); }
        __syncthreads();
        if (c + 1 < 32) {
#pragma unroll
            for (int i = 0; i < 4; ++i) { const int id = tid + 512 * i, tok = id >> 4, pc = id & 15; kreg[i] = *(const u32x4*)(kbase + (size_t)((c + 1) * 128 + tok) * 1024 + pc * 8); }
#pragma unroll
            for (int i = 0; i < 2; ++i) { const int id = tid + 512 * i, tok = id >> 3, pc = id & 7; vreg[i] = *(const u32x4*)(vbase + (size_t)((c + 1) * 128 + tok) * 2048 + pc * 8); }
        }
        bf16_t* sc = p.SC + ((size_t)(bh * 32 + c) * 256 + dkh * 128 + dkt * 32) * 512 + dvs * 64 + dvt * 32 + r31;
#pragma unroll
        for (int reg = 0; reg < 16; ++reg) sc[(size_t)crow(reg, lh) * 512] = (bf16_t)(pk2(acc[reg], 0.f) & 0xffffu);
        acc = acc * gC;
#pragma unroll
        for (int s = 0; s < 8; ++s) {
            const bf16x8 A = ld_tr8(KT + offA + 16 * s * PK, 4 * PK);
            const bf16x8 B = ld_tr8(VS + offB + 16 * s * PV, 4 * PV);
            acc = MFMA32(A, B, acc);
        }
        __syncthreads();
    }
    float* so = p.ret_prompt + ((size_t)bh * 256 + dkh * 128 + dkt * 32) * 512 + dvs * 64 + dvt * 32 + r31;
#pragma unroll
    for (int reg = 0; reg < 16; ++reg) so[(size_t)crow(reg, lh) * 512] = acc[reg];
}

__device__ __forceinline__ void ret_out_item(const Params& p, int item, ldsp lds) {
    const int tid = opaque((int)threadIdx.x), lane = tid & 63, w = __builtin_amdgcn_readfirstlane(tid >> 6);
    const int bh = item >> 5, c = item & 31, b = bh >> 2, hd = bh & 3;
    const float l2g = log2f(1.0f - exp2f(-5.0f - (float)hd));
    constexpr int PQ = 528, PS = 1088, SLB = 32 * PS;
    ldsp QI = lds, KI = lds + 128 * PQ, RED = KI + 2 * SLB;
    const int r31 = lane & 31, lh = lane >> 5;
    const int it = w & 3, dvh = w >> 2;
    const unsigned row0 = (unsigned)(b * 4096 + c * 128);
    const char* qg = (const char*)(p.RQ + (size_t)row0 * 1024 + hd * 256);
    const char* kg = (const char*)(p.RK + (size_t)row0 * 1024 + hd * 256);
    const char* sg_ = (const char*)(p.SC + (size_t)(bh * 32 + c) * 256 * 512);
    const char* vg = (const char*)(p.RV + (size_t)row0 * 2048 + hd * 512);
#pragma unroll
    for (int i = 0; i < 8; ++i) {
        const int id = tid + 512 * i, tok = id >> 5, pc = id & 31;
        const unsigned go = (unsigned)(tok * 2048 + pc * 16);
        *(LAS3 u32x4*)(QI + tok * PQ + pc * 16) = *(const u32x4*)(qg + go);
        *(LAS3 u32x4*)(KI + tok * PQ + pc * 16) = *(const u32x4*)(kg + go);
    }
    u32x4 sreg[4];
    {
        const int tt = opaque(tid);
#pragma unroll
        for (int i = 0; i < 4; ++i) { const int id = tt + 512 * i, rr = id >> 6, pc = id & 63; sreg[i] = *(const u32x4*)(sg_ + (unsigned)(rr * 1024 + pc * 16)); }
    }
    __syncthreads();
    bf16x8 pf[4][2];
    const int ig = 32 * it + r31;
#pragma unroll
    for (int jt = 0; jt < 4; ++jt) {
        if (jt <= it) {
            f32x16 a;
#pragma unroll
            for (int i = 0; i < 16; ++i) a[i] = 0.f;
            ldsp ka = KI + (32 * jt + r31) * PQ + 16 * lh, qa = QI + (32 * it + r31) * PQ + 16 * lh;
#pragma unroll 4
            for (int s = 0; s < 16; ++s) a = MFMA32(ld_b128(ka + 32 * s), ld_b128(qa + 32 * s), a);
#pragma unroll
            for (int reg = 0; reg < 16; ++reg) {
                const int j = 32 * jt + crow(reg, lh);
                a[reg] = (ig >= j) ? a[reg] * exp2f((float)(ig - j) * l2g) : 0.f;
            }
#pragma unroll
            for (int s2 = 0; s2 < 2; ++s2) {
                u32x4 pkd;
                pkd.x = pk2(a[8 * s2 + 0], a[8 * s2 + 1]); pkd.y = pk2(a[8 * s2 + 2], a[8 * s2 + 3]);
                pkd.z = pk2(a[8 * s2 + 4], a[8 * s2 + 5]); pkd.w = pk2(a[8 * s2 + 6], a[8 * s2 + 7]);
                pf[jt][s2] = __builtin_bit_cast(bf16x8, pkd);
            }
        } else {
            const u32x4 z = {0u, 0u, 0u, 0u};
            pf[jt][0] = __builtin_bit_cast(bf16x8, z); pf[jt][1] = __builtin_bit_cast(bf16x8, z);
        }
    }
    __syncthreads();
    f32x16 acc[8];
#pragma unroll
    for (int t = 0; t < 8; ++t)
#pragma unroll
        for (int i = 0; i < 16; ++i) acc[t][i] = 0.f;
    for (int d = 0; d < 8; ++d) {
        ldsp buf = KI + (d & 1) * SLB;
        const int tt = opaque(tid);
#pragma unroll
        for (int i = 0; i < 4; ++i) { const int id = tt + 512 * i, rr = id >> 6, pc = id & 63; *(LAS3 u32x4*)(buf + rr * PS + pc * 16) = sreg[i]; }
        __syncthreads();
        {
            const char* src = (d + 1 < 8) ? (sg_ + (size_t)(32 * (d + 1)) * 1024) : vg;
            const int pitch = (d + 1 < 8) ? 1024 : 4096;
#pragma unroll
            for (int i = 0; i < 4; ++i) { const int id = tt + 512 * i, rr = id >> 6, pc = id & 63; sreg[i] = *(const u32x4*)(src + (unsigned)(rr * pitch + pc * 16)); }
        }
        const int ln = opaque(lane);
        ldsp qa = QI + (32 * it + (ln & 31)) * PQ + 64 * d + 16 * (ln >> 5);
        ldsp sa = buf + (8 * (ln >> 5) + ((ln & 15) >> 2)) * PS + 2 * (256 * dvh + 16 * ((ln >> 4) & 1) + 4 * (ln & 3));
#pragma unroll
        for (int s = 0; s < 2; ++s) {
            const bf16x8 B = ld_b128(qa + 32 * s);
#pragma unroll
            for (int t = 0; t < 8; ++t) acc[t] = MFMA32(ld_tr8(sa + 16 * s * PS + 64 * t, 4 * PS), B, acc[t]);
        }
    }
    {
        const float rowdec = exp2f((float)(ig + 1) * l2g);
#pragma unroll
        for (int t = 0; t < 8; ++t) acc[t] = acc[t] * rowdec;
    }
#pragma unroll
    for (int u = 0; u < 4; ++u) {
        ldsp buf = KI + (u & 1) * SLB;
        const int tt = opaque(tid);
#pragma unroll
        for (int i = 0; i < 4; ++i) { const int id = tt + 512 * i, rr = id >> 6, pc = id & 63; *(LAS3 u32x4*)(buf + rr * PS + pc * 16) = sreg[i]; }
        __syncthreads();
        if (u + 1 < 4) {
#pragma unroll
            for (int i = 0; i < 4; ++i) { const int id = tt + 512 * i, rr = id >> 6, pc = id & 63; sreg[i] = *(const u32x4*)(vg + (unsigned)((32 * (u + 1) + rr) * 4096 + pc * 16)); }
        }
        if (u <= it) {
            const int ln = opaque(lane);
            ldsp sa = buf + (4 * (ln >> 5) + ((ln & 15) >> 2)) * PS + 2 * (256 * dvh + 16 * ((ln >> 4) & 1) + 4 * (ln & 3));
#pragma unroll
            for (int s2 = 0; s2 < 2; ++s2)
#pragma unroll
                for (int t = 0; t < 8; ++t) acc[t] = MFMA32(ld_tr8(sa + 16 * s2 * PS + 64 * t, 8 * PS), pf[u][s2], acc[t]);
        }
    }
    float sm = 0.f, sq = 0.f;
#pragma unroll
    for (int t = 0; t < 8; ++t)
#pragma unroll
        for (int i = 0; i < 16; ++i) { sm += acc[t][i]; sq += acc[t][i] * acc[t][i]; }
    sm += __shfl_xor(sm, 32); sq += __shfl_xor(sq, 32);
    LAS3 float* red = (LAS3 float*)RED;
    if (lh == 0) { red[(w * 32 + r31) * 2] = sm; red[(w * 32 + r31) * 2 + 1] = sq; }
    __syncthreads();
    {
        const int ln = opaque(lane), r31b = ln & 31, lhb = ln >> 5;
        const float osm = red[((w ^ 4) * 32 + r31b) * 2], osq = red[((w ^ 4) * 32 + r31b) * 2 + 1];
        const float mean = (sm + osm) * (1.0f / 512.0f);
        const float var = (sq + osq) * (1.0f / 512.0f) - mean * mean;
        const float rstd = rsqrtf(fmaxf(var, 0.f) + LN_EPS);
        ldsp ot = lds + (32 * it + r31b) * 1040 + 2 * (256 * dvh + 4 * lhb);
#pragma unroll
        for (int t = 0; t < 8; ++t)
#pragma unroll
            for (int g = 0; g < 4; ++g) {
                u32x2 o; o.x = pk2((acc[t][4 * g] - mean) * rstd, (acc[t][4 * g + 1] - mean) * rstd); o.y = pk2((acc[t][4 * g + 2] - mean) * rstd, (acc[t][4 * g + 3] - mean) * rstd);
                *(LAS3 u32x2*)(ot + 2 * (32 * t + 8 * g)) = o;
            }
    }
    __syncthreads();
    {
        const int tt = opaque(tid);
        const bf16_t* sgp = p.SG + (size_t)row0 * 2048 + hd * 512;
        bf16_t* outp = p.RETO + (size_t)row0 * 2048 + hd * 512;
#pragma unroll 4
        for (int i = 0; i < 16; ++i) {
            const int id = tt + 512 * i, rr = id >> 6, pc = id & 63;
            const u32x4 xn = *(LAS3 u32x4*)(lds + rr * 1040 + pc * 16);
            const u32x4 sg = *(const u32x4*)(sgp + (size_t)rr * 2048 + pc * 8);
            const f32x4 g0 = *(const f32x4*)(p.gn_g + hd * 512 + pc * 8), g1 = *(const f32x4*)(p.gn_g + hd * 512 + pc * 8 + 4);
            const f32x4 b0 = *(const f32x4*)(p.gn_b + hd * 512 + pc * 8), b1 = *(const f32x4*)(p.gn_b + hd * 512 + pc * 8 + 4);
            u32x4 o;
            o.x = pk2((__uint_as_float(xn.x << 16) * g0[0] + b0[0]) * __uint_as_float(sg.x << 16), (__uint_as_float(xn.x & 0xffff0000u) * g0[1] + b0[1]) * __uint_as_float(sg.x & 0xffff0000u));
            o.y = pk2((__uint_as_float(xn.y << 16) * g0[2] + b0[2]) * __uint_as_float(sg.y << 16), (__uint_as_float(xn.y & 0xffff0000u) * g0[3] + b0[3]) * __uint_as_float(sg.y & 0xffff0000u));
            o.z = pk2((__uint_as_float(xn.z << 16) * g1[0] + b1[0]) * __uint_as_float(sg.z << 16), (__uint_as_float(xn.z & 0xffff0000u) * g1[1] + b1[1]) * __uint_as_float(sg.z & 0xffff0000u));
            o.w = pk2((__uint_as_float(xn.w << 16) * g1[2] + b1[2]) * __uint_as_float(sg.w << 16), (__uint_as_float(xn.w & 0xffff0000u) * g1[3] + b1[3]) * __uint_as_float(sg.w & 0xffff0000u));
            *(u32x4*)(outp + (size_t)rr * 2048 + pc * 8) = o;
        }
    }
    __syncthreads();
}

__device__ __forceinline__ void ret_scan_load(const Params& p, int item, int row0, const float* state_in, float (&S)[32], float (&qk)[4], float (&vt)[4]) {
    const int tid = opaque((int)threadIdx.x), col = tid & 63, dkq = tid >> 6;
    const int bh = item >> 3, vg = item & 7, b = bh >> 2, h = bh & 3;
    const size_t sbase = (size_t)bh * 256 * 512 + (size_t)(dkq * 32) * 512 + vg * 64 + col;
#pragma unroll
    for (int i = 0; i < 32; ++i) S[i] = state_in ? state_in[sbase + (size_t)i * 512] : 0.f;
#pragma unroll
    for (int t = 0; t < 4; ++t) {
        const size_t r = (size_t)(row0 + b * 4 + t);
        qk[t] = (tid < 256) ? bf2f(p.RQ[r * 1024 + h * 256 + tid]) : bf2f(p.RK[r * 1024 + h * 256 + (tid - 256)]);
        vt[t] = bf2f(p.RV[r * 2048 + h * 512 + vg * 64 + col]);
    }
}
__device__ __forceinline__ void ret_scan_item(const Params& p, int item, int next_item, int row0, const float* state_in, float* state_out, float* qs, float* ks,
                                              float (&S)[32], float (&qk)[4], float (&vt)[4]) {
    const int tid = opaque((int)threadIdx.x), col = tid & 63, dkq = tid >> 6;
    float* redp = ks + 1024;
    const int bh = item >> 3, vg = item & 7, b = bh >> 2, h = bh & 3;
    const float gamma = 1.0f - exp2f(-5.0f - (float)h);
    const size_t sbase = (size_t)bh * 256 * 512 + (size_t)(dkq * 32) * 512 + vg * 64 + col;
    float vtok[4];
#pragma unroll
    for (int t = 0; t < 4; ++t) {
        if (tid < 256) qs[t * 256 + tid] = qk[t]; else ks[t * 256 + tid - 256] = qk[t];
        vtok[t] = vt[t];
    }
    __syncthreads();
    float Sn[32], qkn[4], vtn[4];
    if (next_item >= 0) ret_scan_load(p, next_item, row0, state_in, Sn, qkn, vtn);
#pragma unroll
    for (int t = 0; t < 4; ++t) {
        const size_t r = (size_t)(row0 + b * 4 + t);
        float part = 0.f;
#pragma unroll
        for (int i = 0; i < 32; ++i) {
            S[i] = gamma * S[i] + ks[t * 256 + dkq * 32 + i] * vtok[t];
            part += qs[t * 256 + dkq * 32 + i] * S[i];
        }
        redp[dkq * 64 + col] = part;
        __syncthreads();
        if (tid < 64) {
            float tot = 0.f;
#pragma unroll
            for (int w = 0; w < 8; ++w) tot += redp[w * 64 + tid];
            p.RO[r * 2048 + h * 512 + vg * 64 + tid] = tot;
        }
        __syncthreads();
    }
#pragma unroll
    for (int i = 0; i < 32; ++i) state_out[sbase + (size_t)i * 512] = S[i];
    if (next_item >= 0) {
#pragma unroll
        for (int i = 0; i < 32; ++i) S[i] = Sn[i];
#pragma unroll
        for (int t = 0; t < 4; ++t) { qk[t] = qkn[t]; vt[t] = vtn[t]; }
    }
    __syncthreads();
}
__device__ __forceinline__ void phase_ret_scan(const Params& p, unsigned char* smem) {
    for (int it = blockIdx.x; it < 256; it += gridDim.x) ret_state_item(p, it, (ldsp)smem);
    float* qs = (float*)smem; float* ks = qs + 1024;
    {
        float S[32], qk[4], vt[4];
        int it = blockIdx.x;
        if (it < 1024) ret_scan_load(p, it, TP, p.state_ret, S, qk, vt);
        for (; it < 1024; it += gridDim.x) { const int nx = it + (int)gridDim.x; ret_scan_item(p, it, nx < 1024 ? nx : -1, TP, p.state_ret, p.ret_sample, qs, ks, S, qk, vt); }
    }
}
__device__ __forceinline__ void phase_ret_out(const Params& p, unsigned char* smem) {
    for (int it = blockIdx.x; it < 512; it += gridDim.x) ret_out_item(p, it, (ldsp)smem);
}
__device__ __forceinline__ void phase_ret_gn(const Params& p) {
    const int tid_ = opaque((int)threadIdx.x), wid = tid_ >> 6, lane = tid_ & 63;
    for (int item = TP * 4 + blockIdx.x * 8 + wid; item < T * 4; item += gridDim.x * 8) {
        const int r = item >> 2, h = item & 3;
        const float* o = p.RO + (size_t)r * 2048 + h * 512;
        float v[8]; float s = 0.f;
#pragma unroll
        for (int i = 0; i < 8; ++i) { v[i] = o[lane + 64 * i]; s += v[i]; }
        const float mean = wave_sum(s) * (1.0f / 512.0f);
        float q = 0.f;
#pragma unroll
        for (int i = 0; i < 8; ++i) { const float d = v[i] - mean; q += d * d; }
        const float rstd = rsqrtf(wave_sum(q) * (1.0f / 512.0f) + LN_EPS);
#pragma unroll
        for (int i = 0; i < 8; ++i) {
            const int c = h * 512 + lane + 64 * i;
            const float on = (v[i] - mean) * rstd * p.gn_g[c] + p.gn_b[c];
            p.RETO[(size_t)r * 2048 + c] = f2bf(bf2f(p.SG[(size_t)r * 2048 + c]) * on);
        }
    }
}


__device__ __forceinline__ unsigned fkey(float f) { const unsigned u = __float_as_uint(f); return (u & 0x80000000u) ? ~u : (u | 0x80000000u); }

__device__ __forceinline__ float block_sum512(float v, float* red) {
    v = wave_sum(v);
    __syncthreads();
    if ((threadIdx.x & 63) == 0) red[threadIdx.x >> 6] = v;
    __syncthreads();
    float t = 0.f;
#pragma unroll
    for (int w = 0; w < 8; ++w) t += red[w];
    return t;
}
__device__ __forceinline__ void phase_ln1(const Params& p) {
    const int tid_ = opaque((int)threadIdx.x), wid = tid_ >> 6, lane = tid_ & 63;
    const int stride = gridDim.x * 8;
    int r = blockIdx.x * 8 + wid;
    u32x4 v8[2], n8[2];
    if (r < T) {
#pragma unroll
        for (int i = 0; i < 2; ++i) v8[i] = *(const u32x4*)(p.VPRE + (size_t)r * 1024 + lane * 8 + 512 * i);
    }
    for (; r < T; r += stride) {
        const int rn = r + stride;
        if (rn < T) {
#pragma unroll
            for (int i = 0; i < 2; ++i) n8[i] = *(const u32x4*)(p.VPRE + (size_t)rn * 1024 + lane * 8 + 512 * i);
        }
        float v[16];
#pragma unroll
        for (int i = 0; i < 2; ++i)
#pragma unroll
            for (int e = 0; e < 4; ++e) { v[8 * i + 2 * e] = __uint_as_float(v8[i][e] << 16); v[8 * i + 2 * e + 1] = __uint_as_float(v8[i][e] & 0xffff0000u); }
        float s = 0.f;
#pragma unroll
        for (int i = 0; i < 16; ++i) s += v[i];
        const float mean = wave_sum(s) * (1.0f / 1024.0f);
        float q = 0.f;
#pragma unroll
        for (int i = 0; i < 16; ++i) { const float d = v[i] - mean; q += d * d; }
        const float rstd = rsqrtf(wave_sum(q) * (1.0f / 1024.0f) + LN_EPS);
#pragma unroll
        for (int i = 0; i < 2; ++i) {
            const int c = lane * 8 + 512 * i;
            const float4 g0 = *(const float4*)(p.ln1_g + c), g1 = *(const float4*)(p.ln1_g + c + 4), b0 = *(const float4*)(p.ln1_b + c), b1 = *(const float4*)(p.ln1_b + c + 4);
            uint4 ob;
            ob.x = pack_bf2((v[8 * i] - mean) * rstd * g0.x + b0.x, (v[8 * i + 1] - mean) * rstd * g0.y + b0.y);
            ob.y = pack_bf2((v[8 * i + 2] - mean) * rstd * g0.z + b0.z, (v[8 * i + 3] - mean) * rstd * g0.w + b0.w);
            ob.z = pack_bf2((v[8 * i + 4] - mean) * rstd * g1.x + b1.x, (v[8 * i + 5] - mean) * rstd * g1.y + b1.y);
            ob.w = pack_bf2((v[8 * i + 6] - mean) * rstd * g1.z + b1.z, (v[8 * i + 7] - mean) * rstd * g1.w + b1.w);
            *(uint4*)(p.X1B + (size_t)r * 1024 + c) = ob;
        }
#pragma unroll
        for (int i = 0; i < 2; ++i) v8[i] = n8[i];
    }
}

__device__ __forceinline__ void wave_argmax(float& v, int& i) {
#pragma unroll
    for (int o = 32; o >= 1; o >>= 1) {
        const float ov = __shfl_xor(v, o);
        const int oi = __shfl_xor(i, o);
        if (ov > v || (ov == v && oi < i)) { v = ov; i = oi; }
    }
}
__device__ __forceinline__ void peer_item(const Params& p, int r, unsigned char* smem) {
    float* xs = (float*)smem;
    float* qs = xs + 1024;
    float* sc = qs + 2048;
    float* topv = sc + 2048;
    int* topi = (int*)(topv + 256);
    float* gw = (float*)(topi + 256);
    int* eid = (int*)(gw + 128);
    float* red = (float*)(eid + 128);
    const int tid = opaque((int)threadIdx.x), wid = tid >> 6, lane = tid & 63;
    xs[tid] = p.X1[(size_t)r * 1024 + tid]; xs[tid + 512] = p.X1[(size_t)r * 1024 + 512 + tid];
#pragma unroll
    for (int i = 0; i < 4; ++i) qs[tid + 512 * i] = bf2f(p.QP[(size_t)r * 2048 + tid + 512 * i]);
    __syncthreads();
    for (int it = 0; it < 4; ++it) {
        const int id = tid + NT * it, list = id >> 7, n = id & 127;
        const float* sk = p.peer_subkeys + ((size_t)list * 128 + n) * 128;
        const float* qq = qs + list * 128;
        float d = 0.f;
#pragma unroll 8
        for (int e = 0; e < 128; ++e) d += qq[e] * sk[e];
        sc[list * 128 + n] = d;
    }
    __syncthreads();
    for (int li = 0; li < 2; ++li) {
        const int list = wid * 2 + li;
        float v0 = sc[list * 128 + lane], v1 = sc[list * 128 + lane + 64];
        for (int k = 0; k < 16; ++k) {
            float bv; int bi;
            if (v1 > v0) { bv = v1; bi = lane + 64; } else { bv = v0; bi = lane; }
            wave_argmax(bv, bi);
            if (lane == 0) { topv[list * 16 + k] = bv; topi[list * 16 + k] = bi; }
            if (bi == lane) v0 = -3.0e38f;
            if (bi == lane + 64) v1 = -3.0e38f;
        }
    }
    __syncthreads();
    {
        const int h = wid;
        float cv[4];
#pragma unroll
        for (int i = 0; i < 4; ++i) { const int c = lane + 64 * i; cv[i] = topv[(2 * h) * 16 + (c >> 4)] + topv[(2 * h + 1) * 16 + (c & 15)]; }
        float myv = 0.f; int myc = 0;
        for (int k = 0; k < 16; ++k) {
            float bv = cv[0]; int bi = lane;
#pragma unroll
            for (int i = 1; i < 4; ++i) if (cv[i] > bv) { bv = cv[i]; bi = lane + 64 * i; }
            wave_argmax(bv, bi);
            if (lane == k) { myv = bv; myc = bi; }
#pragma unroll
            for (int i = 0; i < 4; ++i) if (bi == lane + 64 * i) cv[i] = -3.0e38f;
        }
        float m = (lane < 16) ? myv : -3.0e38f;
        m = wave_max(m);
        const float e = (lane < 16) ? __expf(myv - m) : 0.f;
        const float ssum = wave_sum(e);
        if (lane < 16) {
            gw[h * 16 + lane] = e / ssum;
            eid[h * 16 + lane] = topi[(2 * h) * 16 + (myc >> 4)] * 128 + topi[(2 * h + 1) * 16 + (myc & 15)];
        }
    }
    __syncthreads();
    for (int pi = 0; pi < 16; ++pi) {
        const int pr = wid * 16 + pi;
        const float* uu = p.peer_u + (size_t)eid[pr] * 1024;
        float d = 0.f;
#pragma unroll
        for (int i = 0; i < 4; ++i) {
            const float4 uv = *(const float4*)(uu + lane * 4 + 256 * i);
            const float* xx = xs + lane * 4 + 256 * i;
            d += xx[0] * uv.x + xx[1] * uv.y + xx[2] * uv.z + xx[3] * uv.w;
        }
        d = wave_sum(d);
        if (lane == 0) gw[pr] = gw[pr] * 0.5f * d * (1.0f + erff(d * 0.7071067811865476f));
    }
    __syncthreads();
    float o0 = 0.f, o1 = 0.f;
#pragma unroll 4
    for (int pr = 0; pr < 128; ++pr) {
        const float2 vv = *(const float2*)(p.peer_v + (size_t)eid[pr] * 1024 + tid * 2);
        const float w = gw[pr];
        o0 += w * vv.x; o1 += w * vv.y;
    }
    float2 ple; ple.x = bf2f(p.PLE[(size_t)r * 1024 + tid * 2]); ple.y = bf2f(p.PLE[(size_t)r * 1024 + tid * 2 + 1]);
    const float v0 = ALPHA * xs[tid * 2] + o0 + ple.x, v1 = ALPHA * xs[tid * 2 + 1] + o1 + ple.y;
    const float mean = block_sum512(v0 + v1, red) * (1.0f / 1024.0f);
    const float d0 = v0 - mean, d1 = v1 - mean;
    const float rstd = rsqrtf(block_sum512(d0 * d0 + d1 * d1, red) * (1.0f / 1024.0f) + LN_EPS);
    float* y = (r < TP) ? (p.y_prompt + (size_t)r * 1024) : (p.y_sample + (size_t)(r - TP) * 1024);
    float2 o; o.x = d0 * rstd * p.ln2_g[tid * 2] + p.ln2_b[tid * 2]; o.y = d1 * rstd * p.ln2_g[tid * 2 + 1] + p.ln2_b[tid * 2 + 1];
    *(float2*)(y + tid * 2) = o;
    __syncthreads();
}
__device__ __forceinline__ void phase_peer(const Params& p, unsigned char* smem) {
    for (int r = blockIdx.x; r < T; r += gridDim.x) peer_item(p, r, smem);
}


typedef _Float16 f16x8 __attribute__((ext_vector_type(8)));
#define MFMA32H(a, b, c) __builtin_amdgcn_mfma_f32_32x32x16_f16((a), (b), (c), 0, 0, 0)
struct IdxChunk { int b, nt, m0, m1; };
__device__ __forceinline__ IdxChunk idx_chunk_decode(int chunk) {
    IdxChunk c; c.b = chunk / 187; int idx = chunk - c.b * 187;
    int nt = 0;
    for (;;) { const int nc = (nt + 3) / 3; if (idx < nc) break; idx -= nc; ++nt; }
    c.nt = nt; c.m0 = 3 * idx; c.m1 = (c.m0 + 2 < nt) ? (c.m0 + 2) : nt;
    return c;
}
__device__ __forceinline__ void idx_chunk_load_q(const Params& p, const IdxChunk& c, u32x4 (&qpre)[16], float2& wv) {
    const int tid = opaque((int)threadIdx.x);
    const char* qg = (const char*)(p.IQ + (size_t)(c.b * 4096 + 128 * c.nt) * 512);
#pragma unroll
    for (int i = 0; i < 16; ++i) { const int id = tid + 512 * i, row = id >> 6, pc = id & 63; qpre[i] = *(const u32x4*)(qg + (size_t)row * 1024 + pc * 16); }
    const int q = tid >> 2, h2 = (tid & 3) * 2;
    wv = *(const float2*)(p.IW + (size_t)(c.b * 4096 + 128 * c.nt + q) * 8 + h2);
}
__device__ __forceinline__ void idx_chunk_load_k(const Params& p, int b, int mt, f16x8 (&kf)[2][4]) {
    const int tid = opaque((int)threadIdx.x), lane = tid & 63, w = __builtin_amdgcn_readfirstlane(tid >> 6);
    const int r31 = lane & 31, lh = lane >> 5, kmp = w >> 2;
#pragma unroll
    for (int kk = 0; kk < 2; ++kk) {
        const int krow = b * 4096 + 128 * mt + 32 * (2 * kmp + kk) + r31;
#pragma unroll
        for (int s = 0; s < 4; ++s) kf[kk][s] = *(const f16x8*)(p.IK + (size_t)krow * 64 + 16 * s + 8 * lh);
    }
}
__device__ __forceinline__ void idx_score_chunk(const Params& p, const IdxChunk& ck, const bool has_next, const IdxChunk& cn, u32x4 (&qpre)[16], float2& wvp, f16x8 (&kf)[2][4], ldsp lds) {
    const int tid = opaque((int)threadIdx.x), lane = tid & 63, w = __builtin_amdgcn_readfirstlane(tid >> 6);
    const int b = ck.b, nt = ck.nt, m0 = ck.m0, m1 = ck.m1;
    const int r31 = lane & 31, lh = lane >> 5, qn = w & 3, kmp = w >> 2;
    constexpr int PQI = 1040;
    LAS3 float* wT = (LAS3 float*)(lds + 128 * PQI);
    {
#pragma unroll
        for (int i = 0; i < 16; ++i) { const int id = tid + 512 * i, row = id >> 6, pc = id & 63; *(LAS3 u32x4*)(lds + row * PQI + pc * 16) = qpre[i]; }
        const int q = tid >> 2, h2 = (tid & 3) * 2;
        wT[h2 * 128 + q] = wvp.x; wT[(h2 + 1) * 128 + q] = wvp.y;
    }
    __syncthreads();
    ldsp qa = lds + (32 * qn + r31) * PQI + 16 * lh;
#pragma unroll 1
    for (int mt = m0; mt <= m1; ++mt) {
        f16x8 nk[2][4];
        const bool more = mt < m1;
        if (more) idx_chunk_load_k(p, b, mt + 1, nk);
        else if (has_next) idx_chunk_load_q(p, cn, qpre, wvp);
#pragma unroll
        for (int kk = 0; kk < 2; ++kk) {
            f32x16 score;
#pragma unroll
            for (int i = 0; i < 16; ++i) score[i] = 0.f;
#pragma unroll 2
            for (int h = 0; h < 8; ++h) {
                f32x16 acc;
#pragma unroll
                for (int i = 0; i < 16; ++i) acc[i] = 0.f;
#pragma unroll
                for (int s = 0; s < 4; ++s) acc = MFMA32H(*(LAS3 f16x8*)(qa + 2 * (h * 64 + 16 * s)), kf[kk][s], acc);
#pragma unroll
                for (int g = 0; g < 4; ++g) {
                    const f32x4 wv = *(LAS3 f32x4*)(wT + h * 128 + 32 * qn + 8 * g + 4 * lh);
#pragma unroll
                    for (int e = 0; e < 4; ++e) score[4 * g + e] += wv[e] * fmaxf(acc[4 * g + e], 0.f);
                }
            }
            float* so = p.SCO + (size_t)(b * 4096 + 128 * nt + 32 * qn) * 4096 + 128 * mt + 32 * (2 * kmp + kk) + r31;
#pragma unroll
            for (int reg = 0; reg < 16; ++reg) __builtin_nontemporal_store(score[reg], so + (size_t)crow(reg, lh) * 4096);
        }
        if (more) {
#pragma unroll
            for (int kk = 0; kk < 2; ++kk)
#pragma unroll
                for (int s = 0; s < 4; ++s) kf[kk][s] = nk[kk][s];
        }
    }
    if (has_next) idx_chunk_load_k(p, cn.b, cn.m0, kf);
    __syncthreads();
}
__device__ __forceinline__ void idx_score_sample_item(const Params& p, int item) {
    const int tid = opaque((int)threadIdx.x), lane = tid & 63, w = __builtin_amdgcn_readfirstlane(tid >> 6);
    const int bd = item >> 3, kb = item & 7;
    const int r31 = lane & 31, lh = lane >> 5, tq = r31 >> 3, hq = r31 & 7;
    const size_t qrow = (size_t)(TP + bd * 4 + tq);
    f16x8 bq[4];
#pragma unroll
    for (int s = 0; s < 4; ++s) bq[s] = *(const f16x8*)(p.IQ + qrow * 512 + hq * 64 + 16 * s + 8 * lh);
    const float wv = p.IW[qrow * 8 + hq];
    const int ntile = (kb == 7 && w == 7) ? 9 : 8;
    const float* krp[8];
#pragma unroll
    for (int tile = 0; tile < 8; ++tile) {
        const int key = kb * 2048 + (w * 8 + tile) * 32 + r31;
        krp[tile] = p.cache_kidx + ((size_t)p.page_table[bd * 128 + (key >> 7)] * 128 + (key & 127)) * 64 + 8 * lh;
    }
    float4 cur[8], nxt[8];
#pragma unroll
    for (int s = 0; s < 4; ++s) { cur[2 * s] = *(const float4*)(krp[0] + 16 * s); cur[2 * s + 1] = *(const float4*)(krp[0] + 16 * s + 4); }
#pragma unroll
    for (int tile = 0; tile < 9; ++tile) {
        if (tile < ntile) {
            f16x8 af[4];
            int key0;
            if (tile < 8) {
                key0 = kb * 2048 + (w * 8 + tile) * 32;
                if (tile + 1 < 8) {
#pragma unroll
                    for (int s = 0; s < 4; ++s) { nxt[2 * s] = *(const float4*)(krp[(tile + 1) & 7] + 16 * s); nxt[2 * s + 1] = *(const float4*)(krp[(tile + 1) & 7] + 16 * s + 4); }
                }
#pragma unroll
                for (int s = 0; s < 4; ++s) {
                    const float4 x0 = cur[2 * s], x1 = cur[2 * s + 1];
                    f16x8 v; v[0] = (_Float16)x0.x; v[1] = (_Float16)x0.y; v[2] = (_Float16)x0.z; v[3] = (_Float16)x0.w; v[4] = (_Float16)x1.x; v[5] = (_Float16)x1.y; v[6] = (_Float16)x1.z; v[7] = (_Float16)x1.w;
                    af[s] = v;
                }
            } else {
                key0 = 16384;
                const f16_t* kr = p.IK + (size_t)(TP + bd * 4 + (r31 & 3)) * 64 + 8 * lh;
#pragma unroll
                for (int s = 0; s < 4; ++s) af[s] = *(const f16x8*)(kr + 16 * s);
            }
            f32x16 acc;
#pragma unroll
            for (int i = 0; i < 16; ++i) acc[i] = 0.f;
#pragma unroll
            for (int s = 0; s < 4; ++s) acc = MFMA32H(af[s], bq[s], acc);
            const int nkeys = (tile < 8) ? 32 : 4;
#pragma unroll
            for (int reg = 0; reg < 16; ++reg) {
                float v = wv * fmaxf(acc[reg], 0.f);
                v += __shfl_xor(v, 1); v += __shfl_xor(v, 2); v += __shfl_xor(v, 4);
                const int kin = crow(reg, lh);
                if (hq == 0 && kin < nkeys) p.SS[(size_t)(bd * 4 + tq) * 16392 + key0 + kin] = v;
            }
            if (tile + 1 < 8) {
#pragma unroll
                for (int i = 0; i < 8; ++i) cur[i] = nxt[i];
            }
        }
    }
}
__device__ __forceinline__ float dot2bf_(unsigned a, unsigned b, float c) {
    typedef __bf16 bf2 __attribute__((ext_vector_type(2)));
    return __builtin_amdgcn_fdot2_f32_bf16(__builtin_bit_cast(bf2, a), __builtin_bit_cast(bf2, b), c, false);
}

template <bool SAMPLE>
__device__ __forceinline__ const void* kv_row_ptr(const Params& p, int bidx, int row, int g, bool isv, bool& f32src) {
    f32src = SAMPLE;
    if (SAMPLE) {
        const bool past = row < 16384;
        const int prow = past ? row : 0;
        const size_t ph = (size_t)p.page_table[bidx * 128 + (prow >> 7)] * 128 + (prow & 127);
        const size_t off = past ? (ph * 2 + g) * 128 : (size_t)((bidx * 4 + (row - 16384)) * 2 + g) * 128;
        const float* cb = isv ? p.cache_v : p.cache_k; const float* nb = isv ? p.v_sample : p.k_sample;
        return (past ? cb : nb) + off;
    }
    return (isv ? p.AV : p.AK) + (size_t)(bidx * 4096 + row) * 256 + g * 128;
}
template <bool SAMPLE>
__device__ __forceinline__ u32x4 ld8_kv(const void* rowp, bool f32src, int e0) {
    if (SAMPLE) {
        const float4 a = *(const float4*)((const float*)rowp + e0), b = *(const float4*)((const float*)rowp + e0 + 4);
        u32x4 o; o.x = pk2(a.x, a.y); o.y = pk2(a.z, a.w); o.z = pk2(b.x, b.y); o.w = pk2(b.z, b.w);
        return o;
    }
    return *(const u32x4*)((const bf16_t*)rowp + e0);
}
#define MFMA16(a, b, c) __builtin_amdgcn_mfma_f32_16x16x32_bf16((a), (b), (c), 0, 0, 0)
template <bool SAMPLE>
__device__ __forceinline__ void attend_unit(const Params& p, int r, int bidx, int g, LAS3 int* list, int nsel, ldsp wp) {
    const int lane = opaque((int)threadIdx.x) & 63, n16 = lane & 15, kg = lane >> 4;
    LAS3 float* pw = (LAS3 float*)(wp + 1024);
    ldsp Pt = wp + 5120, Vs = wp + 7168;
    const u32x4 zero4 = {0u, 0u, 0u, 0u};
    bf16x8 qf[4];
    {
        const bf16_t* qp = p.AQ + (size_t)r * 1024 + (4 * g + (n16 & 3)) * 128 + 8 * kg;
#pragma unroll
        for (int s = 0; s < 4; ++s) { u32x4 t = *(const u32x4*)(qp + 32 * s); if (n16 >= 4) t = zero4; qf[s] = __builtin_bit_cast(bf16x8, t); }
    }
    asm volatile("" ::: "memory");
    {
        constexpr int KD = SAMPLE ? 1 : 3;
        u32x4 kk[KD][8];
#pragma unroll
        for (int d = 0; d < KD; ++d) {
#pragma unroll
            for (int u = 0; u < 8; ++u) { bool f32src; const void* rp = kv_row_ptr<SAMPLE>(p, bidx, list[32 * d + 4 * u + kg], g, false, f32src); kk[d][u] = ld8_kv<SAMPLE>(rp, f32src, 8 * n16); }
        }
#pragma unroll
        for (int kt = 0; kt < 8; ++kt) {
#pragma unroll
            for (int u = 0; u < 8; ++u) *(LAS3 u32x4*)(Vs + (4 * u + kg) * 320 + 16 * n16) = kk[kt % KD][u];
            asm volatile("" ::: "memory");
            if (kt + KD < 8) {
#pragma unroll
                for (int u = 0; u < 8; ++u) { bool f32src; const void* rp = kv_row_ptr<SAMPLE>(p, bidx, list[32 * (kt + KD) + 4 * u + kg], g, false, f32src); kk[kt % KD][u] = ld8_kv<SAMPLE>(rp, f32src, 8 * n16); }
            }
#pragma unroll
            for (int tl = 0; tl < 2; ++tl) {
                f32x4 acc = {0.f, 0.f, 0.f, 0.f};
#pragma unroll
                for (int s = 0; s < 4; ++s) acc = MFMA16(qf[s], ld_b128(Vs + (16 * tl + n16) * 320 + 64 * s + 16 * kg), acc);
                if (kg == 0) *(LAS3 f32x4*)(pw + (32 * kt + 16 * tl + n16) * 4) = acc;
            }
            asm volatile("" ::: "memory");
        }
    }
    asm volatile("" ::: "memory");
    const int nb = (nsel + 31) >> 5;
    constexpr int PD = SAMPLE ? 1 : 3;
    u32x4 vv[PD][8];
#pragma unroll
    for (int d = 0; d < PD; ++d) {
        if (d < nb) {
#pragma unroll
            for (int u = 0; u < 8; ++u) { bool f32src; const void* rp = kv_row_ptr<SAMPLE>(p, bidx, list[32 * d + 4 * u + kg], g, true, f32src); vv[d][u] = ld8_kv<SAMPLE>(rp, f32src, 8 * n16); }
        }
    }
#pragma unroll
    for (int hh = 0; hh < 4; ++hh) {
        float sc[4];
#pragma unroll
        for (int ks = 0; ks < 4; ++ks) sc[ks] = (64 * ks + lane < nsel) ? pw[(64 * ks + lane) * 4 + hh] : -3.0e38f;
        float m = fmaxf(fmaxf(sc[0], sc[1]), fmaxf(sc[2], sc[3]));
        m = wave_max(m);
        float e[4], sum = 0.f;
#pragma unroll
        for (int ks = 0; ks < 4; ++ks) { e[ks] = (64 * ks + lane < nsel) ? __expf(sc[ks] - m) : 0.f; sum += e[ks]; }
        sum = wave_sum(sum);
        const float inv = 1.0f / sum;
#pragma unroll
        for (int ks = 0; ks < 4; ++ks) *(LAS3 unsigned short*)(Pt + hh * 512 + 2 * (64 * ks + lane)) = (unsigned short)(pk2(e[ks] * inv, 0.f) & 0xffffu);
    }
    asm volatile("" ::: "memory");
    f32x4 o[8];
#pragma unroll
    for (int nt = 0; nt < 8; ++nt) o[nt] = (f32x4){0.f, 0.f, 0.f, 0.f};
    const int q4 = n16 >> 2, p4 = n16 & 3;
#pragma unroll
    for (int bt = 0; bt < 8; ++bt) {
        if (bt < nb) {
#pragma unroll
            for (int u = 0; u < 8; ++u) *(LAS3 u32x4*)(Vs + (4 * u + kg) * 320 + 16 * n16) = vv[bt % PD][u];
            asm volatile("" ::: "memory");
            if (bt + PD < nb) {
#pragma unroll
                for (int u = 0; u < 8; ++u) { bool f32src; const void* rp = kv_row_ptr<SAMPLE>(p, bidx, list[32 * (bt + PD) + 4 * u + kg], g, true, f32src); vv[bt % PD][u] = ld8_kv<SAMPLE>(rp, f32src, 8 * n16); }
            }
            u32x4 pa = *(LAS3 u32x4*)(Pt + (n16 & 3) * 512 + 2 * (32 * bt + 8 * kg));
            if (n16 >= 4) pa = zero4;
            const bf16x8 A = __builtin_bit_cast(bf16x8, pa);
            ldsp vb = Vs + (8 * kg + q4) * 320 + 8 * p4;
#pragma unroll
            for (int nt = 0; nt < 8; ++nt) o[nt] = MFMA16(A, ld_tr8(vb + 32 * nt, 4 * 320), o[nt]);
            asm volatile("" ::: "memory");
        }
    }
    if (kg == 0) {
#pragma unroll
        for (int nt = 0; nt < 8; ++nt)
#pragma unroll
            for (int j = 0; j < 4; ++j) p.ATTO[(size_t)r * 1024 + (4 * g + j) * 128 + 16 * nt + n16] = (bf16_t)(pk2(o[nt][j], 0.f) & 0xffffu);
    }
}
__device__ __forceinline__ int wave_sum_i(int v) {
    v += __builtin_amdgcn_update_dpp(0, v, 0xB1, 0xf, 0xf, true);
    v += __builtin_amdgcn_update_dpp(0, v, 0x4E, 0xf, 0xf, true);
    v += __builtin_amdgcn_update_dpp(0, v, 0x141, 0xf, 0xf, true);
    v += __builtin_amdgcn_update_dpp(0, v, 0x140, 0xf, 0xf, true);
    v += __builtin_amdgcn_update_dpp(0, v, 0x142, 0xa, 0xf, false);
    v += __builtin_amdgcn_update_dpp(0, v, 0x143, 0xc, 0xf, false);
    return __builtin_amdgcn_readlane(v, 63);
}
__device__ __forceinline__ void attn_query_wave(const Params& p, int b, int t, ldsp wl) {
    const int lane = opaque((int)threadIdx.x) & 63;
    LAS3 int* list = (LAS3 int*)wl;
    const int r = b * 4096 + t, nvalid = t + 1;
    int nsel;
    if (nvalid <= 256) {
#pragma unroll
        for (int i = 0; i < 4; ++i) { const int j = lane + 64 * i; list[j] = (j < nvalid) ? j : 0; }
        nsel = nvalid;
    } else {
        const int ngrp = (nvalid + 511) >> 9;
        const float* srow = p.SCO + (size_t)r * 4096;
        unsigned key[64];
#pragma unroll
        for (int gq = 0; gq < 8; ++gq) {
            if (gq < ngrp) {
#pragma unroll
                for (int s = 8 * gq; s < 8 * gq + 8; ++s) { const int j = 64 * s + lane; key[s] = (j < nvalid) ? fkey(__builtin_nontemporal_load(srow + j)) : 0u; }
            } else {
#pragma unroll
                for (int s = 8 * gq; s < 8 * gq + 8; ++s) key[s] = 0u;
            }
        }
        unsigned lo, hi; int clo = nvalid, chi = 0;
        {
            unsigned kmx = 0u, kmn = 0xffffffffu;
#pragma unroll
            for (int gq = 0; gq < 8; ++gq) {
                if (gq < ngrp) {
#pragma unroll
                    for (int s = 8 * gq; s < 8 * gq + 8; ++s) { kmx = kmx > key[s] ? kmx : key[s]; const unsigned kv = (64 * s + lane < nvalid) ? key[s] : 0xffffffffu; kmn = kmn < kv ? kmn : kv; }
                }
            }
#pragma unroll
            for (int o = 32; o >= 1; o >>= 1) { const unsigned a = (unsigned)__shfl_xor((int)kmx, o), b2 = (unsigned)__shfl_xor((int)kmn, o); kmx = kmx > a ? kmx : a; kmn = kmn < b2 ? kmn : b2; }
            lo = (unsigned)__builtin_amdgcn_readfirstlane((int)kmn); hi = (unsigned)__builtin_amdgcn_readfirstlane((int)kmx);
            if (hi != 0xffffffffu) hi += 1u; else chi = -1;
        }
        for (int it = 0; hi - lo > 1u; ++it) {
            const unsigned wdt = hi - lo;
            unsigned cand;
            if ((it & 1) || chi < 0 || wdt < 8u) cand = lo + (wdt >> 1);
            else {
                const float fr = (float)(clo - 256) / (float)(clo - chi);
                unsigned off = (unsigned)((float)wdt * fr);
                off = off < 1u ? 1u : off; off = off > wdt - 1u ? wdt - 1u : off;
                cand = lo + off;
            }
            int cl = 0;
#pragma unroll
            for (int gq = 0; gq < 8; ++gq) {
                if (gq < ngrp) {
#pragma unroll
                    for (int s = 8 * gq; s < 8 * gq + 8; ++s) cl += (key[s] >= cand) ? 1 : 0;
                }
            }
            const int c = wave_sum_i(cl);
            if (c >= 256) { lo = cand; clo = c; } else { hi = cand; chi = c; }
            if (c == 256) break;
        }
        int ngl = 0, nql = 0;
#pragma unroll
        for (int s = 0; s < 64; ++s) { ngl += (key[s] > lo) ? 1 : 0; nql += (key[s] == lo) ? 1 : 0; }
        const int need = 256 - wave_sum_i(ngl), neqt = wave_sum_i(nql);
        if (neqt == need) {
            int incl = ngl + nql;
#pragma unroll
            for (int d = 1; d < 64; d <<= 1) { const int t2 = __shfl_up(incl, d); if (lane >= d) incl += t2; }
            int pos = incl - (ngl + nql);
#pragma unroll
            for (int gq = 0; gq < 8; ++gq) {
                if (gq < ngrp) {
#pragma unroll
                    for (int s = 8 * gq; s < 8 * gq + 8; ++s) { if (key[s] >= lo) { list[pos] = 64 * s + lane; ++pos; } }
                }
            }
        } else {
            int nout = 0, neq = 0;
            const unsigned long long below = (lane == 0) ? 0ull : (~0ull >> (64 - lane));
#pragma unroll
            for (int gq = 0; gq < 8; ++gq) {
                if (gq < ngrp) {
#pragma unroll
                    for (int s = 8 * gq; s < 8 * gq + 8; ++s) {
                        const bool gt = key[s] > lo, eq = key[s] == lo;
                        const unsigned long long meq = __ballot(eq);
                        const bool take = gt || (eq && (neq + __popcll(meq & below)) < need);
                        const unsigned long long mt = __ballot(take);
                        if (take) list[nout + __popcll(mt & below)] = 64 * s + lane;
                        nout += __popcll(mt); neq += __popcll(meq);
                    }
                }
            }
        }
        nsel = 256;
    }
#pragma unroll 1
    for (int g = 0; g < 2; ++g) attend_unit<false>(p, r, b, g, list, nsel, wl);
}
__device__ __forceinline__ void attn_item(const Params& p, int qn, bool sample, unsigned char* smem) {
    unsigned* keys = (unsigned*)smem;
    int* sel = (int*)(keys + 16400);
    unsigned* red = (unsigned*)(sel + 256);
    const int tid = opaque((int)threadIdx.x), wid = tid >> 6, lane = tid & 63;
    const int b = qn >> 2, qpos = 16384 + (qn & 3), r = TP + qn;
    const int nvalid = qpos + 1;
    for (int s = tid; s < nvalid; s += NT) keys[s] = fkey(p.SS[(size_t)qn * 16392 + s]);
    __syncthreads();
    unsigned prefix = 0u;
    for (int bit = 31; bit >= 0; --bit) {
        const unsigned cand = prefix | (1u << bit);
        int c = 0;
        for (int s = tid; s < nvalid; s += NT) c += (keys[s] >= cand) ? 1 : 0;
        c = (int)wave_sum((float)c);
        if (lane == 0) red[wid] = (unsigned)c;
        __syncthreads();
        unsigned tot = 0;
#pragma unroll
        for (int w = 0; w < 8; ++w) tot += red[w];
        __syncthreads();
        if (tot >= 256u) prefix = cand;
        if (tot == 256u) break;
    }
    const unsigned thr = prefix;
    int c = 0;
    for (int s = tid; s < nvalid; s += NT) c += (keys[s] > thr) ? 1 : 0;
    c = (int)wave_sum((float)c);
    if (lane == 0) red[wid] = (unsigned)c;
    __syncthreads();
    int ngt = 0;
#pragma unroll
    for (int w = 0; w < 8; ++w) ngt += (int)red[w];
    const int need = 256 - ngt;
    if (wid == 0) {
        int nout = 0, neq = 0;
        for (int base = 0; base < nvalid; base += 64) {
            const int s = base + lane;
            const unsigned k = (s < nvalid) ? keys[s] : 0u;
            const bool gt = (s < nvalid) && (k > thr);
            const bool eq = (s < nvalid) && (k == thr);
            const unsigned long long meq = __ballot(eq);
            const unsigned long long below = (lane == 0) ? 0ull : (~0ull >> (64 - lane));
            const int eqrank = neq + __popcll(meq & below);
            const bool take = gt || (eq && eqrank < need);
            const unsigned long long mt = __ballot(take);
            if (take) sel[nout + __popcll(mt & below)] = s;
            nout += __popcll(mt);
            neq += __popcll(meq);
        }
    }
    __syncthreads();
}
__device__ __forceinline__ void attn_sample_units(const Params& p, int qn, unsigned char* smem) {
    const int tid_ = opaque((int)threadIdx.x), wid = tid_ >> 6, lane = tid_ & 63;
    ldsp priv = (ldsp)smem + wid * 17408;
    int mine[4];
    if (wid < 2) {
#pragma unroll
        for (int i = 0; i < 4; ++i) mine[i] = *(LAS3 int*)((ldsp)smem + 65600 + 4 * (lane + 64 * i));
    }
    __syncthreads();
    if (wid < 2) {
#pragma unroll
        for (int i = 0; i < 4; ++i) ((LAS3 int*)priv)[lane + 64 * i] = mine[i];
        attend_unit<true>(p, TP + qn, qn >> 2, wid, (LAS3 int*)priv, 256, priv);
    }
}
__device__ __forceinline__ void phase_attn(const Params& p, unsigned char* smem) {
    for (int it = blockIdx.x; it < TS; it += gridDim.x) { attn_item(p, it, true, smem); attn_sample_units(p, it, smem); __syncthreads(); }
}
__device__ __forceinline__ void phase_idx_scores(const Params& p, unsigned char* smem) {
    for (int it = blockIdx.x; it < 256; it += gridDim.x) idx_score_sample_item(p, it);
    {
        u32x4 qpre[16]; float2 wvp; f16x8 kf[2][4];
        int it = blockIdx.x;
        IdxChunk ck = idx_chunk_decode(it < 748 ? it : 0);
        if (it < 748) { idx_chunk_load_q(p, ck, qpre, wvp); idx_chunk_load_k(p, ck.b, ck.m0, kf); }
        for (; it < 748; it += gridDim.x) {
            const int nx = it + (int)gridDim.x; const bool has_next = nx < 748;
            const IdxChunk cn = idx_chunk_decode(has_next ? nx : 0);
            idx_score_chunk(p, ck, has_next, cn, qpre, wvp, kf, (ldsp)smem);
            ck = cn;
        }
    }
}
__device__ __forceinline__ void phase_attn_prompt(const Params& p, unsigned char* smem, bool has_sample) {
    const int tid_ = opaque((int)threadIdx.x), wl = tid_ >> 6, lane = tid_ & 63;
    if (has_sample) attn_sample_units(p, (int)blockIdx.x, smem);
    ldsp priv = (ldsp)smem + wl * 17408;
    unsigned* ctr = p.bar + 3600;
    for (;;) {
        unsigned pi = 0;
        if (lane == 0) pi = atomicAdd(ctr, 1u);
        pi = (unsigned)__builtin_amdgcn_readfirstlane((int)pi);
        if (pi >= 8192u) break;
        const int b = pi >> 11, tt = pi & 2047;
        attn_query_wave(p, b, tt, priv);
        attn_query_wave(p, b, 4095 - tt, priv);
    }
}

__device__ __forceinline__ unsigned med3u(unsigned a, unsigned b, unsigned c) { unsigned r; asm("v_med3_u32 %0, %1, %2, %3" : "=v"(r) : "v"(a), "v"(b), "v"(c)); return r; }
__device__ __forceinline__ void ins16(unsigned (&top)[16], unsigned x) {
#pragma unroll
    for (int j = 15; j >= 1; --j) top[j] = med3u(top[j - 1], top[j], x);
    top[0] = top[0] > x ? top[0] : x;
}
template <int NT0, int NT1>
__device__ __forceinline__ void peer_score_load(const Params& p, int item, u32x4 (&af)[8], u32x4 (&bf)[4][8]) {
    const int tid = opaque((int)threadIdx.x), lane = tid & 63, w = __builtin_amdgcn_readfirstlane(tid >> 6);
    const int tile = item >> 3, hd = item & 7, row0 = tile * 128;
    const int r31 = lane & 31, lh = lane >> 5, l = w >> 2, mt = w & 3;
    const char* ag = (const char*)(p.QP + (size_t)(row0 + 32 * mt + r31) * 2048 + hd * 256 + l * 128 + 8 * lh);
    if (NT0 == 0) {
#pragma unroll
        for (int s2 = 0; s2 < 8; ++s2) af[s2] = *(const u32x4*)(ag + 32 * s2);
    }
#pragma unroll
    for (int nt = NT0; nt < NT1; ++nt) {
        const char* bg = (const char*)(p.SUBK + (size_t)((hd * 2 + l) * 128 + 32 * nt + r31) * 128 + 8 * lh);
#pragma unroll
        for (int s2 = 0; s2 < 8; ++s2) bf[nt][s2] = *(const u32x4*)(bg + 32 * s2);
    }
}
__device__ __forceinline__ void peer_score_item(const Params& p, int item, int next_item, u32x4 (&af)[8], u32x4 (&bf)[4][8], ldsp lds) {
    const int tid = opaque((int)threadIdx.x), lane = tid & 63, w = __builtin_amdgcn_readfirstlane(tid >> 6);
    const int tile = item >> 3, hd = item & 7, row0 = tile * 128;
    constexpr int PT = 257;
    LAS3 float* sc = (LAS3 float*)lds;
    const int r31 = lane & 31, lh = lane >> 5;
    peer_score_load<2, 4>(p, item, af, bf);
    {
        const int l = w >> 2, mt = w & 3;
#pragma unroll
        for (int nt = 0; nt < 4; ++nt) {
            f32x16 a;
#pragma unroll
            for (int i = 0; i < 16; ++i) a[i] = 0.f;
#pragma unroll
            for (int s2 = 0; s2 < 8; ++s2) a = MFMA32(__builtin_bit_cast(bf16x8, af[s2]), __builtin_bit_cast(bf16x8, bf[nt][s2]), a);
#pragma unroll
            for (int reg = 0; reg < 16; ++reg) sc[(32 * mt + crow(reg, lh)) * PT + l * 128 + 32 * nt + r31] = a[reg];
        }
    }
    __syncthreads();
    if (next_item >= 0) peer_score_load<0, 2>(p, next_item, af, bf);
    const int part = tid & 1, tok = (tid >> 1) & 127, l = tid >> 8;
    unsigned top[16];
#pragma unroll
    for (int j = 0; j < 16; ++j) top[j] = 0u;
    {
        LAS3 float* base = sc + tok * PT + l * 128 + part;
#pragma unroll 4
        for (int e = 0; e < 64; ++e) {
            const int n = 2 * e + part;
            ins16(top, (fkey(base[2 * e]) & ~127u) | (unsigned)(127 - n));
        }
    }
    {
        unsigned oth[16];
#pragma unroll
        for (int j = 0; j < 16; ++j) oth[j] = (unsigned)__shfl_xor((int)top[j], 1);
#pragma unroll
        for (int j = 0; j < 16; ++j) ins16(top, oth[j]);
    }
    float tv[16]; int tix[16];
#pragma unroll
    for (int j = 0; j < 16; ++j) { tix[j] = 127 - (int)(top[j] & 127u); tv[j] = sc[tok * PT + l * 128 + tix[j]]; }
    __syncthreads();
    LAS3 float* TV = (LAS3 float*)lds;
    LAS3 int* TI = (LAS3 int*)(lds + 32768);
    if (part == 0) {
#pragma unroll
        for (int j = 0; j < 16; ++j) { TV[(tok * 2 + l) * 17 + j] = tv[j]; TI[(tok * 2 + l) * 17 + j] = tix[j]; }
    }
    __syncthreads();
    if (tid < 128) {
        const int tk = tid;
        float v1[16], v2[16];
#pragma unroll
        for (int j = 0; j < 16; ++j) { v1[j] = TV[(tk * 2) * 17 + j]; v2[j] = TV[(tk * 2 + 1) * 17 + j]; }
        unsigned ct[16];
#pragma unroll
        for (int j = 0; j < 16; ++j) ct[j] = 0u;
#pragma unroll
        for (int a = 0; a < 16; ++a)
#pragma unroll
            for (int b = 0; b < 16; ++b)
                if ((a + 1) * (b + 1) <= 16) ins16(ct, (fkey(v1[a] + v2[b]) & ~255u) | (unsigned)(255 - (a * 16 + b)));
        float sv[16]; int ei[16];
        float m = -3.0e38f;
#pragma unroll
        for (int j = 0; j < 16; ++j) {
            const int cidx = 255 - (int)(ct[j] & 255u), a = cidx >> 4, b = cidx & 15;
            sv[j] = TV[(tk * 2) * 17 + a] + TV[(tk * 2 + 1) * 17 + b];
            ei[j] = TI[(tk * 2) * 17 + a] * 128 + TI[(tk * 2 + 1) * 17 + b];
            m = fmaxf(m, sv[j]);
        }
        float sum = 0.f;
#pragma unroll
        for (int j = 0; j < 16; ++j) { sv[j] = __expf(sv[j] - m); sum += sv[j]; }
        const float inv = 1.0f / sum;
        int* eo = p.EIDX + (size_t)(row0 + tk) * 128 + hd * 16;
        float* go = p.GW + (size_t)(row0 + tk) * 128 + hd * 16;
#pragma unroll
        for (int j = 0; j < 16; j += 4) {
            *(int4*)(eo + j) = make_int4(ei[j], ei[j + 1], ei[j + 2], ei[j + 3]);
            *(float4*)(go + j) = make_float4(sv[j] * inv, sv[j + 1] * inv, sv[j + 2] * inv, sv[j + 3] * inv);
        }
    }
    __syncthreads();
}
__device__ __forceinline__ void phase_peer_score(const Params& p, unsigned char* smem) {
    u32x4 af[8], bf[4][8];
    int it = blockIdx.x;
    if (it < 129 * 8) peer_score_load<0, 2>(p, it, af, bf);
    for (; it < 129 * 8; it += gridDim.x) { const int nx = it + (int)gridDim.x; peer_score_item(p, it, nx < 129 * 8 ? nx : -1, af, bf, (ldsp)smem); }
}

__device__ __forceinline__ float dot2bf(unsigned a, unsigned b, float c) {
    typedef __bf16 bf2 __attribute__((ext_vector_type(2)));
    return __builtin_amdgcn_fdot2_f32_bf16(__builtin_bit_cast(bf2, a), __builtin_bit_cast(bf2, b), c, false);
}
typedef unsigned u32x3 __attribute__((ext_vector_type(3)));
typedef float f32x32 __attribute__((ext_vector_type(32)));
template <bool SPLIT>
__device__ __forceinline__ void gather_token(const Params& p, const int r, const int kb0, const int kb1, LAS3 float* xrow, const int (&pidx)[16], const int lane, const int wl) {
#pragma unroll
        for (int q = 0; q < 2; ++q) {
            const u32x4 xb = *(const u32x4*)(p.X1B + (size_t)r * 1024 + lane * 16 + 8 * q);
            *(LAS3 f32x4*)(xrow + lane * 16 + 8 * q) = (f32x4){__uint_as_float(xb[0] << 16), __uint_as_float(xb[0] & 0xffff0000u), __uint_as_float(xb[1] << 16), __uint_as_float(xb[1] & 0xffff0000u)};
            *(LAS3 f32x4*)(xrow + lane * 16 + 8 * q + 4) = (f32x4){__uint_as_float(xb[2] << 16), __uint_as_float(xb[2] & 0xffff0000u), __uint_as_float(xb[3] << 16), __uint_as_float(xb[3] & 0xffff0000u)};
        }
        asm volatile("" ::: "memory");
        float x[16];
#pragma unroll
        for (int m = 0; m < 16; ++m) x[m] = xrow[pidx[m]];
        const int e0 = p.EIDX[(size_t)r * 128 + lane], e1 = p.EIDX[(size_t)r * 128 + 64 + lane];
        const float g0 = p.GW[(size_t)r * 128 + lane], g1 = p.GW[(size_t)r * 128 + 64 + lane];
        float o[16];
#pragma unroll
        for (int i = 0; i < 16; ++i) o[i] = 0.f;
#pragma unroll 1
        for (int kb = kb0; kb < kb1; ++kb) {
            u32x3 uu[8], vv[8];
            const int esel = (kb < 8) ? e0 : e1;
#pragma unroll
            for (int j = 0; j < 8; ++j) {
                const int e = __builtin_amdgcn_readlane(esel, (kb * 8 + j) & 63);
                uu[j] = *(const u32x3*)(p.U8 + (size_t)e * 768 + lane * 12);
                vv[j] = *(const u32x3*)(p.V8 + (size_t)e * 768 + lane * 12);
            }
            float d[8];
#pragma unroll
            for (int j = 0; j < 8; j += 2) {
                const u32x6 w6 = {uu[j][0], uu[j][1], uu[j][2], uu[j + 1][0], uu[j + 1][1], uu[j + 1][2]};
                const f32x32 f = __builtin_amdgcn_cvt_scalef32_pk32_f32_fp6(w6, 1.0f);
                float t0 = 0.f, t1 = 0.f;
#pragma unroll
                for (int m = 0; m < 16; ++m) { t0 += x[m] * f[m]; t1 += x[m] * f[16 + m]; }
                d[j] = t0; d[j + 1] = t1;
            }
            float r4[4], r2[2], r1;
#pragma unroll
            for (int j = 0; j < 4; ++j) { const float keep = (lane & 1) ? d[2 * j + 1] : d[2 * j], send = (lane & 1) ? d[2 * j] : d[2 * j + 1]; r4[j] = keep + __shfl_xor(send, 1); }
#pragma unroll
            for (int j = 0; j < 2; ++j) { const float keep = (lane & 2) ? r4[2 * j + 1] : r4[2 * j], send = (lane & 2) ? r4[2 * j] : r4[2 * j + 1]; r2[j] = keep + __shfl_xor(send, 2); }
            { const float keep = (lane & 4) ? r2[1] : r2[0], send = (lane & 4) ? r2[0] : r2[1]; r1 = keep + __shfl_xor(send, 4); }
            r1 += __shfl_xor(r1, 8); r1 += __shfl_xor(r1, 16); r1 += __shfl_xor(r1, 32);
            const float gk = __shfl((kb < 8) ? g0 : g1, (kb * 8 + (lane & 7)) & 63);
            const float dt = r1 * (1.0f / 48.0f);
            const float wk = gk * 0.5f * dt * (1.0f + erff(dt * 0.7071067811865476f)) * (1.0f / 7.0f);
#pragma unroll
            for (int j = 0; j < 8; j += 2) {
                const float wa = __uint_as_float((unsigned)__builtin_amdgcn_readlane((int)__float_as_uint(wk), j));
                const float wb = __uint_as_float((unsigned)__builtin_amdgcn_readlane((int)__float_as_uint(wk), j + 1));
                const u32x6 w6 = {vv[j][0], vv[j][1], vv[j][2], vv[j + 1][0], vv[j + 1][1], vv[j + 1][2]};
                const f32x32 f = __builtin_amdgcn_cvt_scalef32_pk32_f32_fp6(w6, 1.0f);
#pragma unroll
                for (int m = 0; m < 16; ++m) o[m] += wa * f[m] + wb * f[16 + m];
            }
        }
        asm volatile("" ::: "memory");
#pragma unroll
        for (int m = 0; m < 16; ++m) xrow[pidx[m]] = o[m];
        asm volatile("" ::: "memory");
        if (SPLIT) { __syncthreads(); if (wl != 0) { __syncthreads(); return; } }
        float v[16];
        float sm = 0.f;
#pragma unroll
        for (int q = 0; q < 4; ++q) {
            f32x4 on = *(LAS3 f32x4*)(xrow + lane * 16 + 4 * q);
            if (SPLIT) {
#pragma unroll
                for (int w8 = 1; w8 < 8; ++w8) on += *(LAS3 f32x4*)(xrow + w8 * 2048 + lane * 16 + 4 * q);
            }
            const u32x2 pw_ = *(const u32x2*)(p.PLE + (size_t)r * 1024 + lane * 16 + 4 * q);
            float4 pl; pl.x = __uint_as_float(pw_[0] << 16); pl.y = __uint_as_float(pw_[0] & 0xffff0000u); pl.z = __uint_as_float(pw_[1] << 16); pl.w = __uint_as_float(pw_[1] & 0xffff0000u);
            const u32x2 xw = *(const u32x2*)(p.X1B + (size_t)r * 1024 + lane * 16 + 4 * q);
            float4 xn; xn.x = __uint_as_float(xw[0] << 16); xn.y = __uint_as_float(xw[0] & 0xffff0000u); xn.z = __uint_as_float(xw[1] << 16); xn.w = __uint_as_float(xw[1] & 0xffff0000u);
            v[4 * q] = ALPHA * xn.x + on[0] + pl.x; v[4 * q + 1] = ALPHA * xn.y + on[1] + pl.y;
            v[4 * q + 2] = ALPHA * xn.z + on[2] + pl.z; v[4 * q + 3] = ALPHA * xn.w + on[3] + pl.w;
            sm += (v[4 * q] + v[4 * q + 1]) + (v[4 * q + 2] + v[4 * q + 3]);
        }
        asm volatile("" ::: "memory");
        const float mean = wave_sum(sm) * (1.0f / 1024.0f);
        float sq = 0.f;
#pragma unroll
        for (int i = 0; i < 16; ++i) { const float dd = v[i] - mean; sq += dd * dd; }
        const float rstd = rsqrtf(wave_sum(sq) * (1.0f / 1024.0f) + LN_EPS);
        float* y = (r < TP) ? (p.y_prompt + (size_t)r * 1024) : (p.y_sample + (size_t)(r - TP) * 1024);
#pragma unroll
        for (int q = 0; q < 4; ++q) {
            const int c = lane * 16 + 4 * q;
            const float4 g4 = *(const float4*)(p.ln2_g + c), b4 = *(const float4*)(p.ln2_b + c);
            float4 ov; ov.x = (v[4 * q] - mean) * rstd * g4.x + b4.x; ov.y = (v[4 * q + 1] - mean) * rstd * g4.y + b4.y;
            ov.z = (v[4 * q + 2] - mean) * rstd * g4.z + b4.z; ov.w = (v[4 * q + 3] - mean) * rstd * g4.w + b4.w;
            *(float4*)(y + c) = ov;
        }
        if (SPLIT) __syncthreads();
}
__device__ __forceinline__ void phase_peer_gather(const Params& p, unsigned char* smem) {
    const int tid_ = opaque((int)threadIdx.x), lane = tid_ & 63, wl = tid_ >> 6;
    LAS3 float* xrow = (LAS3 float*)((ldsp)smem + wl * 8192);
    int pidx[16];
    {
        f32x16 fa, fb;
#pragma unroll
        for (int k = 0; k < 16; ++k) { fa[k] = (k < 8) ? 0.125f * k : (1.0f + 0.125f * (k & 7)); const int k2 = 16 + k; fb[k] = (1.0f + 0.125f * (k2 & 7)) * ((k2 < 24) ? 2.0f : 4.0f); }
        const u32x6 w6 = __builtin_amdgcn_cvt_scalef32_2xpk16_fp6_f32(fa, fb, 1.0f);
        const f32x32 rr = __builtin_amdgcn_cvt_scalef32_pk32_f32_fp6(w6, 1.0f);
        const int hsel = lane & 1;
#pragma unroll
        for (int m = 0; m < 16; ++m) {
            const float v = hsel ? rr[16 + m] : rr[m];
            const unsigned bits = __float_as_uint(v);
            const int kk = (v < 1.0f) ? (int)(v * 8.0f) : (8 * ((int)(bits >> 23) - 126) + (int)((bits >> 20) & 7u));
            pidx[m] = 32 * (lane >> 1) + kk;
        }
    }
    for (int r = blockIdx.x * 8 + wl; r < TP; r += gridDim.x * 8) gather_token<false>(p, r, 0, 16, xrow, pidx, lane, wl);
    for (int sb = blockIdx.x; sb < TS; sb += gridDim.x) gather_token<true>(p, TP + sb, 2 * wl, 2 * wl + 2, xrow, pidx, lane, wl);
}

struct SEpiBr1 { const bf16_t* G; bf16_t* O; __device__ __forceinline__ void operator()(int r, int c, float v) const { O[(size_t)r * 1024 + c] = f2bf(bf2f(G[(size_t)r * 1024 + c]) * v); } };
struct SEpiBr2 { const bf16_t* G; const bf16_t* I; bf16_t* O; __device__ __forceinline__ void operator()(int r, int c, float v) const { O[(size_t)r * 1024 + c] = f2bf(bf2f(I[(size_t)r * 1024 + c]) + bf2f(G[(size_t)r * 1024 + c]) * v); } };
struct SEpiF32 { float* O; __device__ __forceinline__ void operator()(int r, int c, float v) const { O[(size_t)r * 1024 + c] = v; } };
struct SEpiOutV { const float* xs; bf16_t* O; __device__ __forceinline__ void operator()(int r, int c, float v) const { O[(size_t)r * 1024 + c] = f2bf(ALPHA * xs[(size_t)(r - TP) * 1024 + c] + v); } };
struct SEpiQG { bf16_t* QP; const float* PE; bf16_t* PLE;
    __device__ __forceinline__ void operator()(int r, int c, float v) const {
        if (c < 2048) QP[(size_t)r * 2048 + c] = f2bf(v);
        else { const size_t o = (size_t)r * 1024 + (c - 2048); PLE[o] = f2bf(sigmoidf_(v) * PE[o]); } } };
template <class SE>
__device__ __forceinline__ void small_gemm(const bf16_t* A, int K, const bf16_t* Bt, int N, const SE& E, ldsp lds, int first, int stride) {
    const int tid = opaque((int)threadIdx.x), lane = tid & 63, w = __builtin_amdgcn_readfirstlane(tid >> 6);
    const int r31 = lane & 31, lh = lane >> 5;
    const int nitems = 4 * (N >> 5), ks = K >> 3;
    LAS3 float* part = (LAS3 float*)lds;
    for (int it = first; it < nitems; it += stride) {
        const int mt = it & 3, nt = it >> 2;
        const bf16_t* ap = A + (size_t)(TP + 32 * mt + r31) * K + w * ks + 8 * lh;
        const bf16_t* bp = Bt + (size_t)(32 * nt + r31) * K + w * ks + 8 * lh;
        f32x16 acc;
#pragma unroll
        for (int i = 0; i < 16; ++i) acc[i] = 0.f;
#pragma unroll 8
        for (int s = 0; s < ks; s += 16) {
            const bf16x8 a = __builtin_bit_cast(bf16x8, *(const u32x4*)(ap + s));
            const bf16x8 b = __builtin_bit_cast(bf16x8, *(const u32x4*)(bp + s));
            acc = MFMA32(a, b, acc);
        }
#pragma unroll
        for (int reg = 0; reg < 16; ++reg) part[(w * 32 + crow(reg, lh)) * 33 + r31] = acc[reg];
        __syncthreads();
#pragma unroll
        for (int h = 0; h < 2; ++h) {
            const int e = tid + 512 * h, rr = e >> 5, cc = e & 31;
            float v = 0.f;
#pragma unroll
            for (int ww = 0; ww < 8; ++ww) v += part[(ww * 32 + rr) * 33 + cc];
            E(TP + 32 * mt + rr, 32 * nt + cc, v);
        }
        __syncthreads();
    }
}

__global__ void __launch_bounds__(512, 2) mega(Params p) {
    extern __shared__ __attribute__((aligned(16))) unsigned char smem[];
    if (threadIdx.x == 0) *(uint4*)(smem + LDS_BAR) = make_uint4(0u, 0u, 0u, 0u);
    __syncthreads();
    XcdBarrier bar = xcd_barrier_post(p.bar, (volatile LAS unsigned*)(smem + LDS_BAR));
    PG8_LAS unsigned char* lds = (PG8_LAS unsigned char*)smem;
    const int G = (int)gridDim.x, c = (int)blockIdx.x;

    phase_prologue(p, smem);
    xcd_barrier(bar);
    {
        pg8::Gemm g{p.XB, p.WinT, MP, NINP, 1024};
        pg8::StaticOrder S; S.init(MP, NINP, G, c);
        EpiIn E{p};
        pg8::gemm_phase<EpiIn, pg8::StaticOrder, false>(lds, g, S, E, nullptr);
        const int nunits = (MP / 256) * (NINP / 256), rem = nunits % G;
        const int first = (rem > 0) ? rem : 0, nidle = G - first;
        if (c >= first) phase_peer_tables(p, (size_t)(c - first) * NT + threadIdx.x, (size_t)nidle * NT);
    }
    xcd_barrier(bar);
    phase_ret_scan(p, smem);
    phase_idx_scores(p, smem);
    xcd_barrier(bar);
    phase_ret_out(p, smem);
    phase_ret_gn(p);
    __syncthreads();
    {
        const bool one_each = (int)gridDim.x >= TS;
        const bool has_sample = one_each && (int)blockIdx.x < TS;
        if (!one_each) phase_attn(p, smem);
        else if (has_sample) attn_item(p, (int)blockIdx.x, true, smem);
        phase_attn_prompt(p, smem, has_sample);
    }
    xcd_barrier(bar);
    {
        const int sfirst = G - 1 - c;
        { SEpiBr1 E{p.GA, p.BRP}; small_gemm(p.RETO, 2048, p.WretT, 1024, E, (ldsp)smem, sfirst, G); }
        asm volatile("s_waitcnt vmcnt(0)" ::: "memory"); __syncthreads();
        { SEpiBr2 E{p.GB, p.BRP, p.BR}; small_gemm(p.ATTO, 1024, p.WattT, 1024, E, (ldsp)smem, sfirst, G); }
        { SEpiF32 E{p.PE}; small_gemm(p.PB, 256, p.WpleT, 1024, E, (ldsp)smem, sfirst, G); }
        pg8::StaticOrder S; S.init(TP, 1024, G, c);
        { pg8::Gemm g{p.RETO, p.WretT, TP, 1024, 2048}; EpiBr1 E{p.GA, p.BRP}; pg8::gemm_phase<EpiBr1, pg8::StaticOrder, false>(lds, g, S, E, nullptr); }
        asm volatile("s_waitcnt vmcnt(0)" ::: "memory"); __syncthreads();
        { pg8::Gemm g{p.ATTO, p.WattT, TP, 1024, 1024}; EpiBr2 E{p.GB, p.BRP, p.BR}; pg8::gemm_phase<EpiBr2, pg8::StaticOrder, false>(lds, g, S, E, nullptr); }
        asm volatile("s_waitcnt vmcnt(0)" ::: "memory"); __syncthreads();
        { pg8::Gemm g{p.PB, p.WpleT, TP, 1024, 256}; EpiF32 E{p.PE, 1024}; pg8::gemm_phase<EpiF32, pg8::StaticOrder, false>(lds, g, S, E, nullptr); }
    }
    xcd_barrier(bar);
    {
        { SEpiOutV E{p.x_sample, p.VPRE}; small_gemm(p.BR, 1024, p.WoutT, 1024, E, (ldsp)smem, G - 1 - c, G); }
        pg8::StaticOrder S; S.init(TP, 1024, G, c);
        pg8::Gemm g{p.BR, p.WoutT, TP, 1024, 1024}; EpiOutV E{p.x_prompt, p.x_sample, p.VPRE};
        pg8::gemm_phase<EpiOutV, pg8::StaticOrder, false>(lds, g, S, E, nullptr);
    }
    xcd_barrier(bar);
    phase_ln1(p);
    xcd_barrier(bar);
    {
        { SEpiQG E{p.QP, p.PE, p.PLE}; small_gemm(p.X1B, 1024, p.WqgT, 3072, E, (ldsp)smem, G - 1 - c, G); }
        pg8::StaticOrder S; S.init(TP, 3072, G, c);
        pg8::Gemm g{p.X1B, p.WqgT, TP, 3072, 1024}; EpiQG E{p.QP, p.PE, p.PLE};
        pg8::gemm_phase<EpiQG, pg8::StaticOrder, false>(lds, g, S, E, nullptr);
    }
    xcd_barrier(bar);
    phase_peer_score(p, smem);
    xcd_barrier(bar);
    phase_peer_gather(p, smem);
}
}

extern "C" void kernel_launch(void* const* d_in, const int* in_sizes, int n_in, void* d_out, int out_size, void* d_ws, size_t ws_size,
                              hipStream_t stream) {
    using namespace mk;
    Params p{};
    p.x_prompt = (const float*)d_in[0]; p.x_sample = (const float*)d_in[1]; p.cache_k = (const float*)d_in[2]; p.cache_v = (const float*)d_in[3];
    p.cache_kidx = (const float*)d_in[4]; p.state_ret = (const float*)d_in[5]; p.page_table = (const int*)d_in[6];
    p.p_prompt = (const float*)d_in[7]; p.p_sample = (const float*)d_in[8]; p.w_in = (const float*)d_in[9];
    p.idx_k_g = (const float*)d_in[10]; p.idx_k_b = (const float*)d_in[11]; p.gn_g = (const float*)d_in[12]; p.gn_b = (const float*)d_in[13];
    p.w_ret_o = (const float*)d_in[14]; p.w_att_o = (const float*)d_in[15]; p.w_out = (const float*)d_in[16];
    p.ln1_g = (const float*)d_in[17]; p.ln1_b = (const float*)d_in[18]; p.peer_wq = (const float*)d_in[19]; p.peer_subkeys = (const float*)d_in[20];
    p.peer_u = (const float*)d_in[21]; p.peer_v = (const float*)d_in[22]; p.w_ple_gate = (const float*)d_in[23]; p.w_ple = (const float*)d_in[24];
    p.ln2_g = (const float*)d_in[25]; p.ln2_b = (const float*)d_in[26];
    float* out = (float*)d_out;
    p.y_prompt = out; p.y_sample = p.y_prompt + 16777216; p.k_prompt = p.y_sample + 131072; p.v_prompt = p.k_prompt + 4194304;
    p.kidx_prompt = p.v_prompt + 4194304; p.ret_prompt = p.kidx_prompt + 1048576; p.k_sample = p.ret_prompt + 2097152;
    p.v_sample = p.k_sample + 32768; p.kidx_sample = p.v_sample + 32768; p.ret_sample = p.kidx_sample + 8192;

    unsigned char* w = (unsigned char*)d_ws;
    size_t off = 0;
    auto take = [&](size_t bytes) { unsigned char* r = w + off; off += (bytes + 255) & ~(size_t)255; return r; };
    p.bar = (unsigned*)take(16384);
    p.XB = (bf16_t*)take((size_t)MP * 1024 * 2); p.PB = (bf16_t*)take((size_t)MP * 256 * 2);
    p.WinT = (bf16_t*)take((size_t)NINP * 1024 * 2); p.WretT = (bf16_t*)take((size_t)1024 * 2048 * 2); p.WattT = (bf16_t*)take((size_t)1024 * 1024 * 2);
    p.WoutT = (bf16_t*)take((size_t)1024 * 1024 * 2); p.WqgT = (bf16_t*)take((size_t)3072 * 1024 * 2); p.WpleT = (bf16_t*)take((size_t)1024 * 256 * 2);
    p.c256 = (float*)take((size_t)NPOS * 128 * 4); p.s256 = (float*)take((size_t)NPOS * 128 * 4);
    p.c128 = (float*)take((size_t)NPOS * 64 * 4); p.s128 = (float*)take((size_t)NPOS * 64 * 4);
    p.c64 = (float*)take((size_t)NPOS * 32 * 4); p.s64 = (float*)take((size_t)NPOS * 32 * 4);
    p.RQ = (bf16_t*)take((size_t)MP * 1024 * 2); p.RK = (bf16_t*)take((size_t)MP * 1024 * 2);
    p.RV = (bf16_t*)take((size_t)MP * 2048 * 2); p.SG = (bf16_t*)take((size_t)MP * 2048 * 2);
    p.AQ = (bf16_t*)take((size_t)MP * 1024 * 2); p.AK = (bf16_t*)take((size_t)MP * 256 * 2); p.AV = (bf16_t*)take((size_t)MP * 256 * 2);
    p.GA = (bf16_t*)take((size_t)MP * 1024 * 2); p.GB = (bf16_t*)take((size_t)MP * 1024 * 2);
    p.IQ = (f16_t*)take((size_t)MP * 512 * 2); p.IK = (f16_t*)take((size_t)MP * 64 * 2); p.IW = (float*)take((size_t)MP * 8 * 4);
    p.RO = (float*)take((size_t)MP * 2048 * 4);
    p.SC = (bf16_t*)take((size_t)16 * 32 * 256 * 512 * 2);
    p.RETO = (bf16_t*)take((size_t)MP * 2048 * 2); p.ATTO = (bf16_t*)take((size_t)MP * 1024 * 2);
    p.BRP = (bf16_t*)take((size_t)MP * 1024 * 2); p.BR = (bf16_t*)take((size_t)MP * 1024 * 2);
    p.VPRE = (bf16_t*)take((size_t)MP * 1024 * 2); p.X1 = (float*)take((size_t)256);
    p.X1B = (bf16_t*)take((size_t)MP * 1024 * 2); p.QP = (bf16_t*)take((size_t)MP * 2048 * 2);
    p.PE = (float*)take((size_t)MP * 1024 * 4); p.PLE = (bf16_t*)take((size_t)MP * 1024 * 2);
    p.U8 = (unsigned char*)take((size_t)16384 * 1024); p.V8 = (unsigned char*)take((size_t)16384 * 1024); p.SUBK = (bf16_t*)take((size_t)16 * 128 * 128 * 2);
    p.EIDX = (int*)take((size_t)MP * 128 * 4); p.GW = (float*)take((size_t)MP * 128 * 4);
    p.SCO = (float*)take((size_t)TP * 4096 * 4); p.SS = (float*)take((size_t)TS * 16392 * 4);

    static int grid = 0;
    if (!grid) {
        int dev = 0, cus = 0;
        hipGetDevice(&dev);
        hipDeviceGetAttribute(&cus, hipDeviceAttributeMultiprocessorCount, dev);
        (void)hipFuncSetAttribute((const void*)mega, hipFuncAttributeMaxDynamicSharedMemorySize, LDS_TOTAL);
        grid = cus > 0 ? cus : 256;
        if (grid > 256) grid = 256;
    }
    (void)hipMemsetAsync(p.bar, 0, 16384, stream);
    hipLaunchKernelGGL(mega, dim3(grid), dim3(NT), LDS_TOTAL, stream, p);
}
```
